# Optimizing an MI355X kernel written in HIP

```python
import jax, jax.numpy as jnp
from jax import lax
import numpy as np

D_MODEL = 1024
BATCH = 1
SEQ = 16384
DEPTH = 2

HEAD_DIM = 64
MOBA_HEADS = 8
MOBA_BLOCK = 256
MOBA_TOPK = 3
SWA_Q_HEADS = 8
SWA_KV_HEADS = 2
SWA_WINDOW = 128
N_REL_BUCKETS = 32
REL_MAX_DISTANCE = 2048
D_FF = 4 * D_MODEL
Q_CHUNK = 128
NORM_EPS = 1e-6

MOBA_WIDTH = MOBA_HEADS * HEAD_DIM
SWA_Q_WIDTH = SWA_Q_HEADS * HEAD_DIM
SWA_KV_WIDTH = SWA_KV_HEADS * HEAD_DIM
N_ATTN_HEADS = MOBA_HEADS + SWA_Q_HEADS
IN_WIDTH = 3 * MOBA_WIDTH + SWA_Q_WIDTH + 2 * SWA_KV_WIDTH + 2 * D_MODEL

kernel_name = "hybrid_moba_swa_gated_block"


def rms_norm(x, g):
    xf = x.astype(jnp.float32)
    y = xf * lax.rsqrt(jnp.mean(xf * xf, axis=-1, keepdims=True) + NORM_EPS)
    return (y * g.astype(jnp.float32)).astype(x.dtype)


def rel_bucket(dist):
    n = jnp.maximum(dist, 0)
    exact = N_REL_BUCKETS // 2
    nf = jnp.maximum(n, 1).astype(jnp.float32)
    large = exact + (jnp.log(nf / exact) / np.float32(np.log(REL_MAX_DISTANCE / exact))
                     * (N_REL_BUCKETS - exact)).astype(jnp.int32)
    large = jnp.minimum(large, N_REL_BUCKETS - 1)
    return jnp.where(n < exact, n, large)


def moba_attention(q, k, v, bias_table):
    B, H, S, hd = q.shape
    nb = -(-S // MOBA_BLOCK)
    pad = nb * MOBA_BLOCK - S
    kp = jnp.pad(k, ((0, 0), (0, 0), (0, pad), (0, 0)))
    vp = jnp.pad(v, ((0, 0), (0, 0), (0, pad), (0, 0)))
    kb = kp.reshape(B, H, nb, MOBA_BLOCK, hd)
    vb = vp.reshape(B, H, nb, MOBA_BLOCK, hd)
    kmean = jnp.mean(kb.astype(jnp.float32), axis=3)
    gate = jnp.einsum('bhsd,bhnd->bhsn', q.astype(jnp.float32), kmean)
    qblk = jnp.arange(S) // MOBA_BLOCK
    past = jnp.arange(nb)[None, :] < qblk[:, None]
    gate = jnp.where(past[None, None], gate, -jnp.inf)
    n_sel = min(MOBA_TOPK, nb)
    _, sel = lax.top_k(gate, n_sel)
    sel_valid = sel < qblk[None, None, :, None]
    scale = HEAD_DIM ** -0.5
    n_chunks = S // Q_CHUNK
    q_c = q.reshape(B, H, n_chunks, Q_CHUNK, hd).transpose(2, 0, 1, 3, 4)
    sel_c = sel.reshape(B, H, n_chunks, Q_CHUNK, n_sel).transpose(2, 0, 1, 3, 4)
    val_c = sel_valid.reshape(B, H, n_chunks, Q_CHUNK, n_sel).transpose(2, 0, 1, 3, 4)
    b_ix = jnp.arange(B)[:, None, None, None]
    h_ix = jnp.arange(H)[None, :, None, None]
    h5 = jnp.arange(H)[None, :, None, None, None]
    offs = jnp.arange(MOBA_BLOCK)
    bias_t = bias_table.T.astype(jnp.float32)
    n_past = n_sel * MOBA_BLOCK

    def chunk(args):
        c, qc, sc, vc = args
        qpos = c * Q_CHUNK + jnp.arange(Q_CHUNK)
        kg = kb[b_ix, h_ix, sc]
        vg = vb[b_ix, h_ix, sc]
        lp = jnp.einsum('bhqd,bhqnkd->bhqnk', qc, kg).astype(jnp.float32) * scale
        kpos_p = sc[..., None] * MOBA_BLOCK + offs
        lp = lp + bias_t[h5, rel_bucket(qpos[None, None, :, None, None] - kpos_p)]
        lp = jnp.where(vc[..., None], lp, -jnp.inf)
        ob = (c * Q_CHUNK) // MOBA_BLOCK
        ko = lax.dynamic_index_in_dim(kb, ob, axis=2, keepdims=False)
        vo = lax.dynamic_index_in_dim(vb, ob, axis=2, keepdims=False)
        lo = jnp.einsum('bhqd,bhkd->bhqk', qc, ko).astype(jnp.float32) * scale
        d_o = qpos[:, None] - (ob * MOBA_BLOCK + offs)[None, :]
        lo = lo + bias_t[:, rel_bucket(d_o)][None]
        lo = jnp.where((d_o >= 0)[None, None], lo, -jnp.inf)
        logits = jnp.concatenate([lp.reshape(B, H, Q_CHUNK, n_past), lo], axis=-1)
        p = jax.nn.softmax(logits, axis=-1)
        out = (jnp.einsum('bhqk,bhqkd->bhqd', p[..., :n_past].astype(vg.dtype),
                          vg.reshape(B, H, Q_CHUNK, n_past, hd))
               + jnp.einsum('bhqk,bhkd->bhqd', p[..., n_past:].astype(vo.dtype), vo))
        return out.astype(q.dtype)

    outs = lax.map(chunk, (jnp.arange(n_chunks), q_c, sel_c, val_c))
    return outs.transpose(1, 2, 0, 3, 4).reshape(B, H, S, hd)


def swa_attention(q, k, v, sinks, bias_table):
    B, HQ, S, hd = q.shape
    HKV = k.shape[1]
    G = HQ // HKV
    W = SWA_WINDOW
    nb = S // W
    qb = q.reshape(B, HKV, G, nb, W, hd)
    kb = k.reshape(B, HKV, nb, W, hd)
    vb = v.reshape(B, HKV, nb, W, hd)
    zpad = ((0, 0), (0, 0), (1, 0), (0, 0), (0, 0))
    kband = jnp.concatenate([jnp.pad(kb, zpad)[:, :, :-1], kb], axis=3)
    vband = jnp.concatenate([jnp.pad(vb, zpad)[:, :, :-1], vb], axis=3)
    scale = HEAD_DIM ** -0.5
    logits = jnp.einsum('bkgnqd,bkncd->bkgnqc', qb, kband).astype(jnp.float32) * scale
    kj = jnp.arange(2 * W) - W
    dist = jnp.arange(W)[:, None] - kj[None, :]
    bias = bias_table.T.astype(jnp.float32)[:, rel_bucket(dist)].reshape(HKV, G, 1, W, 2 * W)
    in_win = (dist >= 0) & (dist < W)
    real = (jnp.arange(nb)[:, None] * W + kj[None, :]) >= 0
    mask = in_win[None] & real[:, None, :]
    logits = jnp.where(mask, logits + bias, -jnp.inf)
    sink = jnp.broadcast_to(sinks.astype(jnp.float32).reshape(1, HKV, G, 1, 1, 1),
                            logits.shape[:-1] + (1,))
    p = jax.nn.softmax(jnp.concatenate([logits, sink], axis=-1), axis=-1)[..., :-1]
    out = jnp.einsum('bkgnqc,bkncd->bkgnqd', p.astype(vband.dtype), vband)
    return out.reshape(B, HQ, S, hd).astype(q.dtype)


def _heads(t, n):
    B, S, _ = t.shape
    return t.reshape(B, S, n, HEAD_DIM).transpose(0, 2, 1, 3)


def _merge_heads(t):
    B, H, S, hd = t.shape
    return t.transpose(0, 2, 1, 3).reshape(B, S, H * hd)


def setup_inputs(seed: int = 0) -> dict:
    key = jax.random.key(seed)
    ks = jax.random.split(key, 20)
    f32 = jnp.float32
    nrm = lambda k, shape, s: jax.random.normal(k, shape, f32) * s
    return {
        "x": nrm(ks[0], (BATCH, SEQ, D_MODEL), 1.0),
        "rel_bias": nrm(ks[1], (N_REL_BUCKETS, N_ATTN_HEADS), 0.5),
        "g_mix": 1.0 + nrm(ks[2], (DEPTH, D_MODEL), 0.02),
        "w_in": nrm(ks[3], (DEPTH, D_MODEL, IN_WIDTH), D_MODEL ** -0.5),
        "b_gate": nrm(ks[4], (DEPTH, 2 * D_MODEL), 0.02),
        "q_norm_a": 1.0 + nrm(ks[5], (DEPTH, HEAD_DIM), 0.02),
        "k_norm_a": 1.0 + nrm(ks[6], (DEPTH, HEAD_DIM), 0.02),
        "q_norm_b": 1.0 + nrm(ks[7], (DEPTH, HEAD_DIM), 0.02),
        "k_norm_b": 1.0 + nrm(ks[8], (DEPTH, HEAD_DIM), 0.02),
        "sinks": nrm(ks[9], (DEPTH, SWA_Q_HEADS), 0.5),
        "w_branch_a": nrm(ks[10], (DEPTH, MOBA_WIDTH, D_MODEL), MOBA_WIDTH ** -0.5),
        "w_branch_b": nrm(ks[11], (DEPTH, SWA_Q_WIDTH, D_MODEL), SWA_Q_WIDTH ** -0.5),
        "w_out": nrm(ks[12], (DEPTH, D_MODEL, D_MODEL), D_MODEL ** -0.5),
        "g_ffn": 1.0 + nrm(ks[13], (DEPTH, D_MODEL), 0.02),
        "w_ff1": nrm(ks[14], (DEPTH, D_MODEL, D_FF), D_MODEL ** -0.5),
        "w_ff2": nrm(ks[15], (DEPTH, D_FF, D_MODEL), D_FF ** -0.5),
    }


def reference(x, rel_bias, g_mix, w_in, b_gate, q_norm_a, k_norm_a, q_norm_b, k_norm_b,
              sinks, w_branch_a, w_branch_b, w_out, g_ffn, w_ff1, w_ff2):
    bias_a = rel_bias[:, :MOBA_HEADS]
    bias_b = rel_bias[:, MOBA_HEADS:]
    splits = np.cumsum([MOBA_WIDTH, MOBA_WIDTH, MOBA_WIDTH, SWA_Q_WIDTH,
                        SWA_KV_WIDTH, SWA_KV_WIDTH, D_MODEL]).tolist()
    for l in range(DEPTH):
        h = rms_norm(x, g_mix[l])
        proj = h @ w_in[l]
        qa, ka, va, qb, kb, vb, ga, gb = jnp.split(proj, splits, axis=-1)
        qa = rms_norm(_heads(qa, MOBA_HEADS), q_norm_a[l])
        ka = rms_norm(_heads(ka, MOBA_HEADS), k_norm_a[l])
        va = _heads(va, MOBA_HEADS)
        qb = rms_norm(_heads(qb, SWA_Q_HEADS), q_norm_b[l])
        kb = rms_norm(_heads(kb, SWA_KV_HEADS), k_norm_b[l])
        vb = _heads(vb, SWA_KV_HEADS)
        ya = _merge_heads(moba_attention(qa, ka, va, bias_a))
        yb = _merge_heads(swa_attention(qb, kb, vb, sinks[l], bias_b))
        gate_a = jax.nn.sigmoid((ga + b_gate[l, :D_MODEL]).astype(jnp.float32)).astype(x.dtype)
        gate_b = jax.nn.sigmoid((gb + b_gate[l, D_MODEL:]).astype(jnp.float32)).astype(x.dtype)
        merged = gate_a * (ya @ w_branch_a[l]) + gate_b * (yb @ w_branch_b[l])
        x = x + merged @ w_out[l]
        h2 = rms_norm(x, g_ffn[l])
        x = x + jnp.square(jax.nn.relu(h2 @ w_ff1[l])) @ w_ff2[l]
    return x
```

```cpp
#include <hip/hip_runtime.h>
#include <hip/hip_bf16.h>
#include <cstdint>
#include <cstdio>

#ifndef MK_N_LAUNCHES
#define MK_N_LAUNCHES 1
#endif

#ifndef F8_G1
#define F8_G1 1
#endif
#ifndef F8_G2
#define F8_G2 1
#endif
#ifndef F8_G3
#define F8_G3 0
#endif

#define LAS __attribute__((address_space(3)))
#define GAS __attribute__((address_space(1)))
typedef unsigned short bf16_t;
typedef short bf16x8 __attribute__((ext_vector_type(8)));
typedef float f32x4 __attribute__((ext_vector_type(4)));
typedef float f32x2 __attribute__((ext_vector_type(2)));
typedef float f32x16 __attribute__((ext_vector_type(16)));
typedef unsigned u32x4 __attribute__((ext_vector_type(4)));
typedef unsigned u32x2 __attribute__((ext_vector_type(2)));
typedef short v4i16_t __attribute__((ext_vector_type(4)));
typedef __bf16 bf16x2_t __attribute__((ext_vector_type(2)));
typedef int i32x8 __attribute__((ext_vector_type(8)));
typedef int i32x4 __attribute__((ext_vector_type(4)));

constexpr int M = 16384, D = 1024, INW = 4352, FF = 4096, NLAYER = 2;
constexpr int NPH = 8;
constexpr float NORM_EPS = 1e-6f;
constexpr float LOG2E = 1.4426950408889634f;
constexpr float C2 = 0.125f * LOG2E;
constexpr int LUTN = 2176, LUTPAD = 128;

constexpr size_t MiB = 1u << 20;
constexpr size_t WS_CTL = 0, CTL_ZERO_BYTES = 64 * 1024;
constexpr size_t WS_SSQ = 64 * 1024;
constexpr size_t WS_KMP = WS_SSQ + 1 * MiB;
constexpr size_t WS_LUT = WS_KMP + 256 * 1024;
constexpr size_t WS_CUR = WS_LUT + 256 * 1024;
constexpr size_t WS_PL = WS_CUR + 64 * 1024;
constexpr size_t WS_W = 3 * MiB + 512 * 1024;
constexpr size_t OFF_WIN = 0;
constexpr size_t OFF_WBR = OFF_WIN + (size_t)INW * D * 2;
constexpr size_t OFF_WOUT = OFF_WBR + 2 * MiB;
constexpr size_t OFF_W1 = OFF_WOUT + 2 * MiB;
constexpr size_t OFF_W2 = OFF_W1 + 8 * MiB;
constexpr size_t W_BYTES = OFF_W2 + 8 * MiB;
constexpr size_t WS_XB = WS_W + W_BYTES;
constexpr size_t WS_PROJ = WS_XB + 32 * MiB;
constexpr size_t WS_QA = WS_PROJ, WS_KA = WS_QA + 16 * MiB, WS_VA = WS_KA + 16 * MiB, WS_QB = WS_VA + 16 * MiB;
constexpr size_t WS_KB = WS_QB + 16 * MiB, WS_VB = WS_KB + 4 * MiB, WS_GT = WS_VB + 4 * MiB;
constexpr size_t WS_MRG = WS_PROJ;
constexpr size_t WS_U = WS_PROJ;
constexpr size_t WS_PO = WS_GT + 64 * MiB;
constexpr size_t WS_LISTS = WS_PO + 48 * MiB;
constexpr int LIST_HEAD = 516096;
constexpr size_t WS_END = WS_LISTS + (size_t)8 * LIST_HEAD * 2;
static_assert(WS_END <= 256 * MiB, "ws map");
static_assert(WS_U + (size_t)M * FF * 2 <= WS_PO, "u overlay");
static_assert(WS_PL + 3 * 8 * (size_t)M * 4 <= WS_W, "misc map");
constexpr size_t DO_Y = 0, DO_W = 32 * MiB;
constexpr size_t WS_X8 = WS_PO;

constexpr int RING_BYTES = 131072;
constexpr int LDSCTL_OFF = 145408, MISC_OFF = LDSCTL_OFF + 320;
constexpr int LDS_BYTES = 147456;
constexpr int L_K = 0, L_V = 32768, L_OST = 65536, L_WSF = 98304, L_LUT = 100352, L_TAB = 135168, L_SM = 143360;
constexpr int L_RSTD = 131072;
static_assert(L_RSTD + 2560 * 4 <= LDSCTL_OFF, "epilogue tables");
static_assert(L_LUT + 4 * LUTN * 4 <= L_TAB && L_TAB + 4096 <= L_SM && L_SM + 1024 <= LDSCTL_OFF && MISC_OFF + 128 <= LDS_BYTES, "LDS map");

__device__ __forceinline__ unsigned cvtpk(float lo, float hi) { f32x2 v = {lo, hi}; bf16x2_t b = __builtin_convertvector(v, bf16x2_t); return __builtin_bit_cast(unsigned, b); }
__device__ __forceinline__ float bf_lo(unsigned w) { return __builtin_bit_cast(float, w << 16); }
__device__ __forceinline__ float bf_hi(unsigned w) { return __builtin_bit_cast(float, w & 0xffff0000u); }
__device__ __forceinline__ unsigned f2bf(float f) { unsigned u = __builtin_bit_cast(unsigned, f); return (u + 0x7fffu + ((u >> 16) & 1u)) >> 16; }
__device__ __forceinline__ unsigned pk2(float lo, float hi) { return f2bf(lo) | (f2bf(hi) << 16); }
__device__ __forceinline__ unsigned pk4f8(float a, float b, float c, float d) { int p = __builtin_amdgcn_cvt_pk_fp8_f32(a, b, 0, false); p = __builtin_amdgcn_cvt_pk_fp8_f32(c, d, p, true); return (unsigned)p; }
constexpr float F8_SW = 64.f, F8_SY = F8_G2 ? 16.f : 1.f, F8_SM = F8_G3 ? 16.f : 1.f;
constexpr float F8_SW2 = F8_G2 ? F8_SW : 1.f, F8_SW3 = F8_G3 ? F8_SW : 1.f;

namespace pg8 {
constexpr int BM = 256, BK = 64, HALF = 128, HTB = HALF * BK * 2, NXCD = 8, WGM = 8;
__host__ __device__ __forceinline__ int lds_byte(int r, int c) { const int st = (r >> 4) * 2 + (c >> 5), rr = r & 15, cc = c & 31, ob = rr * 64 + cc * 2; return st * 1024 + (ob ^ (((ob >> 9) & 1) << 5)); }
__host__ __device__ __forceinline__ void stage_rc(int b, int& R, int& C) { const int st = b / 1024, sb = b % 1024, swz = sb ^ (((sb >> 9) & 1) << 5); R = (st >> 1) * 16 + swz / 64; C = (st & 1) * 32 + (swz % 64) / 2; }
__host__ __device__ __forceinline__ int perm32(int rho) { const int n = rho >> 4, i = rho & 15; return 8 * (i >> 2) + 4 * n + (i & 3); }

struct Unit { int pm, pn, part; };
struct Gemm { const void* A; const void* Bt; int lda, ldb, K, kpart; };

struct StaticOrder {
    int nM, nN, nwg, G, c, parts;
    int fixed, fpm, fpn;
    __device__ __forceinline__ void init(int M_, int N_, int G_, int c_, int parts_) { nM = M_ / BM; nN = N_ / BM; nwg = nM * nN; G = G_; c = c_; parts = parts_; fixed = 0; fpm = 0; fpn = 0; }
    __device__ __forceinline__ void init_single(int pm_, int pn_, bool have) { nM = 1; nN = 1; nwg = 1; G = 1; c = 0; parts = 1; fixed = have ? 1 : 2; fpm = pm_; fpn = pn_; }
    __device__ __forceinline__ int first_pm() const {
        if (c >= nwg) return -1;
        int wgid = c; { const int q = nwg / NXCD, r = nwg % NXCD, xcd = wgid % NXCD, off = wgid / NXCD; wgid = (xcd < r ? xcd * (q + 1) : r * (q + 1) + (xcd - r) * q) + off; }
        const int nig = WGM * nN, gid = wgid / nig, fm = gid * WGM, gsz = (nM - fm) < WGM ? (nM - fm) : WGM;
        return fm + ((wgid % nig) % gsz);
    }
    __device__ __forceinline__ bool next(int i, Unit& u) const {
        if (fixed) { u.pm = fpm; u.pn = fpn; u.part = 0; return fixed == 1 && i == 0; }
        const int ti = i / parts; u.part = i - ti * parts;
        const long L = (long)ti * G + c; if (L >= nwg) return false;
        int wgid = (int)L; { const int q = nwg / NXCD, r = nwg % NXCD, xcd = wgid % NXCD, off = wgid / NXCD; wgid = (xcd < r ? xcd * (q + 1) : r * (q + 1) + (xcd - r) * q) + off; }
        const int nig = WGM * nN, gid = wgid / nig, fm = gid * WGM, gsz = (nM - fm) < WGM ? (nM - fm) : WGM;
        u.pm = fm + ((wgid % nig) % gsz); u.pn = (wgid % nig) / gsz; return true;
    }
};

template <bool F8, class Epi>
__device__ __forceinline__ void gemm_phase(LAS unsigned char* lds, const Gemm g, const StaticOrder& S, const Epi& E) {
    const int tid = threadIdx.x, wid = __builtin_amdgcn_readfirstlane(tid >> 6), lane = tid & 63, wr = wid >> 2, wc = wid & 3, fr = lane & 15, fq = lane >> 4;
    const int nt = g.K / 128;
    unsigned voffA, voffB;
    { int R, C; stage_rc(tid * 16, R, C); const int Rb = (R & ~31) + perm32(R & 31); voffA = (unsigned)(R * g.lda + 2 * C); voffB = (unsigned)(Rb * g.ldb + 2 * C); }
    const size_t ivoffA = (size_t)64 * g.lda, ivoffB = (size_t)64 * g.ldb;
    const size_t kstep = (size_t)(BK * 2);
    const size_t hstepA = (size_t)HALF * g.lda, hstepB = (size_t)HALF * g.ldb;
    const size_t tstepA = 2 * hstepA, tstepB = 2 * hstepB;
    const unsigned ldsw = (unsigned)wid * 1024u;
    const int aoff = lds_byte(wr * 64 + fr, fq * 8), boff = lds_byte(wc * 32 + fr, fq * 8);
#define PG8_SA(b, h) (((b) * 2 + (h)) * HTB)
#define PG8_SB(b, h) ((4 + (b) * 2 + (h)) * HTB)
#define PG8_STAGE(bufoff, gbase, voff) do { _Pragma("unroll") for (int _i = 0; _i < 2; ++_i) \
        __builtin_amdgcn_global_load_lds((const unsigned*)((const char*)(gbase) + _i * i##voff + (voff)), (LAS unsigned*)(lds + (bufoff) + ldsw + _i * 8192), 16, 0, 0); } while (0)
#define PG8_LDA(dst, b, h) do { _Pragma("unroll") for (int m = 0; m < 4; ++m) _Pragma("unroll") for (int k = 0; k < 2; ++k) dst[m][k] = *(const LAS bf16x8*)(lds + PG8_SA(b, h) + aoff + m * 2048 + k * 1024); } while (0)
#define PG8_LDB(dst, b, h) do { _Pragma("unroll") for (int n = 0; n < 2; ++n) _Pragma("unroll") for (int k = 0; k < 2; ++k) dst[n][k] = *(const LAS bf16x8*)(lds + PG8_SB(b, h) + boff + n * 2048 + k * 1024); } while (0)
#define PG8_F8CAT(x) __builtin_shufflevector(__builtin_bit_cast(i32x4, x[0]), __builtin_bit_cast(i32x4, x[1]), 0, 1, 2, 3, 4, 5, 6, 7)
#define PG8_MMA(ai, bj, At, Bt) do { __builtin_amdgcn_s_setprio(1); _Pragma("unroll") for (int m = 0; m < 4; ++m) _Pragma("unroll") for (int n = 0; n < 2; ++n) { \
        if (F8) { const i32x8 b8_ = PG8_F8CAT(Bt[n]), a8_ = PG8_F8CAT(At[m]); asm volatile("v_mfma_scale_f32_16x16x128_f8f6f4 %0, %1, %2, %0, %3, %3 op_sel_hi:[0,0,0]" : "+v"(acc[ai][bj][m][n]) : "v"(b8_), "v"(a8_), "v"(f8one)); } \
        else { _Pragma("unroll") for (int k = 0; k < 2; ++k) acc[ai][bj][m][n] = __builtin_amdgcn_mfma_f32_16x16x32_bf16(Bt[n][k], At[m][k], acc[ai][bj][m][n], 0, 0, 0); } } __builtin_amdgcn_s_setprio(0); } while (0)
#define PG8_WAIT_V(n) asm volatile("s_waitcnt vmcnt(" #n ")" ::: "memory")
#define PG8_WAIT_L(n) asm volatile("s_waitcnt lgkmcnt(" #n ")" ::: "memory")
#define PG8_BAR __builtin_amdgcn_s_barrier()
#define PG8_SCHED __builtin_amdgcn_sched_barrier(0)
    Unit cur, nxt; int ui = 0;
    if (!S.next(0, cur)) return;
    const int f8one = 0x7f7f7f7f;
    f32x4 acc[2][2][4][2];
#pragma unroll
    for (int a = 0; a < 2; ++a)
#pragma unroll
        for (int b = 0; b < 2; ++b)
#pragma unroll
            for (int m = 0; m < 4; ++m)
#pragma unroll
                for (int n = 0; n < 2; ++n) acc[a][b][m][n] = (f32x4){0.f, 0.f, 0.f, 0.f};
    bf16x8 At[4][2], B0[2][2], B1[2][2];
    const char* cA = (const char*)g.A + (size_t)cur.pm * tstepA + (size_t)cur.part * g.kpart; const char* cB = (const char*)g.Bt + (size_t)cur.pn * tstepB + (size_t)cur.part * g.kpart;
    PG8_STAGE(PG8_SB(0, 0), cB, voffB); PG8_STAGE(PG8_SB(0, 1), cB + hstepB, voffB); PG8_STAGE(PG8_SA(0, 0), cA, voffA); PG8_STAGE(PG8_SA(0, 1), cA + hstepA, voffA);
    if (wr == 1) PG8_BAR;
    PG8_WAIT_V(2); PG8_BAR;
    PG8_STAGE(PG8_SB(1, 0), cB + kstep, voffB); PG8_STAGE(PG8_SA(1, 0), cA + kstep, voffA); PG8_STAGE(PG8_SB(1, 1), cB + hstepB + kstep, voffB);
    PG8_WAIT_V(6); PG8_BAR;
    for (;;) {
        const bool has_next = S.next(ui + 1, nxt);
        const char* nA = has_next ? (const char*)g.A + (size_t)nxt.pm * tstepA + (size_t)nxt.part * g.kpart : cA;
        const char* nB = has_next ? (const char*)g.Bt + (size_t)nxt.pn * tstepB + (size_t)nxt.part * g.kpart : cB;
#pragma unroll 1
        for (int t = 0; t < nt; t += 2) {
            const bool last = (t == nt - 2);
            const char* a1 = cA + (size_t)(t + 1) * kstep;
            const char* a2 = last ? nA : cA + (size_t)(t + 2) * kstep; const char* b2 = last ? nB : cB + (size_t)(t + 2) * kstep;
            const char* a3 = a2 + kstep; const char* b3 = b2 + kstep;
            PG8_LDB(B0, 0, 0); PG8_LDB(B1, 0, 1); PG8_SCHED; PG8_LDA(At, 0, 0); PG8_STAGE(PG8_SA(1, 1), a1 + hstepA, voffA);
            PG8_WAIT_V(8); PG8_WAIT_L(0); PG8_BAR; PG8_MMA(0, 0, At, B0); PG8_MMA(0, 1, At, B1); PG8_BAR; PG8_SCHED;
            PG8_LDA(At, 0, 1); PG8_STAGE(PG8_SB(0, 0), b2, voffB); PG8_STAGE(PG8_SB(0, 1), b2 + hstepB, voffB); PG8_STAGE(PG8_SA(0, 0), a2, voffA);
            PG8_WAIT_V(8); PG8_WAIT_L(0); PG8_BAR; PG8_MMA(1, 0, At, B0); PG8_MMA(1, 1, At, B1); PG8_BAR; PG8_SCHED;
            PG8_LDB(B0, 1, 0); PG8_LDB(B1, 1, 1); PG8_SCHED; PG8_LDA(At, 1, 0); PG8_STAGE(PG8_SA(0, 1), a2 + hstepA, voffA);
            PG8_WAIT_V(8); PG8_WAIT_L(0); PG8_BAR; PG8_MMA(0, 0, At, B0); PG8_MMA(0, 1, At, B1); PG8_BAR; PG8_SCHED;
            PG8_LDA(At, 1, 1); PG8_STAGE(PG8_SB(1, 0), b3, voffB); PG8_STAGE(PG8_SB(1, 1), b3 + hstepB, voffB); PG8_STAGE(PG8_SA(1, 0), a3, voffA);
            PG8_WAIT_V(8); PG8_WAIT_L(0); PG8_BAR; PG8_MMA(1, 0, At, B0); PG8_MMA(1, 1, At, B1); PG8_BAR; PG8_SCHED;
        }
        if (F8) asm volatile("s_nop 15\n\ts_nop 15" ::: "memory");
        if (wr == 0) PG8_BAR;
        E(acc, cur, wr, wc, fr, fq);
        if (!has_next) break;
        if (!E.keep(cur)) {
#pragma unroll
        for (int a = 0; a < 2; ++a)
#pragma unroll
            for (int b = 0; b < 2; ++b)
#pragma unroll
                for (int m = 0; m < 4; ++m)
#pragma unroll
                    for (int n = 0; n < 2; ++n) acc[a][b][m][n] = (f32x4){0.f, 0.f, 0.f, 0.f};
        }
        cur = nxt; cA = nA; cB = nB; ++ui;
        if (wr == 1) PG8_BAR;
    }
    PG8_WAIT_V(0);
    PG8_BAR;
#undef PG8_SA
#undef PG8_SB
#undef PG8_STAGE
#undef PG8_LDA
#undef PG8_LDB
#undef PG8_MMA
#undef PG8_F8CAT
#undef PG8_WAIT_V
#undef PG8_WAIT_L
#undef PG8_BAR
#undef PG8_SCHED
}

__device__ __forceinline__ float row_rstd(const float* ssq, int row, int fq) {
    const f32x4 s4 = *(const f32x4*)(ssq + (size_t)row * 16 + 4 * fq);
    float s = (s4[0] + s4[1]) + (s4[2] + s4[3]);
    s += __shfl_xor(s, 16); s += __shfl_xor(s, 32);
    return 1.0f / sqrtf(s * (1.0f / 1024.0f) + NORM_EPS);
}
__device__ __forceinline__ void store8(bf16_t* p, const f32x4 a, const f32x4 b) {
    u32x4 w; w.x = cvtpk(a[0], a[1]); w.y = cvtpk(a[2], a[3]); w.z = cvtpk(b[0], b[1]); w.w = cvtpk(b[2], b[3]); *(u32x4*)p = w;
}

struct EpiProj {
    const LAS float* rtab; bf16_t *Qa, *Ka, *Va, *Qb, *Kb, *Vb, *Gt; float* kmp;
    __device__ __forceinline__ bool keep(const Unit&) const { return false; }
    __device__ __forceinline__ void operator()(f32x4 (&acc)[2][2][4][2], const Unit& u, int wr, int wc, int fr, int fq) const {
        const int pn = u.pn, row0 = u.pm * BM + wr * 64 + fr;
        int mode; bf16_t* dst; int ld, col0; const LAS float* w = rtab + 256; int kmhead = -1;
        if (pn < 2) { mode = 0; dst = Qa; ld = 512; col0 = (4 * pn + wc) * 64; }
        else if (pn < 4) { mode = 0; dst = Ka; ld = 512; col0 = (4 * (pn - 2) + wc) * 64; w += 64; kmhead = 4 * (pn - 2) + wc; }
        else if (pn < 6) { mode = 1; dst = Va; ld = 512; col0 = (4 * (pn - 4) + wc) * 64; }
        else if (pn < 8) { mode = 0; dst = Qb; ld = 512; col0 = (4 * (pn - 6) + wc) * 64; w += 128; }
        else if (pn == 8) { if (wc < 2) { mode = 0; dst = Kb; ld = 128; col0 = wc * 64; w += 192; } else { mode = 1; dst = Vb; ld = 128; col0 = (wc - 2) * 64; } }
        else { mode = 2; dst = Gt; ld = 2048; col0 = (pn - 9) * 128 + 32 * wc; }
        f32x4 cw[2][2];
#pragma unroll
        for (int bj = 0; bj < 2; ++bj)
#pragma unroll
            for (int n = 0; n < 2; ++n) {
                if (mode == 0) cw[bj][n] = *(const LAS f32x4*)(w + 32 * bj + 8 * fq + 4 * n);
                else if (mode == 2) cw[bj][n] = *(const LAS f32x4*)(rtab + 512 + 1024 * bj + col0 + 8 * fq + 4 * n);
                else cw[bj][n] = (f32x4){1.f, 1.f, 1.f, 1.f};
            }
        f32x4 ks[2][2];
#pragma unroll
        for (int bj = 0; bj < 2; ++bj)
#pragma unroll
            for (int n = 0; n < 2; ++n) ks[bj][n] = (f32x4){0.f, 0.f, 0.f, 0.f};
#pragma unroll
        for (int ai = 0; ai < 2; ++ai)
#pragma unroll
            for (int m = 0; m < 4; ++m) {
                const int row = row0 + ai * HALF + m * 16;
                const float rs = rtab[ai * HALF + wr * 64 + m * 16 + fr];
                f32x4 v[2][2];
#pragma unroll
                for (int bj = 0; bj < 2; ++bj)
#pragma unroll
                    for (int n = 0; n < 2; ++n) v[bj][n] = acc[ai][bj][m][n] * rs;
                if (mode == 0) {
                    float ss = 0.f;
#pragma unroll
                    for (int bj = 0; bj < 2; ++bj)
#pragma unroll
                        for (int n = 0; n < 2; ++n) { const f32x4 x = v[bj][n]; ss += (x[0] * x[0] + x[1] * x[1]) + (x[2] * x[2] + x[3] * x[3]); }
                    ss += __shfl_xor(ss, 16); ss += __shfl_xor(ss, 32);
                    const float inv = 1.0f / sqrtf(ss * (1.0f / 64.0f) + NORM_EPS);
#pragma unroll
                    for (int bj = 0; bj < 2; ++bj)
#pragma unroll
                        for (int n = 0; n < 2; ++n) { v[bj][n] = v[bj][n] * inv * cw[bj][n]; ks[bj][n] += v[bj][n]; }
                } else if (mode == 2) {
#pragma unroll
                    for (int n = 0; n < 2; ++n) { f32x4 xa = v[0][n] + cw[0][n], xg = v[1][n] + cw[1][n];
#pragma unroll
                        for (int e = 0; e < 4; ++e) { const float da = 1.0f + __builtin_amdgcn_exp2f(-LOG2E * xa[e]), db = fminf(1.0f + __builtin_amdgcn_exp2f(-LOG2E * xg[e]), 1e20f);
                            xg[e] = __builtin_amdgcn_rcpf(db); xa[e] = db * __builtin_amdgcn_rcpf(da); }
                        v[0][n] = xa; v[1][n] = xg; }
                }
                bf16_t* rp = dst + (size_t)row * ld + col0 + 8 * fq;
                if (mode == 2) {
                    constexpr float cG = F8_SM / (F8_SW2 * F8_SY);
                    store8(rp, v[0][0], v[0][1]); store8(rp + 1024, v[1][0] * cG, v[1][1] * cG);
                } else { store8(rp, v[0][0], v[0][1]); store8(rp + 32, v[1][0], v[1][1]); }
            }
        if (kmhead >= 0) {
#pragma unroll
            for (int bj = 0; bj < 2; ++bj)
#pragma unroll
                for (int n = 0; n < 2; ++n) { f32x4 x = ks[bj][n];
#pragma unroll
                    for (int o = 1; o < 16; o <<= 1) { x[0] += __shfl_xor(x[0], o); x[1] += __shfl_xor(x[1], o); x[2] += __shfl_xor(x[2], o); x[3] += __shfl_xor(x[3], o); }
                    if (fr == 0) *(f32x4*)(kmp + ((size_t)(kmhead * 64 + u.pm) * 2 + wr) * 64 + 32 * bj + 8 * fq + 4 * n) = x; }
        }
    }
};

struct EpiMerge {
    const bf16_t* Gt; unsigned char* out;
    __device__ __forceinline__ bool keep(const Unit& u) const { return u.part == 0; }
    __device__ __forceinline__ void operator()(f32x4 (&acc)[2][2][4][2], const Unit& u, int wr, int wc, int fr, int fq) const {
        const int row0 = u.pm * BM + wr * 64 + fr, colb = u.pn * BM + wc * 32 + 8 * fq;
        const bf16_t* gp = Gt + (u.part == 0 ? 0 : 1024);
        u32x4 gw[2][4][2];
#pragma unroll
        for (int ai = 0; ai < 2; ++ai)
#pragma unroll
            for (int m = 0; m < 4; ++m)
#pragma unroll
                for (int bj = 0; bj < 2; ++bj) gw[ai][m][bj] = __builtin_nontemporal_load((const u32x4*)(gp + (size_t)(row0 + ai * HALF + m * 16) * 2048 + colb + bj * HALF));
#pragma unroll
        for (int ai = 0; ai < 2; ++ai)
#pragma unroll
            for (int m = 0; m < 4; ++m) {
                const int row = row0 + ai * HALF + m * 16;
#pragma unroll
                for (int bj = 0; bj < 2; ++bj) {
                    const int col = colb + bj * HALF; const u32x4 w = gw[ai][m][bj];
                    const f32x4 g0 = (f32x4){bf_lo(w.x), bf_hi(w.x), bf_lo(w.y), bf_hi(w.y)}, g1 = (f32x4){bf_lo(w.z), bf_hi(w.z), bf_lo(w.w), bf_hi(w.w)};
                    acc[ai][bj][m][0] *= g0; acc[ai][bj][m][1] *= g1;
                    if (u.part != 0) { const f32x4 a0 = acc[ai][bj][m][0], a1 = acc[ai][bj][m][1]; u32x2 w8; w8.x = pk4f8(a0[0], a0[1], a0[2], a0[3]); w8.y = pk4f8(a1[0], a1[1], a1[2], a1[3]); if (F8_G3) *(u32x2*)(out + (size_t)row * 1024 + col) = w8; else store8((bf16_t*)out + (size_t)row * 1024 + col, a0, a1); }
                }
            }
    }
};

struct EpiResid {
    bf16_t* xb; float* ssq; float* outf; float cs; unsigned char* x8;
    __device__ __forceinline__ bool keep(const Unit&) const { return false; }
    __device__ __forceinline__ void operator()(f32x4 (&acc)[2][2][4][2], const Unit& u, int wr, int wc, int fr, int fq) const {
        const int row0 = u.pm * BM + wr * 64 + fr, colb = u.pn * BM + wc * 32 + 8 * fq;
        u32x4 xw[2][4][2];
#pragma unroll
        for (int ai = 0; ai < 2; ++ai)
#pragma unroll
            for (int m = 0; m < 4; ++m)
#pragma unroll
                for (int bj = 0; bj < 2; ++bj) xw[ai][m][bj] = *(const u32x4*)(xb + (size_t)(row0 + ai * HALF + m * 16) * 1024 + colb + bj * HALF);
#pragma unroll
        for (int ai = 0; ai < 2; ++ai)
#pragma unroll
            for (int m = 0; m < 4; ++m) {
                const int row = row0 + ai * HALF + m * 16; float ss = 0.f;
#pragma unroll
                for (int bj = 0; bj < 2; ++bj) {
                    const size_t off = (size_t)row * 1024 + colb + bj * HALF;
                    const u32x4 w = xw[ai][m][bj];
                    const f32x4 x0 = (f32x4){bf_lo(w.x), bf_hi(w.x), bf_lo(w.y), bf_hi(w.y)} + acc[ai][bj][m][0] * cs, x1 = (f32x4){bf_lo(w.z), bf_hi(w.z), bf_lo(w.w), bf_hi(w.w)} + acc[ai][bj][m][1] * cs;
                    if (outf) { __builtin_nontemporal_store(x0, (f32x4*)(outf + off)); __builtin_nontemporal_store(x1, (f32x4*)(outf + off + 4)); }
                    else { store8(xb + off, x0, x1);
                        if (x8) { u32x2 w8; w8.x = pk4f8(x0[0], x0[1], x0[2], x0[3]); w8.y = pk4f8(x1[0], x1[1], x1[2], x1[3]); *(u32x2*)(x8 + off) = w8; }
                        ss += (x0[0] * x0[0] + x0[1] * x0[1]) + (x0[2] * x0[2] + x0[3] * x0[3]) + (x1[0] * x1[0] + x1[1] * x1[1]) + (x1[2] * x1[2] + x1[3] * x1[3]); }
                }
                if (!outf) { ss += __shfl_xor(ss, 16); ss += __shfl_xor(ss, 32);
                    if (fq == 0) ssq[(size_t)row * 16 + 4 * u.pn + wc] = ss; }
            }
    }
};

struct EpiFfnUp {
    const LAS float* rtab; bf16_t* U;
    __device__ __forceinline__ bool keep(const Unit&) const { return false; }
    __device__ __forceinline__ void operator()(f32x4 (&acc)[2][2][4][2], const Unit& u, int wr, int wc, int fr, int fq) const {
        const int row0 = u.pm * BM + wr * 64 + fr, colb = u.pn * BM + wc * 32 + 8 * fq;
#pragma unroll
        for (int ai = 0; ai < 2; ++ai)
#pragma unroll
            for (int m = 0; m < 4; ++m) {
                const int row = row0 + ai * HALF + m * 16;
                const float rs = rtab[ai * HALF + wr * 64 + m * 16 + fr];
#pragma unroll
                for (int bj = 0; bj < 2; ++bj) {
                    f32x4 a, b;
#pragma unroll
                    for (int e = 0; e < 4; ++e) { const float t0 = fmaxf(acc[ai][bj][m][0][e], 0.f) * rs, t1 = fmaxf(acc[ai][bj][m][1][e], 0.f) * rs; a[e] = t0 * t0; b[e] = t1 * t1; }
                    store8(U + (size_t)row * FF + colb + bj * HALF, a, b);
                }
            }
    }
};
}

namespace att {
__device__ __forceinline__ int crow(int r, int hi) { return (r & 3) + 8 * (r >> 2) + 4 * hi; }
__device__ __forceinline__ bf16x8 vtr2(const LAS char* p) {
    const v4i16_t lo = __builtin_amdgcn_ds_read_tr16_b64_v4i16((LAS v4i16_t*)p), hi = __builtin_amdgcn_ds_read_tr16_b64_v4i16((LAS v4i16_t*)(p + 512));
    return (bf16x8){lo[0], lo[1], lo[2], lo[3], hi[0], hi[1], hi[2], hi[3]};
}
__device__ __forceinline__ int kswz(int row, int chunk) { return chunk * 1024 + ((row & ~7) | ((row ^ chunk) & 7)) * 16; }
__device__ __forceinline__ void load_kv(LAS unsigned char* lds, const bf16_t* Kg, const bf16_t* Vg, int pitch, int row0, int tid) {
    const int lane = tid & 63, w = tid >> 6;
#pragma unroll
    for (int t = 0; t < 4; ++t) {
        const int kr = w * 8 + (lane >> 3), kc = lane & 7, gk = row0 + 64 * t + kr;
        u32x4 kv = (u32x4){0u, 0u, 0u, 0u};
        if (gk >= 0) kv = *(const u32x4*)(Kg + (size_t)gk * pitch + kc * 8);
        *(LAS u32x4*)(lds + L_K + t * 8192 + kswz(kr, kc)) = kv;
        const int gv = row0 + 64 * t + 16 * (w & 3) + (lane >> 2);
        u32x4 vv = (u32x4){0u, 0u, 0u, 0u};
        if (gv >= 0) vv = *(const u32x4*)(Vg + (size_t)gv * pitch + (w >> 2) * 32 + (lane & 3) * 8);
        *(LAS u32x4*)(lds + L_V + t * 8192 + w * 1024 + lane * 16) = vv;
    }
}
__device__ __forceinline__ void load_q(bf16x8 (&qr)[4], const bf16_t* qrow, int hi) {
#pragma unroll
    for (int d0 = 0; d0 < 4; ++d0) qr[d0] = *(const bf16x8*)(qrow + d0 * 16 + hi * 8);
}
__device__ __forceinline__ void qkt(f32x16& p0, f32x16& p1, const LAS unsigned char* Kt, const bf16x8 (&qr)[4], int r32, int hi) {
#pragma unroll
    for (int d0 = 0; d0 < 4; ++d0) {
        const LAS unsigned char* kb = Kt + kswz(r32, 2 * d0 + hi);
        const bf16x8 b0 = *(const LAS bf16x8*)(kb);
        const bf16x8 b1 = *(const LAS bf16x8*)(kb + 512);
        p0 = __builtin_amdgcn_mfma_f32_32x32x16_bf16(b0, qr[d0], p0, 0, 0, 0);
        p1 = __builtin_amdgcn_mfma_f32_32x32x16_bf16(b1, qr[d0], p1, 0, 0, 0);
    }
}
struct LutLane { const LAS float* lutp; int amax; };
__device__ __forceinline__ LutLane lut_lane(const LAS float* lut4, int cstride, int nmax, int dlane) {
    const int k = (dlane - 3 + LUTPAD) & 3; LutLane L; L.lutp = lut4 + k * cstride - k; L.amax = ((nmax - 4 - k) & ~3) + k; return L;
}
template <bool LUTB, bool MASKED>
__device__ __forceinline__ void tile(f32x16 (&o)[2], float& lsum, const bf16x8 (&qr)[4], const LAS unsigned char* Kt, const LAS unsigned char* Vt,
                                     float cbias, const LutLane L, int dbase, unsigned dmax, int r32, int hi, int lane, const bool domask = true) {
    f32x16 p0, p1;
    const int db = dbase - 4 * hi;
    if (LUTB) {
#pragma unroll
        for (int gq = 0; gq < 4; ++gq) {
            int a0 = db - 3 - 8 * gq + LUTPAD, a1 = a0 - 32; a0 = a0 < L.amax ? a0 : L.amax; a1 = a1 < L.amax ? a1 : L.amax;
            const f32x4 x0 = *(const LAS f32x4*)(L.lutp + a0), x1 = *(const LAS f32x4*)(L.lutp + a1);
#pragma unroll
            for (int i = 0; i < 4; ++i) { p0[4 * gq + i] = x0[3 - i]; p1[4 * gq + i] = x1[3 - i]; }
        }
    } else {
#pragma unroll
        for (int r = 0; r < 16; ++r) { p0[r] = cbias; p1[r] = cbias; }
    }
    qkt(p0, p1, Kt, qr, r32, hi);
    if (MASKED && domask) {
#pragma unroll
        for (int r = 0; r < 16; ++r) { const int c = (r & 3) + 8 * (r >> 2);
            if ((unsigned)(db - c) > dmax) p0[r] = -INFINITY;
            if ((unsigned)(db - 32 - c) > dmax) p1[r] = -INFINITY; }
    }
    float s = 0.f;
#pragma unroll
    for (int r = 0; r < 16; ++r) { p0[r] = __builtin_amdgcn_exp2f(p0[r]); p1[r] = __builtin_amdgcn_exp2f(p1[r]); s += p0[r] + p1[r]; }
    lsum += s;
    u32x4 pw[4];
#pragma unroll
    for (int k = 0; k < 4; ++k) { pw[0][k] = cvtpk(p0[2 * k], p0[2 * k + 1]); pw[1][k] = cvtpk(p0[8 + 2 * k], p0[9 + 2 * k]); pw[2][k] = cvtpk(p1[2 * k], p1[2 * k + 1]); pw[3][k] = cvtpk(p1[8 + 2 * k], p1[9 + 2 * k]); }
    const LAS char* vp = (const LAS char*)Vt + ((lane >> 4) & 1) * 32 + (lane & 3) * 8 + (4 * hi + ((lane & 15) >> 2)) * 64;
#pragma unroll
    for (int d0 = 0; d0 < 2; ++d0)
#pragma unroll
        for (int ks = 0; ks < 4; ++ks) {
            const bf16x8 vf = vtr2(vp + d0 * 4096 + ks * 1024);
            o[d0] = __builtin_amdgcn_mfma_f32_32x32x16_bf16(__builtin_bit_cast(bf16x8, pw[ks]), vf, o[d0], 0, 0, 0);
        }
}
__device__ __forceinline__ void lut4_put(LAS float* lut4, int cstride, int ix, float v) {
#pragma unroll
    for (int k = 0; k < 4; ++k) if (ix - k >= 0) lut4[k * cstride + ix - k] = v;
}
__device__ __forceinline__ void stage_o(LAS bf16_t* stg, const f32x16 (&o)[2], int r32, int hi) {
#pragma unroll
    for (int r = 0; r < 16; r += 2) { const int orow0 = crow(r, hi), orow1 = crow(r + 1, hi);
#pragma unroll
        for (int d0 = 0; d0 < 2; ++d0) { const unsigned w = cvtpk(o[d0][r], o[d0][r + 1]); stg[orow0 * 64 + d0 * 32 + r32] = (bf16_t)(w & 0xffffu); stg[orow1 * 64 + d0 * 32 + r32] = (bf16_t)(w >> 16); } }
}
__device__ __forceinline__ void unpack8(float (&f)[8], const u32x4 w) { f[0] = bf_lo(w.x); f[1] = bf_hi(w.x); f[2] = bf_lo(w.y); f[3] = bf_hi(w.y); f[4] = bf_lo(w.z); f[5] = bf_hi(w.z); f[6] = bf_lo(w.w); f[7] = bf_hi(w.w); }
__device__ __forceinline__ u32x2 pack8f8(const float (&f)[8]) { u32x2 w; w.x = pk4f8(f[0], f[1], f[2], f[3]); w.y = pk4f8(f[4], f[5], f[6], f[7]); return w; }
__device__ __forceinline__ u32x4 pack8(const float (&f)[8]) { u32x4 w; w.x = cvtpk(f[0], f[1]); w.y = cvtpk(f[2], f[3]); w.z = cvtpk(f[4], f[5]); w.w = cvtpk(f[6], f[7]); return w; }
}

typedef GAS unsigned gu32;
#define RLX_AGENT __ATOMIC_RELAXED, __HIP_MEMORY_SCOPE_AGENT
#define LDS_WAIT() asm volatile("s_waitcnt lgkmcnt(0)" ::: "memory")
#define VM_WAIT() asm volatile("s_waitcnt vmcnt(0)" ::: "memory")
#define XB_TMO      128
#define XB_XCNT(j)  (256  + 64 * (j))
#define XB_XSUB(j)  (1280 + 64 * (j))
#define XB_XGEN(j)  (2304 + 64 * (j))
#define XB_TOP      3328
#define XB_TOPGEN   3392
#define XCD_BAR_WORDS 3456
#define XB_SPIN_CAP (1u << 22)
__device__ __forceinline__ unsigned xb_ld(unsigned* p)              { return __hip_atomic_load(p, __ATOMIC_RELAXED, __HIP_MEMORY_SCOPE_AGENT); }
__device__ __forceinline__ unsigned xb_add(unsigned* p, unsigned v) { return __hip_atomic_fetch_add(p, v, __ATOMIC_RELAXED, __HIP_MEMORY_SCOPE_AGENT); }
__device__ __forceinline__ unsigned xb_xcc_id() { return (unsigned)__builtin_amdgcn_s_getreg((3 << 11) | 20) & 0xFu; }
#define XB_SPIN(cond, bar) do { unsigned _sp = 0; while (cond) { __builtin_amdgcn_s_sleep(1); \
    if ((++_sp & 255u) == 0u) { if (xb_ld(&(bar)[XB_TMO])) break; if (_sp > XB_SPIN_CAP) { atomicAdd(&(bar)[XB_TMO], 1u); break; } } } } while (0)
struct XcdBarrier { unsigned* bar; unsigned x; volatile LAS unsigned* st; };
__device__ __forceinline__ XcdBarrier xcd_barrier_post(unsigned* bar, volatile LAS unsigned* st) {
    XcdBarrier b; b.bar = bar; b.x = xb_xcc_id(); b.st = st;
    if (threadIdx.x == 0) (void)xb_add(&bar[XB_XCNT(b.x)], 1u);
    return b;
}
__device__ __forceinline__ void xcd_barrier_complete(unsigned* bar, unsigned x, unsigned& nloc, unsigned& nx) {
    const unsigned G = gridDim.x * gridDim.y * gridDim.z;
    unsigned sum, cnt, mine, sp = 0u;
    for (;;) {
        sum = 0u; cnt = 0u; mine = 0u;
#pragma unroll
        for (unsigned j = 0; j < 16; ++j) { const unsigned c = xb_ld(&bar[XB_XCNT(j)]); sum += c; cnt += (c > 0u) ? 1u : 0u; mine = (j == x) ? c : mine; }
        if (sum == G) break;
        __builtin_amdgcn_s_sleep(1);
        if ((++sp & 255u) == 0u) { if (xb_ld(&bar[XB_TMO])) break; if (sp > XB_SPIN_CAP) { atomicAdd(&bar[XB_TMO], 1u); break; } }
    }
    nloc = mine > 0u ? mine : 1u; nx = cnt > 0u ? cnt : 1u;
}
__device__ __forceinline__ void xcd_barrier(const XcdBarrier& b) {
    asm volatile("s_waitcnt vmcnt(0)" ::: "memory");
    __syncthreads();
    if (threadIdx.x == 0) {
        unsigned* bar = b.bar;
        __builtin_amdgcn_s_waitcnt(0);
        unsigned nloc = b.st[0], nx = b.st[1];
        if (nloc == 0u) { xcd_barrier_complete(bar, b.x, nloc, nx); b.st[0] = nloc; b.st[1] = nx; }
        const unsigned old = xb_add(&bar[XB_XSUB(b.x)], 1u);
        const unsigned gen = old / nloc;
        if (old + 1u == (gen + 1u) * nloc) {
            __builtin_amdgcn_fence(__ATOMIC_RELEASE, "agent");
            asm volatile("s_waitcnt vmcnt(0)" ::: "memory");
            const unsigned og = xb_add(&bar[XB_TOP], 1u);
            const unsigned tg = og / nx;
            if (og + 1u == (tg + 1u) * nx) xb_add(&bar[XB_TOPGEN], 1u);
            else XB_SPIN(xb_ld(&bar[XB_TOPGEN]) == tg, bar);
            __builtin_amdgcn_fence(__ATOMIC_ACQUIRE, "agent");
            xb_add(&bar[XB_XGEN(b.x)], 1u);
            asm volatile("s_waitcnt vmcnt(0)" ::: "memory");
        } else {
            XB_SPIN(xb_ld(&bar[XB_XGEN(b.x)]) == gen, bar);
            __builtin_amdgcn_fence(__ATOMIC_ACQUIRE, "agent");
            asm volatile("s_waitcnt vmcnt(0)" ::: "memory");
        }
    }
    __syncthreads();
}

__device__ __forceinline__ void rstd_table(LAS float* rtab, const float* ssq, int pm, const float scale) {
    const int tid = threadIdx.x;
    if (tid < 256) { const f32x4* p = (const f32x4*)(ssq + (size_t)(pm * 256 + tid) * 16); const f32x4 a = p[0], b = p[1], c = p[2], d = p[3];
        const float s = ((a[0] + a[1]) + (a[2] + a[3])) + ((b[0] + b[1]) + (b[2] + b[3])) + ((c[0] + c[1]) + (c[2] + c[3])) + ((d[0] + d[1]) + (d[2] + d[3]));
        rtab[tid] = scale / sqrtf(s * (1.0f / 1024.0f) + NORM_EPS); }
    __syncthreads();
}
__device__ __forceinline__ void proj_consts(LAS float* tab, const float* qna, const float* kna, const float* qnb, const float* knb, const float* bgate) {
    const int tid = threadIdx.x;
    if (tid < 256) { const int k = tid >> 6, i = tid & 63; tab[256 + tid] = (k == 0) ? qna[i] * C2 : (k == 1) ? kna[i] : (k == 2) ? qnb[i] * C2 : knb[i]; }
#pragma unroll
    for (int i = 0; i < 4; ++i) tab[512 + tid + 512 * i] = bgate[tid + 512 * i];
}
struct Args { const float* in[16]; float* out; unsigned char* ws; int ph_lo, ph_hi; };
struct Frame {
    LAS unsigned char* lds;
    int tid, lane, wave, G, vcu;
    unsigned char* ws; float* out;
};

__device__ __forceinline__ float wave_sum(float v) {
#pragma unroll
    for (int o = 1; o < 64; o <<= 1) v += __shfl_xor(v, o);
    return v;
}
__device__ __forceinline__ int rel_bucket(int d) {
    if (d < 16) return d < 0 ? 0 : d;
    int b = 16;
    b += (d >= 22); b += (d >= 30); b += (d >= 40); b += (d >= 54); b += (d >= 73); b += (d >= 99); b += (d >= 134); b += (d >= 182);
    b += (d >= 246); b += (d >= 332); b += (d >= 450); b += (d >= 609); b += (d >= 825); b += (d >= 1117); b += (d >= 1513);
    return b;
}

struct PItem { int type; const float* src; int N; const float* gs; unsigned char* dst; int f8, ldk, kcol, drowA, drowB, m0; };
__device__ __forceinline__ int win_drow(int n0) {
    if (n0 >= 2304) { const int gg = n0 - 2304, isb = gg >= 1024 ? 1 : 0, G0 = gg - 1024 * isb; return (9 + (G0 >> 7)) * 256 + 128 * isb + 32 * ((G0 & 127) >> 5); }
    const int cc = n0 & 255; return (n0 & ~255) + 128 * ((cc >> 5) & 1) + 32 * (cc >> 6);
}
constexpr int PT_LAYER = 16 * 68 + 2 * 8 * 16 + 16 * 16 + 16 * 64 + 64 * 16;
constexpr int PT_X = M / 4;
__device__ __forceinline__ PItem pro_decode(int it, const Args& a, unsigned char* ws, unsigned char* outb) {
    PItem p; p.gs = nullptr; p.m0 = 0; p.ldk = D; p.drowA = 0; p.drowB = 0; p.kcol = 0; p.N = D; p.dst = nullptr; p.src = nullptr; p.f8 = 0;
    if (it >= NLAYER * PT_LAYER) { p.type = 1; p.m0 = (it - NLAYER * PT_LAYER) * 4; p.src = a.in[0] + (size_t)p.m0 * D; return p; }
    p.type = 0;
    const int l = it / PT_LAYER; int r = it - l * PT_LAYER;
    unsigned char* wb = (l == 0) ? outb + DO_W : ws + WS_W;
    if (r < 16 * 68) { const int kb = r / 68, n0 = (r % 68) * 64, k0 = kb * 64; p.src = a.in[3] + (size_t)l * D * INW + (size_t)k0 * INW + n0; p.N = INW; p.gs = a.in[2] + (size_t)l * D + k0;
        p.dst = wb + OFF_WIN; p.f8 = F8_G1; p.kcol = k0; p.drowA = win_drow(n0); p.drowB = win_drow(n0 + 32); return p; } r -= 16 * 68;
    if (r < 128) { const int kb = r / 16, n0 = (r % 16) * 64, k0 = kb * 64; p.src = a.in[10] + (size_t)l * 512 * D + (size_t)k0 * D + n0; p.dst = wb + OFF_WBR; p.f8 = F8_G2; p.kcol = k0; p.drowA = n0; p.drowB = n0 + 32; return p; } r -= 128;
    if (r < 128) { const int kb = r / 16, n0 = (r % 16) * 64, k0 = kb * 64; p.src = a.in[11] + (size_t)l * 512 * D + (size_t)k0 * D + n0; p.dst = wb + OFF_WBR; p.f8 = F8_G2; p.kcol = 512 + k0; p.drowA = n0; p.drowB = n0 + 32; return p; } r -= 128;
    if (r < 256) { const int kb = r / 16, n0 = (r % 16) * 64, k0 = kb * 64; p.src = a.in[12] + (size_t)l * D * D + (size_t)k0 * D + n0; p.dst = wb + OFF_WOUT; p.f8 = F8_G3; p.kcol = k0; p.drowA = n0; p.drowB = n0 + 32; return p; } r -= 256;
    if (r < 1024) { const int kb = r / 64, n0 = (r % 64) * 64, k0 = kb * 64; p.src = a.in[14] + (size_t)l * D * FF + (size_t)k0 * FF + n0; p.N = FF; p.gs = a.in[13] + (size_t)l * D + k0;
        p.dst = wb + OFF_W1; p.kcol = k0; p.drowA = n0; p.drowB = n0 + 32; return p; } r -= 1024;
    { const int kb = r / 16, n0 = (r % 16) * 64, k0 = kb * 64; p.src = a.in[15] + (size_t)l * FF * D + (size_t)k0 * D + n0; p.dst = wb + OFF_W2; p.ldk = FF; p.kcol = k0; p.drowA = n0; p.drowB = n0 + 32; }
    return p;
}
__device__ __forceinline__ void pro_load(f32x4 (&v)[16], const PItem& p, int lane) {
    if (p.type == 0) { const float* s = p.src + (size_t)(lane >> 4) * p.N + (lane & 15) * 4;
#pragma unroll
        for (int i = 0; i < 16; ++i) v[i] = __builtin_nontemporal_load((const f32x4*)(s + (size_t)(4 * i) * p.N));
    } else { const float* s = p.src + lane * 4;
#pragma unroll
        for (int i = 0; i < 16; ++i) v[i] = __builtin_nontemporal_load((const f32x4*)(s + (i >> 2) * D + (i & 3) * 256));
    }
}
__device__ __forceinline__ void pro_process(const f32x4 (&v)[16], const PItem& p, LAS float* scr, int lane, unsigned char* ws, unsigned char* x8) {
    if (p.type == 0) {
        const int c = lane & 7, nl = lane >> 3;
        f32x4 g0 = (f32x4){1.f, 1.f, 1.f, 1.f}, g1 = g0;
        if (p.gs) { g0 = *(const f32x4*)(p.gs + 8 * c); g1 = *(const f32x4*)(p.gs + 8 * c + 4); }
        if (p.f8) { g0 = g0 * F8_SW; g1 = g1 * F8_SW; }
#pragma unroll
        for (int i = 0; i < 16; ++i) { LAS float* w = scr + (4 * i + (lane >> 4)) * 65 + (lane & 15) * 4; w[0] = v[i][0]; w[1] = v[i][1]; w[2] = v[i][2]; w[3] = v[i][3]; }
        LDS_WAIT(); asm volatile("" ::: "memory");
#pragma unroll
        for (int j = 0; j < 8; ++j) { const int n = nl + 8 * j; const LAS float* s = scr + (8 * c) * 65 + n;
            const float t0 = s[0 * 65] * g0[0], t1 = s[1 * 65] * g0[1], t2 = s[2 * 65] * g0[2], t3 = s[3 * 65] * g0[3], t4 = s[4 * 65] * g1[0], t5 = s[5 * 65] * g1[1], t6 = s[6 * 65] * g1[2], t7 = s[7 * 65] * g1[3];
            const int drow = (j < 4) ? p.drowA + n : p.drowB + n - 32;
            const size_t eo = (size_t)drow * p.ldk + p.kcol + 8 * c;
            if (p.f8) { u32x2 o; o.x = pk4f8(t0, t1, t2, t3); o.y = pk4f8(t4, t5, t6, t7); *(u32x2*)(p.dst + eo) = o; }
            else { u32x4 o; o.x = cvtpk(t0, t1); o.y = cvtpk(t2, t3); o.z = cvtpk(t4, t5); o.w = cvtpk(t6, t7); *(u32x4*)(p.dst + eo * 2) = o; } }
        LDS_WAIT(); asm volatile("" ::: "memory");
    } else {
        bf16_t* xb = (bf16_t*)(ws + WS_XB); float* ssq = (float*)(ws + WS_SSQ);
#pragma unroll
        for (int r = 0; r < 4; ++r) { float s = 0.f;
#pragma unroll
            for (int q = 0; q < 4; ++q) { const f32x4 x = v[4 * r + q]; s += (x[0] * x[0] + x[1] * x[1]) + (x[2] * x[2] + x[3] * x[3]); }
            s = wave_sum(s);
            u32x2* o8 = (u32x2*)(xb + (size_t)(p.m0 + r) * D) + lane;
#pragma unroll
            for (int q = 0; q < 4; ++q) { const f32x4 x = v[4 * r + q]; u32x2 w; w.x = cvtpk(x[0], x[1]); w.y = cvtpk(x[2], x[3]); o8[64 * q] = w;
                if (F8_G1) ((unsigned*)(x8 + (size_t)(p.m0 + r) * D))[lane + 64 * q] = pk4f8(x[0], x[1], x[2], x[3]); }
            if (lane < 16) ssq[(size_t)(p.m0 + r) * 16 + lane] = (lane == 0) ? s : 0.f; }
    }
}
__device__ __forceinline__ void phase_prologue(Frame& F, const Args& a) {
    LAS float* scr = (LAS float*)(F.lds + F.wave * 16640);
    const int gw = F.vcu * 8 + F.wave, NGW = F.G * 8;
    unsigned char* ws = F.ws; unsigned char* outb = (unsigned char*)F.out;
    {
        if (gw == 0) { unsigned* cur = (unsigned*)(ws + WS_CUR); for (int i = F.lane; i < NLAYER * 512; i += 64) cur[i] = 0u; }
        const float* rel_bias = a.in[1]; float* lut = (float*)(ws + WS_LUT);
        for (int i = gw * 64 + F.lane; i < 16 * LUTN; i += NGW * 64) { const int hh = i / LUTN, k = i % LUTN, d = k - LUTPAD;
            lut[i] = (d < 0) ? 0.f : rel_bias[rel_bucket(d) * 16 + hh] * LOG2E; }
    }
    constexpr int NTOT = NLAYER * PT_LAYER + PT_X;
    f32x4 va[16], vb[16]; PItem pa, pb;
    int it = gw;
    if (it < NTOT) { pa = pro_decode(it, a, ws, outb); pro_load(va, pa, F.lane); }
    while (it < NTOT) {
        const int i1 = it + NGW; if (i1 < NTOT) { pb = pro_decode(i1, a, ws, outb); pro_load(vb, pb, F.lane); }
        pro_process(va, pa, scr, F.lane, ws, ws + WS_X8);
        if (i1 >= NTOT) break;
        const int i2 = i1 + NGW; if (i2 < NTOT) { pa = pro_decode(i2, a, ws, outb); pro_load(va, pa, F.lane); }
        pro_process(vb, pb, scr, F.lane, ws, ws + WS_X8);
        it = i2;
    }
}

__device__ __forceinline__ void phase_swa_select(Frame& F, const Args& a, int l) {
    using namespace att;
    const bool tailwg = (F.G == 256) && (blockIdx.x < 64);
    if (F.G == 256) {
        unsigned char* ws_ = F.ws; unsigned char* wb_ = (l == 0) ? (unsigned char*)F.out + DO_W : ws_ + WS_W;
        pg8::Gemm g{F8_G1 ? ws_ + WS_X8 : ws_ + WS_XB, wb_ + OFF_WIN, F8_G1 ? D : 2 * D, F8_G1 ? D : 2 * D, F8_G1 ? D : 2 * D, 0}; pg8::StaticOrder S; S.init_single((int)blockIdx.x, 16, tailwg);
        if (tailwg) { proj_consts((LAS float*)(F.lds + L_RSTD), a.in[5] + l * 64, a.in[6] + l * 64, a.in[7] + l * 64, a.in[8] + l * 64, a.in[4] + l * 2048); rstd_table((LAS float*)(F.lds + L_RSTD), (const float*)(ws_ + WS_SSQ), (int)blockIdx.x, F8_G1 ? 1.0f / F8_SW : 1.0f); }
        pg8::EpiProj E{(const LAS float*)(F.lds + L_RSTD), (bf16_t*)(ws_ + WS_QA), (bf16_t*)(ws_ + WS_KA), (bf16_t*)(ws_ + WS_VA), (bf16_t*)(ws_ + WS_QB), (bf16_t*)(ws_ + WS_KB), (bf16_t*)(ws_ + WS_VB), (bf16_t*)(ws_ + WS_GT), (float*)(ws_ + WS_KMP)};
        if (tailwg) pg8::gemm_phase<F8_G1 != 0, pg8::EpiProj>(F.lds, g, S, E);
    }
    unsigned char* ws = F.ws; LAS unsigned char* lds = F.lds;
    const int tid = F.tid, lane = F.lane, wave = F.wave, r32 = lane & 31, hi = lane >> 5;
    const bf16_t* Qb = (const bf16_t*)(ws + WS_QB); const bf16_t* Kb = (const bf16_t*)(ws + WS_KB); const bf16_t* Vb = (const bf16_t*)(ws + WS_VB);
    unsigned char* Y = (unsigned char*)F.out + DO_Y;
    const float* lutg = (const float*)(ws + WS_LUT); const float* sinks = a.in[9] + l * 8;
    LAS float* lut = (LAS float*)(lds + L_LUT); LAS float* wsf = (LAS float*)(lds + L_WSF) + wave * 64; LAS bf16_t* stg = (LAS bf16_t*)(lds + L_OST) + wave * 2048;
    const int bxi = (int)blockIdx.x; const bool swa_split = (F.G == 256);
    for (int ui = 0; ui < 2; ++ui) {
        int unit, gi_lo = 0, gi_hi = 16;
        if (swa_split) { if (tailwg) break;
            if (ui == 0) unit = bxi;
            else if (bxi < 128) { unit = bxi - 64; gi_hi = 8; }
            else if (bxi < 192) { unit = bxi - 128; gi_lo = 8; }
            else break; }
        else { if (ui == 1) break; unit = F.vcu; if (unit >= 256) break; }
        const int kvh = unit >> 7, c = unit & 127;
        bf16x8 qsw[2][4];
#pragma unroll
        for (int k2 = 0; k2 < 2; ++k2) { const int gi_ = gi_lo + wave + 8 * k2; const int gg_ = gi_ < gi_hi ? gi_ : gi_lo + wave;
            load_q(qsw[k2], Qb + (size_t)(128 * c + 32 * (gg_ & 3) + r32) * 512 + (kvh * 4 + (gg_ >> 2)) * 64, hi); }
        __syncthreads();
        load_kv(lds, Kb + kvh * 64, Vb + kvh * 64, 128, 128 * c - 128, tid);
        for (int i = tid; i < 4 * 512; i += 512) lut4_put(lut + (i >> 9) * 2048, 512, i & 511, lutg[(size_t)(8 + kvh * 4 + (i >> 9)) * LUTN + (i & 511)]);
        __syncthreads();
        for (int gi = gi_lo + wave; gi < gi_hi; gi += 8) {
            const int hl = gi >> 2, g = gi & 3, hq = kvh * 4 + hl, q = 128 * c + 32 * g + r32;
            bf16x8 qr[4];
#pragma unroll
            for (int d0 = 0; d0 < 4; ++d0) qr[d0] = (gi - gi_lo - wave) ? qsw[1][d0] : qsw[0][d0];
            f32x16 o[2];
#pragma unroll
            for (int r = 0; r < 16; ++r) { o[0][r] = 0.f; o[1][r] = 0.f; }
            float lsum = 0.f; const unsigned dmax = (unsigned)(q < 127 ? q : 127);
            const int t0 = g < 2 ? 0 : 1; const LutLane LL = lut_lane(lut + hl * 2048, 512, 512, r32 - 4 * hi);
            for (int t = t0; t < t0 + 3; ++t)
                tile<true, true>(o, lsum, qr, lds + L_K + t * 8192, lds + L_V + t * 8192, 0.f, LL, 32 * g + r32 + 128 - 64 * t, dmax, r32, hi, lane, t != t0 + 1 || c == 0);
            lsum += __shfl_xor(lsum, 32);
            lsum += __builtin_amdgcn_exp2f(sinks[hq] * LOG2E);
            if (hi == 0) wsf[r32] = lsum;
            stage_o(stg, o, r32, hi);
            LDS_WAIT(); asm volatile("" ::: "memory");
#pragma unroll
            for (int i = 0; i < 4; ++i) { const int row = i * 8 + (lane >> 3), ch = lane & 7;
                const u32x4 v = *(const LAS u32x4*)(stg + row * 64 + ch * 8); float f[8]; unpack8(f, v);
                const float inv = F8_SY / wsf[row];
#pragma unroll
                for (int e = 0; e < 8; ++e) f[e] *= inv;
                const size_t yo = (size_t)(128 * c + 32 * g + row) * 1024 + 512 + hq * 64 + ch * 8;
                if (F8_G2) *(u32x2*)(Y + yo) = pack8f8(f); else *(u32x4*)(Y + 2 * yo) = pack8(f); }
            LDS_WAIT(); asm volatile("" ::: "memory");
        }
    }
    const bf16_t* Qa = (const bf16_t*)(ws + WS_QA); const float* kmp = (const float*)(ws + WS_KMP);
    unsigned* cursor = (unsigned*)(ws + WS_CUR) + l * 512; unsigned short* lists = (unsigned short*)(ws + WS_LISTS);
    LAS unsigned* hist = (LAS unsigned*)(lds + L_SM); LAS unsigned* lbase = hist + 64;
    int sel0, selstep, selend;
    if (F.G == 256) { const int bx_ = (int)blockIdx.x;
        if (bx_ < 64) { sel0 = bx_; selstep = 512; selend = 64; }
        else if (bx_ < 192) { sel0 = bx_; selstep = 128; selend = 320; }
        else { sel0 = 320 + (bx_ - 192); selstep = 64; selend = 512; } }
    else { sel0 = F.vcu; selstep = F.G; selend = 512; }
    f32x4 kmr[4]; bf16x8 qsel[4];
#define SEL_FETCH(unit_) do { const int h_ = (unit_) >> 6, qb_ = (unit_) & 63; const float* p_ = kmp + ((size_t)(h_ * 64 + (tid >> 3)) * 2) * 64 + (tid & 7) * 8; \
        kmr[0] = *(const f32x4*)(p_); kmr[1] = *(const f32x4*)(p_ + 4); kmr[2] = *(const f32x4*)(p_ + 64); kmr[3] = *(const f32x4*)(p_ + 68); \
        load_q(qsel, Qa + (size_t)(qb_ * 256 + 32 * wave + r32) * 512 + h_ * 64, hi); } while (0)
    if (sel0 < selend) SEL_FETCH(sel0);
    for (int unit = sel0; unit < selend; unit += selstep) {
        const int h = unit >> 6, qb = unit & 63;
        __syncthreads();
        { const int j = tid >> 3, cch = tid & 7;
          float hi8[8], lo8[8];
#pragma unroll
          for (int e = 0; e < 8; ++e) { const float km = (kmr[e >> 2][e & 3] + kmr[2 + (e >> 2)][e & 3]) * (1.0f / 256.0f); const unsigned hb = f2bf(km); const float hf = __builtin_bit_cast(float, hb << 16); hi8[e] = hf; lo8[e] = km - hf; }
          *(LAS u32x4*)(lds + L_K + kswz(j, cch)) = pack8(hi8); *(LAS u32x4*)(lds + L_K + 8192 + kswz(j, cch)) = pack8(lo8); }
        if (tid < 64) hist[tid] = 0u;
        __syncthreads();
        const int q = qb * 256 + 32 * wave + r32;
        int i1 = 255, i2 = 255, i3 = 255;
        {
            bf16x8 qr[4];
#pragma unroll
            for (int d0 = 0; d0 < 4; ++d0) qr[d0] = qsel[d0];
            if (unit + selstep < selend) SEL_FETCH(unit + selstep);
            f32x16 p0, p1;
#pragma unroll
            for (int r = 0; r < 16; ++r) { p0[r] = 0.f; p1[r] = 0.f; }
            qkt(p0, p1, lds + L_K, qr, r32, hi); qkt(p0, p1, lds + L_K + 8192, qr, r32, hi);
            float v1 = -INFINITY, v2 = -INFINITY, v3 = -INFINITY;
#define TOP_INS(v_, i_) do { const float vv = (v_); const int ii = (i_); if (vv > v3) { if (vv > v2) { v3 = v2; i3 = i2; if (vv > v1) { v2 = v1; i2 = i1; v1 = vv; i1 = ii; } else { v2 = vv; i2 = ii; } } else { v3 = vv; i3 = ii; } } } while (0)
#pragma unroll
            for (int r = 0; r < 16; ++r) { const int j0 = crow(r, hi), j1 = 32 + j0;
                TOP_INS(j0 < qb ? p0[r] : -INFINITY, j0); TOP_INS(j1 < qb ? p1[r] : -INFINITY, j1); }
            const float w1 = __shfl_xor(v1, 32), w2 = __shfl_xor(v2, 32), w3 = __shfl_xor(v3, 32);
            const int k1 = __shfl_xor(i1, 32), k2 = __shfl_xor(i2, 32), k3 = __shfl_xor(i3, 32);
            TOP_INS(w1, k1); TOP_INS(w2, k2); TOP_INS(w3, k3);
#undef TOP_INS
            if (hi == 0) {
                if (i1 < 64) __hip_atomic_fetch_add(hist + i1, 1u, __ATOMIC_RELAXED, __HIP_MEMORY_SCOPE_WORKGROUP);
                if (i2 < 64) __hip_atomic_fetch_add(hist + i2, 1u, __ATOMIC_RELAXED, __HIP_MEMORY_SCOPE_WORKGROUP);
                if (i3 < 64) __hip_atomic_fetch_add(hist + i3, 1u, __ATOMIC_RELAXED, __HIP_MEMORY_SCOPE_WORKGROUP);
            }
        }
        __syncthreads();
        if (tid < 64) { const unsigned c = hist[tid]; unsigned bs = 0u; if (c) bs = __hip_atomic_fetch_add(cursor + h * 64 + tid, c, __ATOMIC_RELAXED, __HIP_MEMORY_SCOPE_AGENT); lbase[tid] = bs; hist[tid] = 0u; }
        __syncthreads();
        if (hi == 0) {
            const int pick[3] = {i1, i2, i3};
#pragma unroll
            for (int s = 0; s < 3; ++s) { const int j = pick[s];
                if (j < 64) { const unsigned rk = __hip_atomic_fetch_add(hist + j, 1u, __ATOMIC_RELAXED, __HIP_MEMORY_SCOPE_WORKGROUP);
                    lists[(size_t)h * LIST_HEAD + 256 * (63 * j - (j * (j - 1)) / 2) + lbase[j] + rk] = (unsigned short)(q | (s << 14)); } }
        }
    }
#undef SEL_FETCH
}

__device__ __forceinline__ void phase_moba_past(Frame& F, const Args& a, int l) {
    using namespace att;
    constexpr int PCH = 512;
    unsigned char* ws = F.ws; LAS unsigned char* lds = F.lds;
    const int tid = F.tid, lane = F.lane, wave = F.wave, r32 = lane & 31, hi = lane >> 5;
    const bf16_t* Qa = (const bf16_t*)(ws + WS_QA); const bf16_t* Ka = (const bf16_t*)(ws + WS_KA); const bf16_t* Va = (const bf16_t*)(ws + WS_VA);
    const unsigned* cursor = (const unsigned*)(ws + WS_CUR) + l * 512; const unsigned short* lists = (const unsigned short*)(ws + WS_LISTS);
    bf16_t* Po = (bf16_t*)(ws + WS_PO); float* Pl = (float*)(ws + WS_PL);
    const float* lutg = (const float*)(ws + WS_LUT);
    LAS float* lut = (LAS float*)(lds + L_LUT); LAS bf16_t* stg = (LAS bf16_t*)(lds + L_OST) + wave * 2048;
    LAS unsigned* pfx = (LAS unsigned*)(lds + L_TAB); LAS unsigned* nls = pfx + 512; LAS unsigned* pfs = pfx + 1024;
    LAS unsigned* scan = (LAS unsigned*)(lds + L_SM);
    __syncthreads();
    const int nlist = (int)cursor[tid];
    const int nrem = nlist % PCH, nbig = nlist / PCH + (nrem > PCH / 2 ? 1 : 0), nsml = (nrem > 0 && nrem <= PCH / 2) ? 1 : 0;
    int inc = nbig | (nsml << 16);
#pragma unroll
    for (int o = 1; o < 64; o <<= 1) { const int v = __shfl_up(inc, o); if (lane >= o) inc += v; }
    if (lane == 63) scan[wave] = (unsigned)inc;
    __syncthreads();
    { int base = 0; for (int w = 0; w < wave; ++w) base += (int)scan[w]; const int tot_ = base + inc; pfx[tid] = (unsigned)(tot_ & 0xffff); pfs[tid] = (unsigned)(tot_ >> 16); nls[tid] = (unsigned)nlist; }
    int totb = 0; for (int w = 0; w < 8; ++w) totb += (int)scan[w];
    totb = __builtin_amdgcn_readfirstlane(totb);
    const int nbigtot = totb & 0xffff; const int total = nbigtot + (totb >> 16);
    __syncthreads();
    u32x4 kreg[4], vreg[4]; float lreg[5];
    const int lw = tid >> 6, kr = lw * 8 + (lane >> 3), kc8 = lane & 7;
#define PAST_FETCH(h_, j_) do { \
        const bf16_t* Kg_ = Ka + (h_) * 64 + (size_t)((j_) * 256) * 512; const bf16_t* Vg_ = Va + (h_) * 64 + (size_t)((j_) * 256) * 512; \
        _Pragma("unroll") for (int t = 0; t < 4; ++t) { kreg[t] = *(const u32x4*)(Kg_ + (size_t)(64 * t + kr) * 512 + kc8 * 8); \
            vreg[t] = *(const u32x4*)(Vg_ + (size_t)(64 * t + 16 * (lw & 3) + (lane >> 2)) * 512 + (lw >> 2) * 32 + (lane & 3) * 8); } \
        _Pragma("unroll") for (int i = 0; i < 5; ++i) { const int ix = tid + 512 * i; lreg[i] = lutg[(size_t)(h_) * LUTN + (ix < LUTN ? ix : LUTN - 1)]; } } while (0)
#define PAST_DEC(it_, h_, j_, k_, n_) int h_, j_, k_, n_; { const bool big_ = (it_) < nbigtot; const int iq_ = big_ ? (it_) : (it_) - nbigtot; const LAS unsigned* px_ = big_ ? pfx : pfs; \
        int lo_ = 0, hi_ = 511; while (lo_ < hi_) { const int mid_ = (lo_ + hi_) >> 1; if ((int)px_[mid_] > iq_) hi_ = mid_; else lo_ = mid_ + 1; } \
        h_ = lo_ >> 6; j_ = lo_ & 63; k_ = big_ ? iq_ - (lo_ ? (int)pfx[lo_ - 1] : 0) : (int)nls[lo_] / PCH; n_ = (int)nls[lo_] - PCH * k_; n_ = n_ > PCH ? PCH : n_; \
        h_ = __builtin_amdgcn_readfirstlane(h_); j_ = __builtin_amdgcn_readfirstlane(j_); k_ = __builtin_amdgcn_readfirstlane(k_); n_ = __builtin_amdgcn_readfirstlane(n_); }
#define PAST_LP(h_, j_, k_) (lists + (size_t)(h_) * LIST_HEAD + 256 * (63 * (j_) - ((j_) * ((j_) - 1)) / 2) + (k_) * PCH)
#define WG_BAR() asm volatile("s_waitcnt lgkmcnt(0)\n\ts_barrier" ::: "memory")
    int it = F.vcu;
    unsigned ec0 = 0u, ec1 = 0u; bf16x8 qr_c[4]; int hprev = -1;
#pragma unroll
    for (int d0 = 0; d0 < 4; ++d0) qr_c[d0] = (bf16x8){0, 0, 0, 0, 0, 0, 0, 0};
    int h = 0, j = 0, kc = 0, n = 0;
    if (it < total) { PAST_DEC(it, h0, j0, k0, n0); h = h0; j = j0; kc = k0; n = n0; const int idx0 = wave * 32 + r32; const unsigned short* lp0 = PAST_LP(h0, j0, k0);
        ec0 = lp0[idx0 < n0 ? idx0 : 0]; ec1 = lp0[idx0 + 256 < n0 ? idx0 + 256 : 0]; PAST_FETCH(h0, j0); load_q(qr_c, Qa + (size_t)(ec0 & 0x3fffu) * 512 + h0 * 64, hi); }
    for (; it < total; it += F.G) {
        WG_BAR();
#pragma unroll
        for (int t = 0; t < 4; ++t) { *(LAS u32x4*)(lds + L_K + t * 8192 + kswz(kr, kc8)) = kreg[t]; *(LAS u32x4*)(lds + L_V + t * 8192 + lw * 1024 + lane * 16) = vreg[t]; }
        if (h != hprev) {
#pragma unroll
            for (int i = 0; i < 5; ++i) { const int ix = tid + 512 * i; if (ix < LUTN) lut4_put(lut, LUTN, ix, lreg[i]); }
            hprev = h; }
        WG_BAR();
        const bool hn = it + F.G < total; unsigned en0 = 0u, en1 = 0u; int hnx = 0, jnx = 0, knx = 0, nnx = 0;
        if (hn) { PAST_DEC(it + F.G, h1, j1, k1, n1); const int idx1 = wave * 32 + r32; hnx = h1; jnx = j1; knx = k1; nnx = n1; const unsigned short* lp1 = PAST_LP(h1, j1, k1);
            en0 = lp1[idx1 < n1 ? idx1 : 0]; en1 = lp1[idx1 + 256 < n1 ? idx1 + 256 : 0]; PAST_FETCH(h1, j1); }
        const float cbias = lut[LUTN - 1];
        const bool act1 = (wave + 8) * 32 < n;
#pragma unroll 1
        for (int gi = 0; gi < 2; ++gi) {
            const int g = wave + 8 * gi;
            const bool nx_same = (gi == 0) && act1; const bool nx_any = nx_same || hn;
            const unsigned nx_ent = nx_same ? ec1 : en0; const int nx_h = nx_same ? h : hnx;
            const bf16_t* nx_q = Qa + (size_t)(nx_ent & 0x3fffu) * 512 + nx_h * 64;
            if (g * 32 < n) {
                const unsigned ent_c = gi ? ec1 : ec0;
                const int idx = g * 32 + r32; const bool valid = idx < n;
                const int q = (int)(ent_c & 0x3fffu), s = (int)(ent_c >> 14);
                f32x16 o[2];
#pragma unroll
                for (int r = 0; r < 16; ++r) { o[0][r] = 0.f; o[1][r] = 0.f; }
                float lsum = 0.f;
                const int dfirst = q - j * 256;
                const LutLane LL = lut_lane(lut, LUTN, LUTN, dfirst - 4 * hi);
                bf16x8 qr_n[4];
#pragma unroll
                for (int d0 = 0; d0 < 4; ++d0) qr_n[d0] = qr_c[d0];
                if (__all(dfirst - 255 >= 1513)) {
#pragma unroll 1
                    for (int t = 0; t < 4; ++t) { tile<false, false>(o, lsum, qr_c, lds + L_K + t * 8192, lds + L_V + t * 8192, cbias, LL, dfirst - 64 * t, 0u, r32, hi, lane);
                        if (t == 1 && nx_any) load_q(qr_n, nx_q, hi); }
                } else {
#pragma unroll 1
                    for (int t = 0; t < 4; ++t) { tile<true, false>(o, lsum, qr_c, lds + L_K + t * 8192, lds + L_V + t * 8192, 0.f, LL, dfirst - 64 * t, 0u, r32, hi, lane);
                        if (t == 1 && nx_any) load_q(qr_n, nx_q, hi); }
                }
                lsum += __shfl_xor(lsum, 32);
                if (hi == 0 && valid) Pl[(size_t)(s * 8 + h) * M + q] = lsum;
                stage_o(stg, o, r32, hi);
                LDS_WAIT(); asm volatile("" ::: "memory");
#pragma unroll
                for (int i = 0; i < 4; ++i) { const int row = i * 8 + (lane >> 3), ch = lane & 7;
                    const u32x4 v = *(const LAS u32x4*)(stg + row * 64 + ch * 8);
                    const unsigned en = (unsigned)__shfl((int)ent_c, row);
                    if (g * 32 + row < n) { const int qq = (int)(en & 0x3fffu), ss = (int)(en >> 14);
                        *(u32x4*)(Po + ((size_t)(ss * 8 + h) * M + qq) * 64 + ch * 8) = v; } }
                LDS_WAIT(); asm volatile("" ::: "memory");
#pragma unroll
                for (int d0 = 0; d0 < 4; ++d0) qr_c[d0] = qr_n[d0];
            } else if (gi == 0 && nx_any) load_q(qr_c, nx_q, hi);
        }
        ec0 = en0; ec1 = en1; h = hnx; j = jnx; kc = knx; n = nnx;
    }
#undef WG_BAR
#undef PAST_FETCH
#undef PAST_DEC
#undef PAST_LP
}

__device__ __forceinline__ void phase_moba_own(Frame& F, const Args& a, int l) {
    using namespace att;
    unsigned char* ws = F.ws; LAS unsigned char* lds = F.lds;
    const int tid = F.tid, lane = F.lane, wave = F.wave, r32 = lane & 31, hi = lane >> 5;
    const bf16_t* Qa = (const bf16_t*)(ws + WS_QA); const bf16_t* Ka = (const bf16_t*)(ws + WS_KA); const bf16_t* Va = (const bf16_t*)(ws + WS_VA);
    const bf16_t* Po = (const bf16_t*)(ws + WS_PO); const float* Pl = (const float*)(ws + WS_PL);
    unsigned char* Y = (unsigned char*)F.out + DO_Y;
    const float* lutg = (const float*)(ws + WS_LUT);
    LAS float* lut = (LAS float*)(lds + L_LUT); LAS float* wsf = (LAS float*)(lds + L_WSF) + wave * 64; LAS bf16_t* stg = (LAS bf16_t*)(lds + L_OST) + wave * 2048;
#define WG_BAR() asm volatile("s_waitcnt lgkmcnt(0)\n\ts_barrier" ::: "memory")
    u32x4 kreg[4], vreg[4]; float lreg;
    const int lw = tid >> 6, kr = lw * 8 + (lane >> 3), kc8 = lane & 7;
#define OWN_FETCH(unit_) do { const int h_ = (unit_) >> 6, qb_ = (unit_) & 63; \
        const bf16_t* Kg_ = Ka + h_ * 64 + (size_t)(qb_ * 256) * 512; const bf16_t* Vg_ = Va + h_ * 64 + (size_t)(qb_ * 256) * 512; \
        _Pragma("unroll") for (int t = 0; t < 4; ++t) { kreg[t] = *(const u32x4*)(Kg_ + (size_t)(64 * t + kr) * 512 + kc8 * 8); \
            vreg[t] = *(const u32x4*)(Vg_ + (size_t)(64 * t + 16 * (lw & 3) + (lane >> 2)) * 512 + (lw >> 2) * 32 + (lane & 3) * 8); } \
        lreg = lutg[(size_t)h_ * LUTN + tid]; } while (0)
    int unit = F.vcu;
    if (unit < 512) OWN_FETCH(unit);
    for (; unit < 512; unit += F.G) {
        const int h = unit >> 6, qb = unit & 63, nsl = qb < 3 ? qb : 3;
        const int q = qb * 256 + 32 * wave + r32;
        bf16x8 qr[4]; load_q(qr, Qa + (size_t)q * 512 + h * 64, hi);
        u32x4 pov[4][3]; float plv[4][3];
#pragma unroll
        for (int i = 0; i < 4; ++i) { const int row = i * 8 + (lane >> 3), ch = lane & 7, qq = qb * 256 + 32 * wave + row;
#pragma unroll
            for (int s = 0; s < 3; ++s) { const size_t pi = (size_t)(s * 8 + h) * M + qq;
                if (s < nsl) { plv[i][s] = Pl[pi]; pov[i][s] = __builtin_nontemporal_load((const u32x4*)(Po + pi * 64 + ch * 8)); } else { plv[i][s] = 0.f; pov[i][s] = (u32x4){0u, 0u, 0u, 0u}; } } }
        WG_BAR();
#pragma unroll
        for (int t = 0; t < 4; ++t) { *(LAS u32x4*)(lds + L_K + t * 8192 + kswz(kr, kc8)) = kreg[t]; *(LAS u32x4*)(lds + L_V + t * 8192 + lw * 1024 + lane * 16) = vreg[t]; }
        lut4_put(lut, 512, tid, lreg);
        WG_BAR();
        if (unit + F.G < 512) OWN_FETCH(unit + F.G);
        f32x16 o[2];
#pragma unroll
        for (int r = 0; r < 16; ++r) { o[0][r] = 0.f; o[1][r] = 0.f; }
        float lsum = 0.f; const int nt = (wave >> 1) + 1; const LutLane LL = lut_lane(lut, 512, 512, r32 - 4 * hi);
#pragma unroll 1
        for (int t = 0; t < nt; ++t)
            tile<true, true>(o, lsum, qr, lds + L_K + t * 8192, lds + L_V + t * 8192, 0.f, LL, 32 * wave + r32 - 64 * t, 0x7fffffffu, r32, hi, lane, t == nt - 1);
        lsum += __shfl_xor(lsum, 32);
        if (hi == 0) wsf[r32] = lsum;
        stage_o(stg, o, r32, hi);
        LDS_WAIT(); asm volatile("" ::: "memory");
#pragma unroll
        for (int i = 0; i < 4; ++i) { const int row = i * 8 + (lane >> 3), ch = lane & 7, qq = qb * 256 + 32 * wave + row;
            const u32x4 v = *(const LAS u32x4*)(stg + row * 64 + ch * 8); float f[8]; unpack8(f, v);
            float L = wsf[row];
#pragma unroll
            for (int s = 0; s < 3; ++s) { L += plv[i][s]; float pf[8]; unpack8(pf, pov[i][s]);
#pragma unroll
                for (int e = 0; e < 8; ++e) f[e] += pf[e]; }
            const float inv = F8_SY / L;
#pragma unroll
            for (int e = 0; e < 8; ++e) f[e] *= inv;
            const size_t yo = (size_t)qq * 1024 + h * 64 + ch * 8;
            if (F8_G2) *(u32x2*)(Y + yo) = pack8f8(f); else *(u32x4*)(Y + 2 * yo) = pack8(f); }
        LDS_WAIT(); asm volatile("" ::: "memory");
    }
#undef OWN_FETCH
#undef WG_BAR
}

__global__ void __launch_bounds__(512, 2) fwd_kernel(Args args) {
    extern __shared__ __attribute__((aligned(16))) unsigned char lds_raw[];
    Frame F;
    F.lds = (LAS unsigned char*)lds_raw;
    F.tid = threadIdx.x; F.lane = F.tid & 63; F.wave = __builtin_amdgcn_readfirstlane(F.tid >> 6);
    F.G = gridDim.x; { const int bx = blockIdx.x; F.vcu = (F.G % 8 == 0) ? (bx % 8) * (F.G / 8) + bx / 8 : bx; }
    F.ws = args.ws; F.out = args.out;
    unsigned char* ws = args.ws;
    volatile LAS unsigned* MISC = (volatile LAS unsigned*)(F.lds + MISC_OFF);
    for (int u = F.tid; u < (LDS_BYTES - LDSCTL_OFF) / 4; u += 512) ((LAS unsigned*)(F.lds + LDSCTL_OFF))[u] = 0u;
    __syncthreads();
    XcdBarrier bar; bar.bar = (unsigned*)(ws + WS_CTL) + 4096; bar.x = 0; bar.st = nullptr;
    const bool multi = (args.ph_hi - args.ph_lo) > 1;
    if (multi) bar = xcd_barrier_post((unsigned*)(ws + WS_CTL) + 4096, MISC + 8);

    const int lo = args.ph_lo, hi = args.ph_hi;
    float* ssq = (float*)(ws + WS_SSQ);
#ifndef PH_MASK
#define PH_MASK 0x1ffff
#endif
#define IN(k) (lo <= (k) && (k) < hi && ((PH_MASK >> ((k) > 8 ? (k) - 8 : (k))) & 1))
#define SEAM(k) do { if (IN(k) && IN((k) + 1)) xcd_barrier(bar); } while (0)
#ifndef REP_MASK
#define REP_MASK 0
#endif
#define RUN(p, l, X) do { if (IN(1 + NPH * (l) + (p))) { X; if ((REP_MASK >> (p)) & 1) { xcd_barrier(bar); X; } } SEAM(1 + NPH * (l) + (p)); } while (0)
#define WB(l) ((l) == 0 ? (unsigned char*)args.out + DO_W : ws + WS_W)
#define PH_G1(l) do { \
        pg8::Gemm g{F8_G1 ? ws + WS_X8 : ws + WS_XB, WB(l) + OFF_WIN, F8_G1 ? D : 2 * D, F8_G1 ? D : 2 * D, F8_G1 ? D : 2 * D, 0}; pg8::StaticOrder S; S.init(M, INW - 256, F.G, (int)blockIdx.x, 1); \
        const int pm0_ = S.first_pm(); const LAS float* rt_ = (const LAS float*)(F.lds + L_RSTD); proj_consts((LAS float*)(F.lds + L_RSTD), args.in[5] + (l) * 64, args.in[6] + (l) * 64, args.in[7] + (l) * 64, args.in[8] + (l) * 64, args.in[4] + (l) * 2048); rstd_table((LAS float*)(F.lds + L_RSTD), ssq, pm0_ < 0 ? 0 : pm0_, F8_G1 ? 1.0f / F8_SW : 1.0f); \
        pg8::EpiProj E{rt_, (bf16_t*)(ws + WS_QA), (bf16_t*)(ws + WS_KA), (bf16_t*)(ws + WS_VA), (bf16_t*)(ws + WS_QB), (bf16_t*)(ws + WS_KB), (bf16_t*)(ws + WS_VB), (bf16_t*)(ws + WS_GT), (float*)(ws + WS_KMP)}; \
        pg8::gemm_phase<F8_G1 != 0, pg8::EpiProj>(F.lds, g, S, E); } while (0)
#define PH_G2(l) do { \
        pg8::Gemm g{(unsigned char*)args.out + DO_Y, WB(l) + OFF_WBR, F8_G2 ? D : 2 * D, F8_G2 ? D : 2 * D, F8_G2 ? 512 : 1024, F8_G2 ? 512 : 1024}; pg8::StaticOrder S; S.init(M, D, F.G, (int)blockIdx.x, 2); \
        pg8::EpiMerge E{(const bf16_t*)(ws + WS_GT), ws + WS_MRG}; \
        pg8::gemm_phase<F8_G2 != 0, pg8::EpiMerge>(F.lds, g, S, E); } while (0)
#define PH_G3(l) do { \
        pg8::Gemm g{ws + WS_MRG, WB(l) + OFF_WOUT, F8_G3 ? D : 2 * D, F8_G3 ? D : 2 * D, F8_G3 ? D : 2 * D, 0}; pg8::StaticOrder S; S.init(M, D, F.G, (int)blockIdx.x, 1); \
        pg8::EpiResid E{(bf16_t*)(ws + WS_XB), ssq, nullptr, 1.0f / (F8_SM * F8_SW3), nullptr}; \
        pg8::gemm_phase<F8_G3 != 0, pg8::EpiResid>(F.lds, g, S, E); } while (0)
#define PH_G4(l) do { \
        pg8::Gemm g{ws + WS_XB, WB(l) + OFF_W1, 2 * D, 2 * D, 2 * D, 0}; pg8::StaticOrder S; S.init(M, FF, F.G, (int)blockIdx.x, 1); \
        const int pm0_ = S.first_pm(); const LAS float* rt_ = (const LAS float*)(F.lds + L_RSTD); rstd_table((LAS float*)(F.lds + L_RSTD), ssq, pm0_ < 0 ? 0 : pm0_, 1.0f); \
        pg8::EpiFfnUp E{rt_, (bf16_t*)(ws + WS_U)}; \
        pg8::gemm_phase<false, pg8::EpiFfnUp>(F.lds, g, S, E); } while (0)
#define PH_G5(l) do { \
        pg8::Gemm g{ws + WS_U, WB(l) + OFF_W2, 2 * FF, 2 * FF, 2 * FF, 0}; pg8::StaticOrder S; S.init(M, D, F.G, (int)blockIdx.x, 1); \
        pg8::EpiResid E{(bf16_t*)(ws + WS_XB), ssq, (l) == NLAYER - 1 ? args.out : nullptr, 1.0f, (l) == NLAYER - 1 || !F8_G1 ? nullptr : ws + WS_X8}; \
        pg8::gemm_phase<false, pg8::EpiResid>(F.lds, g, S, E); } while (0)
#define LAYER(l) do { \
    RUN(0, l, PH_G1(l)); \
    RUN(1, l, phase_swa_select(F, args, (l))); \
    RUN(2, l, phase_moba_past(F, args, (l))); \
    RUN(3, l, phase_moba_own(F, args, (l))); \
    RUN(4, l, PH_G2(l)); \
    if (IN(1 + NPH * (l) + 5)) { PH_G3(l); } SEAM(1 + NPH * (l) + 5); \
    RUN(6, l, PH_G4(l)); \
    if (IN(1 + NPH * (l) + 7)) { PH_G5(l); } SEAM(1 + NPH * (l) + 7); \
    } while (0)
    if (IN(0)) { phase_prologue(F, args); } SEAM(0);
    LAYER(0);
    LAYER(1);
#undef LAYER
#undef RUN
#undef WB
#undef SEAM
#undef IN
}

extern "C" void kernel_launch(void* const* d_in, const int* in_sizes, int n_in, void* d_out, int out_size, void* d_ws, size_t ws_size, hipStream_t stream) {
    static int grid = 0;
    if (grid == 0) {
        if (n_in != 16 || out_size != M * D || ws_size < WS_END) { fprintf(stderr, "kernel_launch: unexpected shapes (n_in %d out %d ws %zu)\n", n_in, out_size, ws_size); grid = -1; return; }
        if (hipFuncSetAttribute((const void*)fwd_kernel, hipFuncAttributeMaxDynamicSharedMemorySize, LDS_BYTES) != hipSuccess) { fprintf(stderr, "kernel_launch: hipFuncSetAttribute failed\n"); grid = -1; return; }
        (void)hipGetLastError();
        grid = 256;
    }
    if (grid < 0) return;
    (void)hipMemsetAsync((char*)d_ws + WS_CTL, 0, CTL_ZERO_BYTES, stream);
    Args a{};
    for (int i = 0; i < 16; ++i) a.in[i] = (const float*)d_in[i];
    a.out = (float*)d_out; a.ws = (unsigned char*)d_ws;
    constexpr int NPHASES = 1 + NLAYER * NPH;
    if (MK_N_LAUNCHES == 1) {
        a.ph_lo = 0; a.ph_hi = NPHASES;
        hipLaunchKernelGGL(fwd_kernel, dim3(grid), dim3(512), LDS_BYTES, stream, a);
    } else {
        for (int p = 0; p < NPHASES; ++p) { a.ph_lo = p; a.ph_hi = p + 1; hipLaunchKernelGGL(fwd_kernel, dim3(grid), dim3(512), LDS_BYTES, stream, a); }
    }
}
```

```cpp
#include <hip/hip_runtime.h>
#include <hip/hip_bf16.h>
#include <cstdint>
#include <cstdio>

#ifndef MK_N_LAUNCHES
#define MK_N_LAUNCHES 1
#endif

#ifndef F8_G1
#define F8_G1 1
#endif
#ifndef F8_G2
#define F8_G2 1
#endif
#ifndef F8_G3
#define F8_G3 0
#endif

#define LAS __attribute__((address_space(3)))
#define GAS __attribute__((address_space(1)))
typedef unsigned short bf16_t;
typedef short bf16x8 __attribute__((ext_vector_type(8)));
typedef float f32x4 __attribute__((ext_vector_type(4)));
typedef float f32x2 __attribute__((ext_vector_type(2)));
typedef float f32x16 __attribute__((ext_vector_type(16)));
typedef unsigned u32x4 __attribute__((ext_vector_type(4)));
typedef unsigned u32x2 __attribute__((ext_vector_type(2)));
typedef short v4i16_t __attribute__((ext_vector_type(4)));
typedef __bf16 bf16x2_t __attribute__((ext_vector_type(2)));
typedef int i32x8 __attribute__((ext_vector_type(8)));
typedef int i32x4 __attribute__((ext_vector_type(4)));

constexpr int M = 16384, D = 1024, INW = 4352, FF = 4096, NLAYER = 2;
constexpr int NPH = 8;
constexpr float NORM_EPS = 1e-6f;
constexpr float LOG2E = 1.4426950408889634f;
constexpr float C2 = 0.125f * LOG2E;
constexpr int LUTN = 2176, LUTPAD = 128;

constexpr size_t MiB = 1u << 20;
constexpr size_t WS_CTL = 0, CTL_ZERO_BYTES = 64 * 1024;
constexpr size_t WS_SSQ = 64 * 1024;
constexpr size_t WS_KMP = WS_SSQ + 1 * MiB;
constexpr size_t WS_LUT = WS_KMP + 256 * 1024;
constexpr size_t WS_CUR = WS_LUT + 256 * 1024;
constexpr size_t WS_PL = WS_CUR + 64 * 1024;
constexpr size_t WS_W = 3 * MiB + 512 * 1024;
constexpr size_t OFF_WIN = 0;
constexpr size_t OFF_WBR = OFF_WIN + (size_t)INW * D * 2;
constexpr size_t OFF_WOUT = OFF_WBR + 2 * MiB;
constexpr size_t OFF_W1 = OFF_WOUT + 2 * MiB;
constexpr size_t OFF_W2 = OFF_W1 + 8 * MiB;
constexpr size_t W_BYTES = OFF_W2 + 8 * MiB;
constexpr size_t WS_XB = WS_W + W_BYTES;
constexpr size_t WS_PROJ = WS_XB + 32 * MiB;
constexpr size_t WS_QA = WS_PROJ, WS_KA = WS_QA + 16 * MiB, WS_VA = WS_KA + 16 * MiB, WS_QB = WS_VA + 16 * MiB;
constexpr size_t WS_KB = WS_QB + 16 * MiB, WS_VB = WS_KB + 4 * MiB, WS_GT = WS_VB + 4 * MiB;
constexpr size_t WS_MRG = WS_PROJ;
constexpr size_t WS_U = WS_PROJ;
constexpr size_t WS_PO = WS_GT + 64 * MiB;
constexpr size_t WS_LISTS = WS_PO + 48 * MiB;
constexpr int LIST_HEAD = 516096;
constexpr size_t WS_END = WS_LISTS + (size_t)8 * LIST_HEAD * 2;
static_assert(WS_END <= 256 * MiB, "ws map");
static_assert(WS_U + (size_t)M * FF * 2 <= WS_PO, "u overlay");
static_assert(WS_PL + 3 * 8 * (size_t)M * 4 <= WS_W, "misc map");
constexpr size_t DO_Y = 0, DO_W = 32 * MiB;
constexpr size_t WS_X8 = WS_PO;

constexpr int RING_BYTES = 131072;
constexpr int LDSCTL_OFF = 145408, MISC_OFF = LDSCTL_OFF + 320;
constexpr int LDS_BYTES = 147456;
constexpr int L_K = 0, L_V = 32768, L_OST = 65536, L_WSF = 98304, L_LUT = 100352, L_TAB = 135168, L_SM = 143360;
constexpr int L_RSTD = 131072;
static_assert(L_RSTD + 2560 * 4 <= LDSCTL_OFF, "epilogue tables");
static_assert(L_LUT + 4 * LUTN * 4 <= L_TAB && L_TAB + 4096 <= L_SM && L_SM + 1024 <= LDSCTL_OFF && MISC_OFF + 128 <= LDS_BYTES, "LDS map");

__device__ __forceinline__ unsigned cvtpk(float lo, float hi) { f32x2 v = {lo, hi}; bf16x2_t b = __builtin_convertvector(v, bf16x2_t); return __builtin_bit_cast(unsigned, b); }
__device__ __forceinline__ float bf_lo(unsigned w) { return __builtin_bit_cast(float, w << 16); }
__device__ __forceinline__ float bf_hi(unsigned w) { return __builtin_bit_cast(float, w & 0xffff0000u); }
__device__ __forceinline__ unsigned f2bf(float f) { unsigned u = __builtin_bit_cast(unsigned, f); return (u + 0x7fffu + ((u >> 16) & 1u)) >> 16; }
__device__ __forceinline__ unsigned pk2(float lo, float hi) { return f2bf(lo) | (f2bf(hi) << 16); }
__device__ __forceinline__ unsigned pk4f8(float a, float b, float c, float d) { int p = __builtin_amdgcn_cvt_pk_fp8_f32(a, b, 0, false); p = __builtin_amdgcn_cvt_pk_fp8_f32(c, d, p, true); return (unsigned)p; }
constexpr float F8_SW = 64.f, F8_SY = F8_G2 ? 16.f : 1.f, F8_SM = F8_G3 ? 16.f : 1.f;
constexpr float F8_SW2 = F8_G2 ? F8_SW : 1.f, F8_SW3 = F8_G3 ? F8_SW : 1.f;

namespace pg8 {
constexpr int BM = 256, BK = 64, HALF = 128, HTB = HALF * BK * 2, NXCD = 8, WGM = 8;
__host__ __device__ __forceinline__ int lds_byte(int r, int c) { const int st = (r >> 4) * 2 + (c >> 5), rr = r & 15, cc = c & 31, ob = rr * 64 + cc * 2; return st * 1024 + (ob ^ (((ob >> 9) & 1) << 5)); }
__host__ __device__ __forceinline__ void stage_rc(int b, int& R, int& C) { const int st = b / 1024, sb = b % 1024, swz = sb ^ (((sb >> 9) & 1) << 5); R = (st >> 1) * 16 + swz / 64; C = (st & 1) * 32 + (swz % 64) / 2; }
__host__ __device__ __forceinline__ int perm32(int rho) { const int n = rho >> 4, i = rho & 15; return 8 * (i >> 2) + 4 * n + (i & 3); }

struct Unit { int pm, pn, part; };
struct Gemm { const void* A; const void* Bt; int lda, ldb, K, kpart; };

struct StaticOrder {
    int nM, nN, nwg, G, c, parts;
    int fixed, fpm, fpn;
    __device__ __forceinline__ void init(int M_, int N_, int G_, int c_, int parts_) { nM = M_ / BM; nN = N_ / BM; nwg = nM * nN; G = G_; c = c_; parts = parts_; fixed = 0; fpm = 0; fpn = 0; }
    __device__ __forceinline__ void init_single(int pm_, int pn_, bool have) { nM = 1; nN = 1; nwg = 1; G = 1; c = 0; parts = 1; fixed = have ? 1 : 2; fpm = pm_; fpn = pn_; }
    __device__ __forceinline__ int first_pm() const {
        if (c >= nwg) return -1;
        int wgid = c; { const int q = nwg / NXCD, r = nwg % NXCD, xcd = wgid % NXCD, off = wgid / NXCD; wgid = (xcd < r ? xcd * (q + 1) : r * (q + 1) + (xcd - r) * q) + off; }
        const int nig = WGM * nN, gid = wgid / nig, fm = gid * WGM, gsz = (nM - fm) < WGM ? (nM - fm) : WGM;
        return fm + ((wgid % nig) % gsz);
    }
    __device__ __forceinline__ bool next(int i, Unit& u) const {
        if (fixed) { u.pm = fpm; u.pn = fpn; u.part = 0; return fixed == 1 && i == 0; }
        const int ti = i / parts; u.part = i - ti * parts;
        const long L = (long)ti * G + c; if (L >= nwg) return false;
        int wgid = (int)L; { const int q = nwg / NXCD, r = nwg % NXCD, xcd = wgid % NXCD, off = wgid / NXCD; wgid = (xcd < r ? xcd * (q + 1) : r * (q + 1) + (xcd - r) * q) + off; }
        const int nig = WGM * nN, gid = wgid / nig, fm = gid * WGM, gsz = (nM - fm) < WGM ? (nM - fm) : WGM;
        u.pm = fm + ((wgid % nig) % gsz); u.pn = (wgid % nig) / gsz; return true;
    }
};

template <bool F8, class Epi>
__device__ __forceinline__ void gemm_phase(LAS unsigned char* lds, const Gemm g, const StaticOrder& S, const Epi& E) {
    const int tid = threadIdx.x, wid = __builtin_amdgcn_readfirstlane(tid >> 6), lane = tid & 63, wr = wid >> 2, wc = wid & 3, fr = lane & 15, fq = lane >> 4;
    const int nt = g.K / 128;
    unsigned voffA, voffB;
    { int R, C; stage_rc(tid * 16, R, C); const int Rb = (R & ~31) + perm32(R & 31); voffA = (unsigned)(R * g.lda + 2 * C); voffB = (unsigned)(Rb * g.ldb + 2 * C); }
    const size_t ivoffA = (size_t)64 * g.lda, ivoffB = (size_t)64 * g.ldb;
    const size_t kstep = (size_t)(BK * 2);
    const size_t hstepA = (size_t)HALF * g.lda, hstepB = (size_t)HALF * g.ldb;
    const size_t tstepA = 2 * hstepA, tstepB = 2 * hstepB;
    const unsigned ldsw = (unsigned)wid * 1024u;
    const int aoff = lds_byte(wr * 64 + fr, fq * 8), boff = lds_byte(wc * 32 + fr, fq * 8);
#define PG8_SA(b, h) (((b) * 2 + (h)) * HTB)
#define PG8_SB(b, h) ((4 + (b) * 2 + (h)) * HTB)
#define PG8_STAGE(bufoff, gbase, voff) do { _Pragma("unroll") for (int _i = 0; _i < 2; ++_i) \
        __builtin_amdgcn_global_load_lds((const unsigned*)((const char*)(gbase) + _i * i##voff + (voff)), (LAS unsigned*)(lds + (bufoff) + ldsw + _i * 8192), 16, 0, 0); } while (0)
#define PG8_LDA(dst, b, h) do { _Pragma("unroll") for (int m = 0; m < 4; ++m) _Pragma("unroll") for (int k = 0; k < 2; ++k) dst[m][k] = *(const LAS bf16x8*)(lds + PG8_SA(b, h) + aoff + m * 2048 + k * 1024); } while (0)
#define PG8_LDB(dst, b, h) do { _Pragma("unroll") for (int n = 0; n < 2; ++n) _Pragma("unroll") for (int k = 0; k < 2; ++k) dst[n][k] = *(const LAS bf16x8*)(lds + PG8_SB(b, h) + boff + n * 2048 + k * 1024); } while (0)
#define PG8_F8CAT(x) __builtin_shufflevector(__builtin_bit_cast(i32x4, x[0]), __builtin_bit_cast(i32x4, x[1]), 0, 1, 2, 3, 4, 5, 6, 7)
#define PG8_MMA(ai, bj, At, Bt) do { __builtin_amdgcn_s_setprio(1); _Pragma("unroll") for (int m = 0; m < 4; ++m) _Pragma("unroll") for (int n = 0; n < 2; ++n) { \
        if (F8) { const i32x8 b8_ = PG8_F8CAT(Bt[n]), a8_ = PG8_F8CAT(At[m]); asm volatile("v_mfma_scale_f32_16x16x128_f8f6f4 %0, %1, %2, %0, %3, %3 op_sel_hi:[0,0,0]" : "+v"(acc[ai][bj][m][n]) : "v"(b8_), "v"(a8_), "v"(f8one)); } \
        else { _Pragma("unroll") for (int k = 0; k < 2; ++k) acc[ai][bj][m][n] = __builtin_amdgcn_mfma_f32_16x16x32_bf16(Bt[n][k], At[m][k], acc[ai][bj][m][n], 0, 0, 0); } } __builtin_amdgcn_s_setprio(0); } while (0)
#define PG8_WAIT_V(n) asm volatile("s_waitcnt vmcnt(" #n ")" ::: "memory")
#define PG8_WAIT_L(n) asm volatile("s_waitcnt lgkmcnt(" #n ")" ::: "memory")
#define PG8_BAR __builtin_amdgcn_s_barrier()
#define PG8_SCHED __builtin_amdgcn_sched_barrier(0)
    Unit cur, nxt; int ui = 0;
    if (!S.next(0, cur)) return;
    const int f8one = 0x7f7f7f7f;
    f32x4 acc[2][2][4][2];
#pragma unroll
    for (int a = 0; a < 2; ++a)
#pragma unroll
        for (int b = 0; b < 2; ++b)
#pragma unroll
            for (int m = 0; m < 4; ++m)
#pragma unroll
                for (int n = 0; n < 2; ++n) acc[a][b][m][n] = (f32x4){0.f, 0.f, 0.f, 0.f};
    bf16x8 At[4][2], B0[2][2], B1[2][2];
    const char* cA = (const char*)g.A + (size_t)cur.pm * tstepA + (size_t)cur.part * g.kpart; const char* cB = (const char*)g.Bt + (size_t)cur.pn * tstepB + (size_t)cur.part * g.kpart;
    PG8_STAGE(PG8_SB(0, 0), cB, voffB); PG8_STAGE(PG8_SB(0, 1), cB + hstepB, voffB); PG8_STAGE(PG8_SA(0, 0), cA, voffA); PG8_STAGE(PG8_SA(0, 1), cA + hstepA, voffA);
    if (wr == 1) PG8_BAR;
    PG8_WAIT_V(2); PG8_BAR;
    PG8_STAGE(PG8_SB(1, 0), cB + kstep, voffB); PG8_STAGE(PG8_SA(1, 0), cA + kstep, voffA); PG8_STAGE(PG8_SB(1, 1), cB + hstepB + kstep, voffB);
    PG8_WAIT_V(6); PG8_BAR;
    for (;;) {
        const bool has_next = S.next(ui + 1, nxt);
        const char* nA = has_next ? (const char*)g.A + (size_t)nxt.pm * tstepA + (size_t)nxt.part * g.kpart : cA;
        const char* nB = has_next ? (const char*)g.Bt + (size_t)nxt.pn * tstepB + (size_t)nxt.part * g.kpart : cB;
#pragma unroll 1
        for (int t = 0; t < nt; t += 2) {
            const bool last = (t == nt - 2);
            const char* a1 = cA + (size_t)(t + 1) * kstep;
            const char* a2 = last ? nA : cA + (size_t)(t + 2) * kstep; const char* b2 = last ? nB : cB + (size_t)(t + 2) * kstep;
            const char* a3 = a2 + kstep; const char* b3 = b2 + kstep;
            PG8_LDB(B0, 0, 0); PG8_LDB(B1, 0, 1); PG8_SCHED; PG8_LDA(At, 0, 0); PG8_STAGE(PG8_SA(1, 1), a1 + hstepA, voffA);
            PG8_WAIT_V(8); PG8_WAIT_L(0); PG8_BAR; PG8_MMA(0, 0, At, B0); PG8_MMA(0, 1, At, B1); PG8_BAR; PG8_SCHED;
            PG8_LDA(At, 0, 1); PG8_STAGE(PG8_SB(0, 0), b2, voffB); PG8_STAGE(PG8_SB(0, 1), b2 + hstepB, voffB); PG8_STAGE(PG8_SA(0, 0), a2, voffA);
            PG8_WAIT_V(8); PG8_WAIT_L(0); PG8_BAR; PG8_MMA(1, 0, At, B0); PG8_MMA(1, 1, At, B1); PG8_BAR; PG8_SCHED;
            PG8_LDB(B0, 1, 0); PG8_LDB(B1, 1, 1); PG8_SCHED; PG8_LDA(At, 1, 0); PG8_STAGE(PG8_SA(0, 1), a2 + hstepA, voffA);
            PG8_WAIT_V(8); PG8_WAIT_L(0); PG8_BAR; PG8_MMA(0, 0, At, B0); PG8_MMA(0, 1, At, B1); PG8_BAR; PG8_SCHED;
            PG8_LDA(At, 1, 1); PG8_STAGE(PG8_SB(1, 0), b3, voffB); PG8_STAGE(PG8_SB(1, 1), b3 + hstepB, voffB); PG8_STAGE(PG8_SA(1, 0), a3, voffA);
            PG8_WAIT_V(8); PG8_WAIT_L(0); PG8_BAR; PG8_MMA(1, 0, At, B0); PG8_MMA(1, 1, At, B1); PG8_BAR; PG8_SCHED;
        }
        if (F8) asm volatile("s_nop 15\n\ts_nop 15" ::: "memory");
        if (wr == 0) PG8_BAR;
        E(acc, cur, wr, wc, fr, fq);
        if (!has_next) break;
        if (!E.keep(cur)) {
#pragma unroll
        for (int a = 0; a < 2; ++a)
#pragma unroll
            for (int b = 0; b < 2; ++b)
#pragma unroll
                for (int m = 0; m < 4; ++m)
#pragma unroll
                    for (int n = 0; n < 2; ++n) acc[a][b][m][n] = (f32x4){0.f, 0.f, 0.f, 0.f};
        }
        cur = nxt; cA = nA; cB = nB; ++ui;
        if (wr == 1) PG8_BAR;
    }
    PG8_WAIT_V(0);
    PG8_BAR;
#undef PG8_SA
#undef PG8_SB
#undef PG8_STAGE
#undef PG8_LDA
#undef PG8_LDB
#undef PG8_MMA
#undef PG8_F8CAT
#undef PG8_WAIT_V
#undef PG8_WAIT_L
#undef PG8_BAR
#undef PG8_SCHED
}

__device__ __forceinline__ float row_rstd(const float* ssq, int row, int fq) {
    const f32x4 s4 = *(const f32x4*)(ssq + (size_t)row * 16 + 4 * fq);
    float s = (s4[0] + s4[1]) + (s4[2] + s4[3]);
    s += __shfl_xor(s, 16); s += __shfl_xor(s, 32);
    return 1.0f / sqrtf(s * (1.0f / 1024.0f) + NORM_EPS);
}
__device__ __forceinline__ void store8(bf16_t* p, const f32x4 a, const f32x4 b) {
    u32x4 w; w.x = cvtpk(a[0], a[1]); w.y = cvtpk(a[2], a[3]); w.z = cvtpk(b[0], b[1]); w.w = cvtpk(b[2], b[3]); *(u32x4*)p = w;
}

struct EpiProj {
    const LAS float* rtab; bf16_t *Qa, *Ka, *Va, *Qb, *Kb, *Vb, *Gt; float* kmp;
    __device__ __forceinline__ bool keep(const Unit&) const { return false; }
    __device__ __forceinline__ void operator()(f32x4 (&acc)[2][2][4][2], const Unit& u, int wr, int wc, int fr, int fq) const {
        const int pn = u.pn, row0 = u.pm * BM + wr * 64 + fr;
        int mode; bf16_t* dst; int ld, col0; const LAS float* w = rtab + 256; int kmhead = -1;
        if (pn < 2) { mode = 0; dst = Qa; ld = 512; col0 = (4 * pn + wc) * 64; }
        else if (pn < 4) { mode = 0; dst = Ka; ld = 512; col0 = (4 * (pn - 2) + wc) * 64; w += 64; kmhead = 4 * (pn - 2) + wc; }
        else if (pn < 6) { mode = 1; dst = Va; ld = 512; col0 = (4 * (pn - 4) + wc) * 64; }
        else if (pn < 8) { mode = 0; dst = Qb; ld = 512; col0 = (4 * (pn - 6) + wc) * 64; w += 128; }
        else if (pn == 8) { if (wc < 2) { mode = 0; dst = Kb; ld = 128; col0 = wc * 64; w += 192; } else { mode = 1; dst = Vb; ld = 128; col0 = (wc - 2) * 64; } }
        else { mode = 2; dst = Gt; ld = 2048; col0 = (pn - 9) * 128 + 32 * wc; }
        f32x4 cw[2][2];
#pragma unroll
        for (int bj = 0; bj < 2; ++bj)
#pragma unroll
            for (int n = 0; n < 2; ++n) {
                if (mode == 0) cw[bj][n] = *(const LAS f32x4*)(w + 32 * bj + 8 * fq + 4 * n);
                else if (mode == 2) cw[bj][n] = *(const LAS f32x4*)(rtab + 512 + 1024 * bj + col0 + 8 * fq + 4 * n);
                else cw[bj][n] = (f32x4){1.f, 1.f, 1.f, 1.f};
            }
        f32x4 ks[2][2];
#pragma unroll
        for (int bj = 0; bj < 2; ++bj)
#pragma unroll
            for (int n = 0; n < 2; ++n) ks[bj][n] = (f32x4){0.f, 0.f, 0.f, 0.f};
#pragma unroll
        for (int ai = 0; ai < 2; ++ai)
#pragma unroll
            for (int m = 0; m < 4; ++m) {
                const int row = row0 + ai * HALF + m * 16;
                const float rs = rtab[ai * HALF + wr * 64 + m * 16 + fr];
                f32x4 v[2][2];
#pragma unroll
                for (int bj = 0; bj < 2; ++bj)
#pragma unroll
                    for (int n = 0; n < 2; ++n) v[bj][n] = acc[ai][bj][m][n] * rs;
                if (mode == 0) {
                    float ss = 0.f;
#pragma unroll
                    for (int bj = 0; bj < 2; ++bj)
#pragma unroll
                        for (int n = 0; n < 2; ++n) { const f32x4 x = v[bj][n]; ss += (x[0] * x[0] + x[1] * x[1]) + (x[2] * x[2] + x[3] * x[3]); }
                    ss += __shfl_xor(ss, 16); ss += __shfl_xor(ss, 32);
                    const float inv = 1.0f / sqrtf(ss * (1.0f / 64.0f) + NORM_EPS);
#pragma unroll
                    for (int bj = 0; bj < 2; ++bj)
#pragma unroll
                        for (int n = 0; n < 2; ++n) { v[bj][n] = v[bj][n] * inv * cw[bj][n]; ks[bj][n] += v[bj][n]; }
                } else if (mode == 2) {
#pragma unroll
                    for (int n = 0; n < 2; ++n) { f32x4 xa = v[0][n] + cw[0][n], xg = v[1][n] + cw[1][n];
#pragma unroll
                        for (int e = 0; e < 4; ++e) { const float da = 1.0f + __builtin_amdgcn_exp2f(-LOG2E * xa[e]), db = fminf(1.0f + __builtin_amdgcn_exp2f(-LOG2E * xg[e]), 1e20f);
                            xg[e] = __builtin_amdgcn_rcpf(db); xa[e] = db * __builtin_amdgcn_rcpf(da); }
                        v[0][n] = xa; v[1][n] = xg; }
                }
                bf16_t* rp = dst + (size_t)row * ld + col0 + 8 * fq;
                if (mode == 2) {
                    constexpr float cG = F8_SM / (F8_SW2 * F8_SY);
                    store8(rp, v[0][0], v[0][1]); store8(rp + 1024, v[1][0] * cG, v[1][1] * cG);
                } else { store8(rp, v[0][0], v[0][1]); store8(rp + 32, v[1][0], v[1][1]); }
            }
        if (kmhead >= 0) {
#pragma unroll
            for (int bj = 0; bj < 2; ++bj)
#pragma unroll
                for (int n = 0; n < 2; ++n) { f32x4 x = ks[bj][n];
#pragma unroll
                    for (int o = 1; o < 16; o <<= 1) { x[0] += __shfl_xor(x[0], o); x[1] += __shfl_xor(x[1], o); x[2] += __shfl_xor(x[2], o); x[3] += __shfl_xor(x[3], o); }
                    if (fr == 0) *(f32x4*)(kmp + ((size_t)(kmhead * 64 + u.pm) * 2 + wr) * 64 + 32 * bj + 8 * fq + 4 * n) = x; }
        }
    }
};

struct EpiMerge {
    const bf16_t* Gt; unsigned char* out;
    __device__ __forceinline__ bool keep(const Unit& u) const { return u.part == 0; }
    __device__ __forceinline__ void operator()(f32x4 (&acc)[2][2][4][2], const Unit& u, int wr, int wc, int fr, int fq) const {
        const int row0 = u.pm * BM + wr * 64 + fr, colb = u.pn * BM + wc * 32 + 8 * fq;
        const bf16_t* gp = Gt + (u.part == 0 ? 0 : 1024);
        u32x4 gw[2][4][2];
#pragma unroll
        for (int ai = 0; ai < 2; ++ai)
#pragma unroll
            for (int m = 0; m < 4; ++m)
#pragma unroll
                for (int bj = 0; bj < 2; ++bj) gw[ai][m][bj] = __builtin_nontemporal_load((const u32x4*)(gp + (size_t)(row0 + ai * HALF + m * 16) * 2048 + colb + bj * HALF));
#pragma unroll
        for (int ai = 0; ai < 2; ++ai)
#pragma unroll
            for (int m = 0; m < 4; ++m) {
                const int row = row0 + ai * HALF + m * 16;
#pragma unroll
                for (int bj = 0; bj < 2; ++bj) {
                    const int col = colb + bj * HALF; const u32x4 w = gw[ai][m][bj];
                    const f32x4 g0 = (f32x4){bf_lo(w.x), bf_hi(w.x), bf_lo(w.y), bf_hi(w.y)}, g1 = (f32x4){bf_lo(w.z), bf_hi(w.z), bf_lo(w.w), bf_hi(w.w)};
                    acc[ai][bj][m][0] *= g0; acc[ai][bj][m][1] *= g1;
                    if (u.part != 0) { const f32x4 a0 = acc[ai][bj][m][0], a1 = acc[ai][bj][m][1]; u32x2 w8; w8.x = pk4f8(a0[0], a0[1], a0[2], a0[3]); w8.y = pk4f8(a1[0], a1[1], a1[2], a1[3]); if (F8_G3) *(u32x2*)(out + (size_t)row * 1024 + col) = w8; else store8((bf16_t*)out + (size_t)row * 1024 + col, a0, a1); }
                }
            }
    }
};

struct EpiResid {
    bf16_t* xb; float* ssq; float* outf; float cs; unsigned char* x8;
    __device__ __forceinline__ bool keep(const Unit&) const { return false; }
    __device__ __forceinline__ void operator()(f32x4 (&acc)[2][2][4][2], const Unit& u, int wr, int wc, int fr, int fq) const {
        const int row0 = u.pm * BM + wr * 64 + fr, colb = u.pn * BM + wc * 32 + 8 * fq;
        u32x4 xw[2][4][2];
#pragma unroll
        for (int ai = 0; ai < 2; ++ai)
#pragma unroll
            for (int m = 0; m < 4; ++m)
#pragma unroll
                for (int bj = 0; bj < 2; ++bj) xw[ai][m][bj] = *(const u32x4*)(xb + (size_t)(row0 + ai * HALF + m * 16) * 1024 + colb + bj * HALF);
#pragma unroll
        for (int ai = 0; ai < 2; ++ai)
#pragma unroll
            for (int m = 0; m < 4; ++m) {
                const int row = row0 + ai * HALF + m * 16; float ss = 0.f;
#pragma unroll
                for (int bj = 0; bj < 2; ++bj) {
                    const size_t off = (size_t)row * 1024 + colb + bj * HALF;
                    const u32x4 w = xw[ai][m][bj];
                    const f32x4 x0 = (f32x4){bf_lo(w.x), bf_hi(w.x), bf_lo(w.y), bf_hi(w.y)} + acc[ai][bj][m][0] * cs, x1 = (f32x4){bf_lo(w.z), bf_hi(w.z), bf_lo(w.w), bf_hi(w.w)} + acc[ai][bj][m][1] * cs;
                    if (outf) { __builtin_nontemporal_store(x0, (f32x4*)(outf + off)); __builtin_nontemporal_store(x1, (f32x4*)(outf + off + 4)); }
                    else { store8(xb + off, x0, x1);
                        if (x8) { u32x2 w8; w8.x = pk4f8(x0[0], x0[1], x0[2], x0[3]); w8.y = pk4f8(x1[0], x1[1], x1[2], x1[3]); *(u32x2*)(x8 + off) = w8; }
                        ss += (x0[0] * x0[0] + x0[1] * x0[1]) + (x0[2] * x0[2] + x0[3] * x0[3]) + (x1[0] * x1[0] + x1[1] * x1[1]) + (x1[2] * x1[2] + x1[3] * x1[3]); }
                }
                if (!outf) { ss += __shfl_xor(ss, 16); ss += __shfl_xor(ss, 32);
                    if (fq == 0) ssq[(size_t)row * 16 + 4 * u.pn + wc] = ss; }
            }
    }
};

struct EpiFfnUp {
    const LAS float* rtab; bf16_t* U;
    __device__ __forceinline__ bool keep(const Unit&) const { return false; }
    __device__ __forceinline__ void operator()(f32x4 (&acc)[2][2][4][2], const Unit& u, int wr, int wc, int fr, int fq) const {
        const int row0 = u.pm * BM + wr * 64 + fr, colb = u.pn * BM + wc * 32 + 8 * fq;
#pragma unroll
        for (int ai = 0; ai < 2; ++ai)
#pragma unroll
            for (int m = 0; m < 4; ++m) {
                const int row = row0 + ai * HALF + m * 16;
                const float rs = rtab[ai * HALF + wr * 64 + m * 16 + fr];
#pragma unroll
                for (int bj = 0; bj < 2; ++bj) {
                    f32x4 a, b;
#pragma unroll
                    for (int e = 0; e < 4; ++e) { const float t0 = fmaxf(acc[ai][bj][m][0][e], 0.f) * rs, t1 = fmaxf(acc[ai][bj][m][1][e], 0.f) * rs; a[e] = t0 * t0; b[e] = t1 * t1; }
                    store8(U + (size_t)row * FF + colb + bj * HALF, a, b);
                }
            }
    }
};
}

namespace att {
__device__ __forceinline__ int crow(int r, int hi) { return (r & 3) + 8 * (r >> 2) + 4 * hi; }
__device__ __forceinline__ bf16x8 vtr2(const LAS char* p) {
    const v4i16_t lo = __builtin_amdgcn_ds_read_tr16_b64_v4i16((LAS v4i16_t*)p), hi = __builtin_amdgcn_ds_read_tr16_b64_v4i16((LAS v4i16_t*)(p + 512));
    return (bf16x8){lo[0], lo[1], lo[2], lo[3], hi[0], hi[1], hi[2], hi[3]};
}
__device__ __forceinline__ int kswz(int row, int chunk) { return chunk * 1024 + ((row & ~7) | ((row ^ chunk) & 7)) * 16; }
__device__ __forceinline__ void load_kv(LAS unsigned char* lds, const bf16_t* Kg, const bf16_t* Vg, int pitch, int row0, int tid) {
    const int lane = tid & 63, w = tid >> 6;
#pragma unroll
    for (int t = 0; t < 4; ++t) {
        const int kr = w * 8 + (lane >> 3), kc = lane & 7, gk = row0 + 64 * t + kr;
        u32x4 kv = (u32x4){0u, 0u, 0u, 0u};
        if (gk >= 0) kv = *(const u32x4*)(Kg + (size_t)gk * pitch + kc * 8);
        *(LAS u32x4*)(lds + L_K + t * 8192 + kswz(kr, kc)) = kv;
        const int gv = row0 + 64 * t + 16 * (w & 3) + (lane >> 2);
        u32x4 vv = (u32x4){0u, 0u, 0u, 0u};
        if (gv >= 0) vv = *(const u32x4*)(Vg + (size_t)gv * pitch + (w >> 2) * 32 + (lane & 3) * 8);
        *(LAS u32x4*)(lds + L_V + t * 8192 + w * 1024 + lane * 16) = vv;
    }
}
__device__ __forceinline__ void load_q(bf16x8 (&qr)[4], const bf16_t* qrow, int hi) {
#pragma unroll
    for (int d0 = 0; d0 < 4; ++d0) qr[d0] = *(const bf16x8*)(qrow + d0 * 16 + hi * 8);
}
__device__ __forceinline__ void qkt(f32x16& p0, f32x16& p1, const LAS unsigned char* Kt, const bf16x8 (&qr)[4], int r32, int hi) {
#pragma unroll
    for (int d0 = 0; d0 < 4; ++d0) {
        const LAS unsigned char* kb = Kt + kswz(r32, 2 * d0 + hi);
        const bf16x8 b0 = *(const LAS bf16x8*)(kb);
        const bf16x8 b1 = *(const LAS bf16x8*)(kb + 512);
        p0 = __builtin_amdgcn_mfma_f32_32x32x16_bf16(b0, qr[d0], p0, 0, 0, 0);
        p1 = __builtin_amdgcn_mfma_f32_32x32x16_bf16(b1, qr[d0], p1, 0, 0, 0);
    }
}
struct LutLane { const LAS float* lutp; int amax; };
__device__ __forceinline__ LutLane lut_lane(const LAS float* lut4, int cstride, int nmax, int dlane) {
    const int k = (dlane - 3 + LUTPAD) & 3; LutLane L; L.lutp = lut4 + k * cstride - k; L.amax = ((nmax - 4 - k) & ~3) + k; return L;
}
template <bool LUTB, bool MASKED>
__device__ __forceinline__ void tile(f32x16 (&o)[2], float& lsum, const bf16x8 (&qr)[4], const LAS unsigned char* Kt, const LAS unsigned char* Vt,
                                     float cbias, const LutLane L, int dbase, unsigned dmax, int r32, int hi, int lane, const bool domask = true) {
    f32x16 p0, p1;
    const int db = dbase - 4 * hi;
    if (LUTB) {
#pragma unroll
        for (int gq = 0; gq < 4; ++gq) {
            int a0 = db - 3 - 8 * gq + LUTPAD, a1 = a0 - 32; a0 = a0 < L.amax ? a0 : L.amax; a1 = a1 < L.amax ? a1 : L.amax;
            const f32x4 x0 = *(const LAS f32x4*)(L.lutp + a0), x1 = *(const LAS f32x4*)(L.lutp + a1);
#pragma unroll
            for (int i = 0; i < 4; ++i) { p0[4 * gq + i] = x0[3 - i]; p1[4 * gq + i] = x1[3 - i]; }
        }
    } else {
#pragma unroll
        for (int r = 0; r < 16; ++r) { p0[r] = cbias; p1[r] = cbias; }
    }
    qkt(p0, p1, Kt, qr, r32, hi);
    if (MASKED && domask) {
#pragma unroll
        for (int r = 0; r < 16; ++r) { const int c = (r & 3) + 8 * (r >> 2);
            if ((unsigned)(db - c) > dmax) p0[r] = -INFINITY;
            if ((unsigned)(db - 32 - c) > dmax) p1[r] = -INFINITY; }
    }
    float s = 0.f;
#pragma unroll
    for (int r = 0; r < 16; ++r) { p0[r] = __builtin_amdgcn_exp2f(p0[r]); p1[r] = __builtin_amdgcn_exp2f(p1[r]); s += p0[r] + p1[r]; }
    lsum += s;
    u32x4 pw[4];
#pragma unroll
    for (int k = 0; k < 4; ++k) { pw[0][k] = cvtpk(p0[2 * k], p0[2 * k + 1]); pw[1][k] = cvtpk(p0[8 + 2 * k], p0[9 + 2 * k]); pw[2][k] = cvtpk(p1[2 * k], p1[2 * k + 1]); pw[3][k] = cvtpk(p1[8 + 2 * k], p1[9 + 2 * k]); }
    const LAS char* vp = (const LAS char*)Vt + ((lane >> 4) & 1) * 32 + (lane & 3) * 8 + (4 * hi + ((lane & 15) >> 2)) * 64;
#pragma unroll
    for (int d0 = 0; d0 < 2; ++d0)
#pragma unroll
        for (int ks = 0; ks < 4; ++ks) {
            const bf16x8 vf = vtr2(vp + d0 * 4096 + ks * 1024);
            o[d0] = __builtin_amdgcn_mfma_f32_32x32x16_bf16(__builtin_bit_cast(bf16x8, pw[ks]), vf, o[d0], 0, 0, 0);
        }
}
__device__ __forceinline__ void lut4_put(LAS float* lut4, int cstride, int ix, float v) {
#pragma unroll
    for (int k = 0; k < 4; ++k) if (ix - k >= 0) lut4[k * cstride + ix - k] = v;
}
__device__ __forceinline__ void stage_o(LAS bf16_t* stg, const f32x16 (&o)[2], int r32, int hi) {
#pragma unroll
    for (int r = 0; r < 16; r += 2) { const int orow0 = crow(r, hi), orow1 = crow(r + 1, hi);
#pragma unroll
        for (int d0 = 0; d0 < 2; ++d0) { const unsigned w = cvtpk(o[d0][r], o[d0][r + 1]); stg[orow0 * 64 + d0 * 32 + r32] = (bf16_t)(w & 0xffffu); stg[orow1 * 64 + d0 * 32 + r32] = (bf16_t)(w >> 16); } }
}
__device__ __forceinline__ void unpack8(float (&f)[8], const u32x4 w) { f[0] = bf_lo(w.x); f[1] = bf_hi(w.x); f[2] = bf_lo(w.y); f[3] = bf_hi(w.y); f[4] = bf_lo(w.z); f[5] = bf_hi(w.z); f[6] = bf_lo(w.w); f[7] = bf_hi(w.w); }
__device__ __forceinline__ u32x2 pack8f8(const float (&f)[8]) { u32x2 w; w.x = pk4f8(f[0], f[1], f[2], f[3]); w.y = pk4f8(f[4], f[5], f[6], f[7]); return w; }
__device__ __forceinline__ u32x4 pack8(const float (&f)[8]) { u32x4 w; w.x = cvtpk(f[0], f[1]); w.y = cvtpk(f[2], f[3]); w.z = cvtpk(f[4], f[5]); w.w = cvtpk(f[6], f[7]); return w; }
}

typedef GAS unsigned gu32;
#define RLX_AGENT __ATOMIC_RELAXED, __HIP_MEMORY_SCOPE_AGENT
#define LDS_WAIT() asm volatile("s_waitcnt lgkmcnt(0)" ::: "memory")
#define VM_WAIT() asm volatile("s_waitcnt vmcnt(0)" ::: "memory")
#define XB_TMO      128
#define XB_XCNT(j)  (256  + 64 * (j))
#define XB_XSUB(j)  (1280 + 64 * (j))
#define XB_XGEN(j)  (2304 + 64 * (j))
#define XB_TOP      3328
#define XB_TOPGEN   3392
#define XCD_BAR_WORDS 3456
#define XB_SPIN_CAP (1u << 22)
__device__ __forceinline__ unsigned xb_ld(unsigned* p)              { return __hip_atomic_load(p, __ATOMIC_RELAXED, __HIP_MEMORY_SCOPE_AGENT); }
__device__ __forceinline__ unsigned xb_add(unsigned* p, unsigned v) { return __hip_atomic_fetch_add(p, v, __ATOMIC_RELAXED, __HIP_MEMORY_SCOPE_AGENT); }
__device__ __forceinline__ unsigned xb_xcc_id() { return (unsigned)__builtin_amdgcn_s_getreg((3 << 11) | 20) & 0xFu; }
#define XB_SPIN(cond, bar) do { unsigned _sp = 0; while (cond) { __builtin_amdgcn_s_sleep(1); \
    if ((++_sp & 255u) == 0u) { if (xb_ld(&(bar)[XB_TMO])) break; if (_sp > XB_SPIN_CAP) { atomicAdd(&(bar)[XB_TMO], 1u); break; } } } } while (0)
struct XcdBarrier { unsigned* bar; unsigned x; volatile LAS unsigned* st; };
__device__ __forceinline__ XcdBarrier xcd_barrier_post(unsigned* bar, volatile LAS unsigned* st) {
    XcdBarrier b; b.bar = bar; b.x = xb_xcc_id(); b.st = st;
    if (threadIdx.x == 0) (void)xb_add(&bar[XB_XCNT(b.x)], 1u);
    return b;
}
__device__ __forceinline__ void xcd_barrier_complete(unsigned* bar, unsigned x, unsigned& nloc, unsigned& nx) {
    const unsigned G = gridDim.x * gridDim.y * gridDim.z;
    unsigned sum, cnt, mine, sp = 0u;
    for (;;) {
        sum = 0u; cnt = 0u; mine = 0u;
#pragma unroll
        for (unsigned j = 0; j < 16; ++j) { const unsigned c = xb_ld(&bar[XB_XCNT(j)]); sum += c; cnt += (c > 0u) ? 1u : 0u; mine = (j == x) ? c : mine; }
        if (sum == G) break;
        __builtin_amdgcn_s_sleep(1);
        if ((++sp & 255u) == 0u) { if (xb_ld(&bar[XB_TMO])) break; if (sp > XB_SPIN_CAP) { atomicAdd(&bar[XB_TMO], 1u); break; } }
    }
    nloc = mine > 0u ? mine : 1u; nx = cnt > 0u ? cnt : 1u;
}
__device__ __forceinline__ void xcd_barrier(const XcdBarrier& b) {
    asm volatile("s_waitcnt vmcnt(0)" ::: "memory");
    __syncthreads();
    if (threadIdx.x == 0) {
        unsigned* bar = b.bar;
        __builtin_amdgcn_s_waitcnt(0);
        unsigned nloc = b.st[0], nx = b.st[1];
        if (nloc == 0u) { xcd_barrier_complete(bar, b.x, nloc, nx); b.st[0] = nloc; b.st[1] = nx; }
        const unsigned old = xb_add(&bar[XB_XSUB(b.x)], 1u);
        const unsigned gen = old / nloc;
        if (old + 1u == (gen + 1u) * nloc) {
            __builtin_amdgcn_fence(__ATOMIC_RELEASE, "agent");
            asm volatile("s_waitcnt vmcnt(0)" ::: "memory");
            const unsigned og = xb_add(&bar[XB_TOP], 1u);
            const unsigned tg = og / nx;
            if (og + 1u == (tg + 1u) * nx) xb_add(&bar[XB_TOPGEN], 1u);
            else XB_SPIN(xb_ld(&bar[XB_TOPGEN]) == tg, bar);
            __builtin_amdgcn_fence(__ATOMIC_ACQUIRE, "agent");
            xb_add(&bar[XB_XGEN(b.x)], 1u);
            asm volatile("s_waitcnt vmcnt(0)" ::: "memory");
        } else {
            XB_SPIN(xb_ld(&bar[XB_XGEN(b.x)]) == gen, bar);
            __builtin_amdgcn_fence(__ATOMIC_ACQUIRE, "agent");
            asm volatile("s_waitcnt vmcnt(0)" ::: "memory");
        }
    }
    __syncthreads();
}

__device__ __forceinline__ void rstd_table(LAS float* rtab, const float* ssq, int pm, const float scale) {
    const int tid = threadIdx.x;
    if (tid < 256) { const f32x4* p = (const f32x4*)(ssq + (size_t)(pm * 256 + tid) * 16); const f32x4 a = p[0], b = p[1], c = p[2], d = p[3];
        const float s = ((a[0] + a[1]) + (a[2] + a[3])) + ((b[0] + b[1]) + (b[2] + b[3])) + ((c[0] + c[1]) + (c[2] + c[3])) + ((d[0] + d[1]) + (d[2] + d[3]));
        rtab[tid] = scale / sqrtf(s * (1.0f / 1024.0f) + NORM_EPS); }
    __syncthreads();
}
__device__ __forceinline__ void proj_consts(LAS float* tab, const float* qna, const float* kna, const float* qnb, const float* knb, const float* bgate) {
    const int tid = threadIdx.x;
    if (tid < 256) { const int k = tid >> 6, i = tid & 63; tab[256 + tid] = (k == 0) ? qna[i] * C2 : (k == 1) ? kna[i] : (k == 2) ? qnb[i] * C2 : knb[i]; }
#pragma unroll
    for (int i = 0; i < 4; ++i) tab[512 + tid + 512 * i] = bgate[tid + 512 * i];
}
struct Args { const float* in[16]; float* out; unsigned char* ws; int ph_lo, ph_hi; };
struct Frame {
    LAS unsigned char* lds;
    int tid, lane, wave, G, vcu;
    unsigned char* ws; float* out;
};

__device__ __forceinline__ float wave_sum(float v) {
#pragma unroll
    for (int o = 1; o < 64; o <<= 1) v += __shfl_xor(v, o);
    return v;
}
__device__ __forceinline__ int rel_bucket(int d) {
    if (d < 16) return d < 0 ? 0 : d;
    int b = 16;
    b += (d >= 22); b += (d >= 30); b += (d >= 40); b += (d >= 54); b += (d >= 73); b += (d >= 99); b += (d >= 134); b += (d >= 182);
    b += (d >= 246); b += (d >= 332); b += (d >= 450); b += (d >= 609); b += (d >= 825); b += (d >= 1117); b += (d >= 1513);
    return b;
}

struct PItem { int type; const float* src; int N; const float* gs; unsigned char* dst; int f8, ldk, kcol, drowA, drowB, m0; };
__device__ __forceinline__ int win_drow(int n0) {
    if (n0 >= 2304) { const int gg = n0 - 2304, isb = gg >= 1024 ? 1 : 0, G0 = gg - 1024 * isb; return (9 + (G0 >> 7)) * 256 + 128 * isb + 32 * ((G0 & 127) >> 5); }
    const int cc = n0 & 255; return (n0 & ~255) + 128 * ((cc >> 5) & 1) + 32 * (cc >> 6);
}
constexpr int PT_LAYER = 16 * 68 + 2 * 8 * 16 + 16 * 16 + 16 * 64 + 64 * 16;
constexpr int PT_X = M / 4;
__device__ __forceinline__ PItem pro_decode(int it, const Args& a, unsigned char* ws, unsigned char* outb) {
    PItem p; p.gs = nullptr; p.m0 = 0; p.ldk = D; p.drowA = 0; p.drowB = 0; p.kcol = 0; p.N = D; p.dst = nullptr; p.src = nullptr; p.f8 = 0;
    if (it >= NLAYER * PT_LAYER) { p.type = 1; p.m0 = (it - NLAYER * PT_LAYER) * 4; p.src = a.in[0] + (size_t)p.m0 * D; return p; }
    p.type = 0;
    const int l = it / PT_LAYER; int r = it - l * PT_LAYER;
    unsigned char* wb = (l == 0) ? outb + DO_W : ws + WS_W;
    if (r < 16 * 68) { const int kb = r / 68, n0 = (r % 68) * 64, k0 = kb * 64; p.src = a.in[3] + (size_t)l * D * INW + (size_t)k0 * INW + n0; p.N = INW; p.gs = a.in[2] + (size_t)l * D + k0;
        p.dst = wb + OFF_WIN; p.f8 = F8_G1; p.kcol = k0; p.drowA = win_drow(n0); p.drowB = win_drow(n0 + 32); return p; } r -= 16 * 68;
    if (r < 128) { const int kb = r / 16, n0 = (r % 16) * 64, k0 = kb * 64; p.src = a.in[10] + (size_t)l * 512 * D + (size_t)k0 * D + n0; p.dst = wb + OFF_WBR; p.f8 = F8_G2; p.kcol = k0; p.drowA = n0; p.drowB = n0 + 32; return p; } r -= 128;
    if (r < 128) { const int kb = r / 16, n0 = (r % 16) * 64, k0 = kb * 64; p.src = a.in[11] + (size_t)l * 512 * D + (size_t)k0 * D + n0; p.dst = wb + OFF_WBR; p.f8 = F8_G2; p.kcol = 512 + k0; p.drowA = n0; p.drowB = n0 + 32; return p; } r -= 128;
    if (r < 256) { const int kb = r / 16, n0 = (r % 16) * 64, k0 = kb * 64; p.src = a.in[12] + (size_t)l * D * D + (size_t)k0 * D + n0; p.dst = wb + OFF_WOUT; p.f8 = F8_G3; p.kcol = k0; p.drowA = n0; p.drowB = n0 + 32; return p; } r -= 256;
    if (r < 1024) { const int kb = r / 64, n0 = (r % 64) * 64, k0 = kb * 64; p.src = a.in[14] + (size_t)l * D * FF + (size_t)k0 * FF + n0; p.N = FF; p.gs = a.in[13] + (size_t)l * D + k0;
        p.dst = wb + OFF_W1; p.kcol = k0; p.drowA = n0; p.drowB = n0 + 32; return p; } r -= 1024;
    { const int kb = r / 16, n0 = (r % 16) * 64, k0 = kb * 64; p.src = a.in[15] + (size_t)l * FF * D + (size_t)k0 * D + n0; p.dst = wb + OFF_W2; p.ldk = FF; p.kcol = k0; p.drowA = n0; p.drowB = n0 + 32; }
    return p;
}
__device__ __forceinline__ void pro_load(f32x4 (&v)[16], const PItem& p, int lane) {
    if (p.type == 0) { const float* s = p.src + (size_t)(lane >> 4) * p.N + (lane & 15) * 4;
#pragma unroll
        for (int i = 0; i < 16; ++i) v[i] = __builtin_nontemporal_load((const f32x4*)(s + (size_t)(4 * i) * p.N));
    } else { const float* s = p.src + lane * 4;
#pragma unroll
        for (int i = 0; i < 16; ++i) v[i] = __builtin_nontemporal_load((const f32x4*)(s + (i >> 2) * D + (i & 3) * 256));
    }
}
__device__ __forceinline__ void pro_process(const f32x4 (&v)[16], const PItem& p, LAS float* scr, int lane, unsigned char* ws, unsigned char* x8) {
    if (p.type == 0) {
        const int c = lane & 7, nl = lane >> 3;
        f32x4 g0 = (f32x4){1.f, 1.f, 1.f, 1.f}, g1 = g0;
        if (p.gs) { g0 = *(const f32x4*)(p.gs + 8 * c); g1 = *(const f32x4*)(p.gs + 8 * c + 4); }
        if (p.f8) { g0 = g0 * F8_SW; g1 = g1 * F8_SW; }
#pragma unroll
        for (int i = 0; i < 16; ++i) { LAS float* w = scr + (4 * i + (lane >> 4)) * 65 + (lane & 15) * 4; w[0] = v[i][0]; w[1] = v[i][1]; w[2] = v[i][2]; w[3] = v[i][3]; }
        LDS_WAIT(); asm volatile("" ::: "memory");
#pragma unroll
        for (int j = 0; j < 8; ++j) { const int n = nl + 8 * j; const LAS float* s = scr + (8 * c) * 65 + n;
            const float t0 = s[0 * 65] * g0[0], t1 = s[1 * 65] * g0[1], t2 = s[2 * 65] * g0[2], t3 = s[3 * 65] * g0[3], t4 = s[4 * 65] * g1[0], t5 = s[5 * 65] * g1[1], t6 = s[6 * 65] * g1[2], t7 = s[7 * 65] * g1[3];
            const int drow = (j < 4) ? p.drowA + n : p.drowB + n - 32;
            const size_t eo = (size_t)drow * p.ldk + p.kcol + 8 * c;
            if (p.f8) { u32x2 o; o.x = pk4f8(t0, t1, t2, t3); o.y = pk4f8(t4, t5, t6, t7); *(u32x2*)(p.dst + eo) = o; }
            else { u32x4 o; o.x = cvtpk(t0, t1); o.y = cvtpk(t2, t3); o.z = cvtpk(t4, t5); o.w = cvtpk(t6, t7); *(u32x4*)(p.dst + eo * 2) = o; } }
        LDS_WAIT(); asm volatile("" ::: "memory");
    } else {
        bf16_t* xb = (bf16_t*)(ws + WS_XB); float* ssq = (float*)(ws + WS_SSQ);
#pragma unroll
        for (int r = 0; r < 4; ++r) { float s = 0.f;
#pragma unroll
            for (int q = 0; q < 4; ++q) { const f32x4 x = v[4 * r + q]; s += (x[0] * x[0] + x[1] * x[1]) + (x[2] * x[2] + x[3] * x[3]); }
            s = wave_sum(s);
            u32x2* o8 = (u32x2*)(xb + (size_t)(p.m0 + r) * D) + lane;
#pragma unroll
            for (int q = 0; q < 4; ++q) { const f32x4 x = v[4 * r + q]; u32x2 w; w.x = cvtpk(x[0], x[1]); w.y = cvtpk(x[2], x[3]); o8[64 * q] = w;
                if (F8_G1) ((unsigned*)(x8 + (size_t)(p.m0 + r) * D))[lane + 64 * q] = pk4f8(x[0], x[1], x[2], x[3]); }
            if (lane < 16) ssq[(size_t)(p.m0 + r) * 16 + lane] = (lane == 0) ? s : 0.f; }
    }
}
__device__ __forceinline__ void phase_prologue(Frame& F, const Args& a) {
    LAS float* scr = (LAS float*)(F.lds + F.wave * 16640);
    const int gw = F.vcu * 8 + F.wave, NGW = F.G * 8;
    unsigned char* ws = F.ws; unsigned char* outb = (unsigned char*)F.out;
    {
        if (gw == 0) { unsigned* cur = (unsigned*)(ws + WS_CUR); for (int i = F.lane; i < NLAYER * 512; i += 64) cur[i] = 0u; }
        const float* rel_bias = a.in[1]; float* lut = (float*)(ws + WS_LUT);
        for (int i = gw * 64 + F.lane; i < 16 * LUTN; i += NGW * 64) { const int hh = i / LUTN, k = i % LUTN, d = k - LUTPAD;
            lut[i] = (d < 0) ? 0.f : rel_bias[rel_bucket(d) * 16 + hh] * LOG2E; }
    }
    constexpr int NTOT = NLAYER * PT_LAYER + PT_X;
    f32x4 va[16], vb[16]; PItem pa, pb;
    int it = gw;
    if (it < NTOT) { pa = pro_decode(it, a, ws, outb); pro_load(va, pa, F.lane); }
    while (it < NTOT) {
        const int i1 = it + NGW; if (i1 < NTOT) { pb = pro_decode(i1, a, ws, outb); pro_load(vb, pb, F.lane); }
        pro_process(va, pa, scr, F.lane, ws, ws + WS_X8);
        if (i1 >= NTOT) break;
        const int i2 = i1 + NGW; if (i2 < NTOT) { pa = pro_decode(i2, a, ws, outb); pro_load(va, pa, F.lane); }
        pro_process(vb, pb, scr, F.lane, ws, ws + WS_X8);
        it = i2;
    }
}

__device__ __forceinline__ void phase_swa_select(Frame& F, const Args& a, int l) {
    using namespace att;
    const bool tailwg = (F.G == 256) && (blockIdx.x < 64);
    if (F.G == 256) {
        unsigned char* ws_ = F.ws; unsigned char* wb_ = (l == 0) ? (unsigned char*)F.out + DO_W : ws_ + WS_W;
        pg8::Gemm g{F8_G1 ? ws_ + WS_X8 : ws_ + WS_XB, wb_ + OFF_WIN, F8_G1 ? D : 2 * D, F8_G1 ? D : 2 * D, F8_G1 ? D : 2 * D, 0}; pg8::StaticOrder S; S.init_single((int)blockIdx.x, 16, tailwg);
        if (tailwg) { proj_consts((LAS float*)(F.lds + L_RSTD), a.in[5] + l * 64, a.in[6] + l * 64, a.in[7] + l * 64, a.in[8] + l * 64, a.in[4] + l * 2048); rstd_table((LAS float*)(F.lds + L_RSTD), (const float*)(ws_ + WS_SSQ), (int)blockIdx.x, F8_G1 ? 1.0f / F8_SW : 1.0f); }
        pg8::EpiProj E{(const LAS float*)(F.lds + L_RSTD), (bf16_t*)(ws_ + WS_QA), (bf16_t*)(ws_ + WS_KA), (bf16_t*)(ws_ + WS_VA), (bf16_t*)(ws_ + WS_QB), (bf16_t*)(ws_ + WS_KB), (bf16_t*)(ws_ + WS_VB), (bf16_t*)(ws_ + WS_GT), (float*)(ws_ + WS_KMP)};
        if (tailwg) pg8::gemm_phase<F8_G1 != 0, pg8::EpiProj>(F.lds, g, S, E);
    }
    unsigned char* ws = F.ws; LAS unsigned char* lds = F.lds;
    const int tid = F.tid, lane = F.lane, wave = F.wave, r32 = lane & 31, hi = lane >> 5;
    const bf16_t* Qb = (const bf16_t*)(ws + WS_QB); const bf16_t* Kb = (const bf16_t*)(ws + WS_KB); const bf16_t* Vb = (const bf16_t*)(ws + WS_VB);
    unsigned char* Y = (unsigned char*)F.out + DO_Y;
    const float* lutg = (const float*)(ws + WS_LUT); const float* sinks = a.in[9] + l * 8;
    LAS float* lut = (LAS float*)(lds + L_LUT); LAS float* wsf = (LAS float*)(lds + L_WSF) + wave * 64; LAS bf16_t* stg = (LAS bf16_t*)(lds + L_OST) + wave * 2048;
    const int bxi = (int)blockIdx.x; const bool swa_split = (F.G == 256);
    for (int ui = 0; ui < 2; ++ui) {
        int unit, gi_lo = 0, gi_hi = 16;
        if (swa_split) { if (tailwg) break;
            if (ui == 0) unit = bxi;
            else if (bxi < 128) { unit = bxi - 64; gi_hi = 8; }
            else if (bxi < 192) { unit = bxi - 128; gi_lo = 8; }
            else break; }
        else { if (ui == 1) break; unit = F.vcu; if (unit >= 256) break; }
        const int kvh = unit >> 7, c = unit & 127;
        bf16x8 qsw[2][4];
#pragma unroll
        for (int k2 = 0; k2 < 2; ++k2) { const int gi_ = gi_lo + wave + 8 * k2; const int gg_ = gi_ < gi_hi ? gi_ : gi_lo + wave;
            load_q(qsw[k2], Qb + (size_t)(128 * c + 32 * (gg_ & 3) + r32) * 512 + (kvh * 4 + (gg_ >> 2)) * 64, hi); }
        __syncthreads();
        load_kv(lds, Kb + kvh * 64, Vb + kvh * 64, 128, 128 * c - 128, tid);
        for (int i = tid; i < 4 * 512; i += 512) lut4_put(lut + (i >> 9) * 2048, 512, i & 511, lutg[(size_t)(8 + kvh * 4 + (i >> 9)) * LUTN + (i & 511)]);
        __syncthreads();
        for (int gi = gi_lo + wave; gi < gi_hi; gi += 8) {
            const int hl = gi >> 2, g = gi & 3, hq = kvh * 4 + hl, q = 128 * c + 32 * g + r32;
            bf16x8 qr[4];
#pragma unroll
            for (int d0 = 0; d0 < 4; ++d0) qr[d0] = (gi - gi_lo - wave) ? qsw[1][d0] : qsw[0][d0];
            f32x16 o[2];
#pragma unroll
            for (int r = 0; r < 16; ++r) { o[0][r] = 0.f; o[1][r] = 0.f; }
            float lsum = 0.f; const unsigned dmax = (unsigned)(q < 127 ? q : 127);
            const int t0 = g < 2 ? 0 : 1; const LutLane LL = lut_lane(lut + hl * 2048, 512, 512, r32 - 4 * hi);
            for (int t = t0; t < t0 + 3; ++t)
                tile<true, true>(o, lsum, qr, lds + L_K + t * 8192, lds + L_V + t * 8192, 0.f, LL, 32 * g + r32 + 128 - 64 * t, dmax, r32, hi, lane, t != t0 + 1 || c == 0);
            lsum += __shfl_xor(lsum, 32);
            lsum += __builtin_amdgcn_exp2f(sinks[hq] * LOG2E);
            if (hi == 0) wsf[r32] = lsum;
            stage_o(stg, o, r32, hi);
            LDS_WAIT(); asm volatile("" ::: "memory");
#pragma unroll
            for (int i = 0; i < 4; ++i) { const int row = i * 8 + (lane >> 3), ch = lane & 7;
                const u32x4 v = *(const LAS u32x4*)(stg + row * 64 + ch * 8); float f[8]; unpack8(f, v);
                const float inv = F8_SY / wsf[row];
#pragma unroll
                for (int e = 0; e < 8; ++e) f[e] *= inv;
                const size_t yo = (size_t)(128 * c + 32 * g + row) * 1024 + 512 + hq * 64 + ch * 8;
                if (F8_G2) *(u32x2*)(Y + yo) = pack8f8(f); else *(u32x4*)(Y + 2 * yo) = pack8(f); }
            LDS_WAIT(); asm volatile("" ::: "memory");
        }
    }
    const bf16_t* Qa = (const bf16_t*)(ws + WS_QA); const float* kmp = (const float*)(ws + WS_KMP);
    unsigned* cursor = (unsigned*)(ws + WS_CUR) + l * 512; unsigned short* lists = (unsigned short*)(ws + WS_LISTS);
    LAS unsigned* hist = (LAS unsigned*)(lds + L_SM); LAS unsigned* lbase = hist + 64;
    int sel0, selstep, selend;
    if (F.G == 256) { const int bx_ = (int)blockIdx.x;
        if (bx_ < 64) { sel0 = bx_; selstep = 512; selend = 64; }
        else if (bx_ < 192) { sel0 = bx_; selstep = 128; selend = 320; }
        else { sel0 = 320 + (bx_ - 192); selstep = 64; selend = 512; } }
    else { sel0 = F.vcu; selstep = F.G; selend = 512; }
    f32x4 kmr[4]; bf16x8 qsel[4];
#define SEL_FETCH(unit_) do { const int h_ = (unit_) >> 6, qb_ = (unit_) & 63; const float* p_ = kmp + ((size_t)(h_ * 64 + (tid >> 3)) * 2) * 64 + (tid & 7) * 8; \
        kmr[0] = *(const f32x4*)(p_); kmr[1] = *(const f32x4*)(p_ + 4); kmr[2] = *(const f32x4*)(p_ + 64); kmr[3] = *(const f32x4*)(p_ + 68); \
        load_q(qsel, Qa + (size_t)(qb_ * 256 + 32 * wave + r32) * 512 + h_ * 64, hi); } while (0)
    if (sel0 < selend) SEL_FETCH(sel0);
    for (int unit = sel0; unit < selend; unit += selstep) {
        const int h = unit >> 6, qb = unit & 63;
        __syncthreads();
        { const int j = tid >> 3, cch = tid & 7;
          float hi8[8], lo8[8];
#pragma unroll
          for (int e = 0; e < 8; ++e) { const float km = (kmr[e >> 2][e & 3] + kmr[2 + (e >> 2)][e & 3]) * (1.0f / 256.0f); const unsigned hb = f2bf(km); const float hf = __builtin_bit_cast(float, hb << 16); hi8[e] = hf; lo8[e] = km - hf; }
          *(LAS u32x4*)(lds + L_K + kswz(j, cch)) = pack8(hi8); *(LAS u32x4*)(lds + L_K + 8192 + kswz(j, cch)) = pack8(lo8); }
        if (tid < 64) hist[tid] = 0u;
        __syncthreads();
        const int q = qb * 256 + 32 * wave + r32;
        int i1 = 255, i2 = 255, i3 = 255;
        {
            bf16x8 qr[4];
#pragma unroll
            for (int d0 = 0; d0 < 4; ++d0) qr[d0] = qsel[d0];
            if (unit + selstep < selend) SEL_FETCH(unit + selstep);
            f32x16 p0, p1;
#pragma unroll
            for (int r = 0; r < 16; ++r) { p0[r] = 0.f; p1[r] = 0.f; }
            qkt(p0, p1, lds + L_K, qr, r32, hi); qkt(p0, p1, lds + L_K + 8192, qr, r32, hi);
            float v1 = -INFINITY, v2 = -INFINITY, v3 = -INFINITY;
#define TOP_INS(v_, i_) do { const float vv = (v_); const int ii = (i_); if (vv > v3) { if (vv > v2) { v3 = v2; i3 = i2; if (vv > v1) { v2 = v1; i2 = i1; v1 = vv; i1 = ii; } else { v2 = vv; i2 = ii; } } else { v3 = vv; i3 = ii; } } } while (0)
#pragma unroll
            for (int r = 0; r < 16; ++r) { const int j0 = crow(r, hi), j1 = 32 + j0;
                TOP_INS(j0 < qb ? p0[r] : -INFINITY, j0); TOP_INS(j1 < qb ? p1[r] : -INFINITY, j1); }
            const float w1 = __shfl_xor(v1, 32), w2 = __shfl_xor(v2, 32), w3 = __shfl_xor(v3, 32);
            const int k1 = __shfl_xor(i1, 32), k2 = __shfl_xor(i2, 32), k3 = __shfl_xor(i3, 32);
            TOP_INS(w1, k1); TOP_INS(w2, k2); TOP_INS(w3, k3);
#undef TOP_INS
            if (hi == 0) {
                if (i1 < 64) __hip_atomic_fetch_add(hist + i1, 1u, __ATOMIC_RELAXED, __HIP_MEMORY_SCOPE_WORKGROUP);
                if (i2 < 64) __hip_atomic_fetch_add(hist + i2, 1u, __ATOMIC_RELAXED, __HIP_MEMORY_SCOPE_WORKGROUP);
                if (i3 < 64) __hip_atomic_fetch_add(hist + i3, 1u, __ATOMIC_RELAXED, __HIP_MEMORY_SCOPE_WORKGROUP);
            }
        }
        __syncthreads();
        if (tid < 64) { const unsigned c = hist[tid]; unsigned bs = 0u; if (c) bs = __hip_atomic_fetch_add(cursor + h * 64 + tid, c, __ATOMIC_RELAXED, __HIP_MEMORY_SCOPE_AGENT); lbase[tid] = bs; hist[tid] = 0u; }
        __syncthreads();
        if (hi == 0) {
            const int pick[3] = {i1, i2, i3};
#pragma unroll
            for (int s = 0; s < 3; ++s) { const int j = pick[s];
                if (j < 64) { const unsigned rk = __hip_atomic_fetch_add(hist + j, 1u, __ATOMIC_RELAXED, __HIP_MEMORY_SCOPE_WORKGROUP);
                    lists[(size_t)h * LIST_HEAD + 256 * (63 * j - (j * (j - 1)) / 2) + lbase[j] + rk] = (unsigned short)(q | (s << 14)); } }
        }
    }
#undef SEL_FETCH
}

__device__ __forceinline__ void phase_moba_past(Frame& F, const Args& a, int l) {
    using namespace att;
    constexpr int PCH = 512;
    unsigned char* ws = F.ws; LAS unsigned char* lds = F.lds;
    const int tid = F.tid, lane = F.lane, wave = F.wave, r32 = lane & 31, hi = lane >> 5;
    const bf16_t* Qa = (const bf16_t*)(ws + WS_QA); const bf16_t* Ka = (const bf16_t*)(ws + WS_KA); const bf16_t* Va = (const bf16_t*)(ws + WS_VA);
    const unsigned* cursor = (const unsigned*)(ws + WS_CUR) + l * 512; const unsigned short* lists = (const unsigned short*)(ws + WS_LISTS);
    bf16_t* Po = (bf16_t*)(ws + WS_PO); float* Pl = (float*)(ws + WS_PL);
    const float* lutg = (const float*)(ws + WS_LUT);
    LAS float* lut = (LAS float*)(lds + L_LUT); LAS bf16_t* stg = (LAS bf16_t*)(lds + L_OST) + wave * 2048;
    LAS unsigned* pfx = (LAS unsigned*)(lds + L_TAB); LAS unsigned* nls = pfx + 512; LAS unsigned* pfs = pfx + 1024;
    LAS unsigned* scan = (LAS unsigned*)(lds + L_SM);
    __syncthreads();
    const int nlist = (int)cursor[tid];
    const int nrem = nlist % PCH, nbig = nlist / PCH + (nrem > PCH / 2 ? 1 : 0), nsml = (nrem > 0 && nrem <= PCH / 2) ? 1 : 0;
    int inc = nbig | (nsml << 16);
#pragma unroll
    for (int o = 1; o < 64; o <<= 1) { const int v = __shfl_up(inc, o); if (lane >= o) inc += v; }
    if (lane == 63) scan[wave] = (unsigned)inc;
    __syncthreads();
    { int base = 0; for (int w = 0; w < wave; ++w) base += (int)scan[w]; const int tot_ = base + inc; pfx[tid] = (unsigned)(tot_ & 0xffff); pfs[tid] = (unsigned)(tot_ >> 16); nls[tid] = (unsigned)nlist; }
    int totb = 0; for (int w = 0; w < 8; ++w) totb += (int)scan[w];
    totb = __builtin_amdgcn_readfirstlane(totb);
    const int nbigtot = totb & 0xffff; const int total = nbigtot + (totb >> 16);
    __syncthreads();
    u32x4 kreg[4], vreg[4]; float lreg[5];
    const int lw = tid >> 6, kr = lw * 8 + (lane >> 3), kc8 = lane & 7;
#define PAST_FETCH(h_, j_) do { \
        const bf16_t* Kg_ = Ka + (h_) * 64 + (size_t)((j_) * 256) * 512; const bf16_t* Vg_ = Va + (h_) * 64 + (size_t)((j_) * 256) * 512; \
        _Pragma("unroll") for (int t = 0; t < 4; ++t) { kreg[t] = *(const u32x4*)(Kg_ + (size_t)(64 * t + kr) * 512 + kc8 * 8); \
            vreg[t] = *(const u32x4*)(Vg_ + (size_t)(64 * t + 16 * (lw & 3) + (lane >> 2)) * 512 + (lw >> 2) * 32 + (lane & 3) * 8); } \
        _Pragma("unroll") for (int i = 0; i < 5; ++i) { const int ix = tid + 512 * i; lreg[i] = lutg[(size_t)(h_) * LUTN + (ix < LUTN ? ix : LUTN - 1)]; } } while (0)
#define PAST_DEC(it_, h_, j_, k_, n_) int h_, j_, k_, n_; { const bool big_ = (it_) < nbigtot; const int iq_ = big_ ? (it_) : (it_) - nbigtot; const LAS unsigned* px_ = big_ ? pfx : pfs; \
        int lo_ = 0, hi_ = 511; while (lo_ < hi_) { const int mid_ = (lo_ + hi_) >> 1; if ((int)px_[mid_] > iq_) hi_ = mid_; else lo_ = mid_ + 1; } \
        h_ = lo_ >> 6; j_ = lo_ & 63; k_ = big_ ? iq_ - (lo_ ? (int)pfx[lo_ - 1] : 0) : (int)nls[lo_] / PCH; n_ = (int)nls[lo_] - PCH * k_; n_ = n_ > PCH ? PCH : n_; \
        h_ = __builtin_amdgcn_readfirstlane(h_); j_ = __builtin_amdgcn_readfirstlane(j_); k_ = __builtin_amdgcn_readfirstlane(k_); n_ = __builtin_amdgcn_readfirstlane(n_); }
#define PAST_LP(h_, j_, k_) (lists + (size_t)(h_) * LIST_HEAD + 256 * (63 * (j_) - ((j_) * ((j_) - 1)) / 2) + (k_) * PCH)
#define WG_BAR() asm volatile("s_waitcnt lgkmcnt(0)\n\ts_barrier" ::: "memory")
    int it = F.vcu, itn = F.vcu + F.G, par = 0;
    unsigned* qctr = (unsigned*)(ws + WS_CTL) + 8192 + 64 * l;
    LAS unsigned* nslot = (LAS unsigned*)(lds + L_SM + 128);
    if (tid == 0) nslot[0] = 2u * (unsigned)F.G + __hip_atomic_fetch_add(qctr, 1u, __ATOMIC_RELAXED, __HIP_MEMORY_SCOPE_AGENT);
    unsigned ec0 = 0u, ec1 = 0u; bf16x8 qr_c[4]; int hprev = -1;
#pragma unroll
    for (int d0 = 0; d0 < 4; ++d0) qr_c[d0] = (bf16x8){0, 0, 0, 0, 0, 0, 0, 0};
    int h = 0, j = 0, kc = 0, n = 0;
    if (it < total) { PAST_DEC(it, h0, j0, k0, n0); h = h0; j = j0; kc = k0; n = n0; const int idx0 = wave * 32 + r32; const unsigned short* lp0 = PAST_LP(h0, j0, k0);
        ec0 = lp0[idx0 < n0 ? idx0 : 0]; ec1 = lp0[idx0 + 256 < n0 ? idx0 + 256 : 0]; PAST_FETCH(h0, j0); load_q(qr_c, Qa + (size_t)(ec0 & 0x3fffu) * 512 + h0 * 64, hi); }
    for (; it < total; ) {
        WG_BAR();
#pragma unroll
        for (int t = 0; t < 4; ++t) { *(LAS u32x4*)(lds + L_K + t * 8192 + kswz(kr, kc8)) = kreg[t]; *(LAS u32x4*)(lds + L_V + t * 8192 + lw * 1024 + lane * 16) = vreg[t]; }
        if (h != hprev) {
#pragma unroll
            for (int i = 0; i < 5; ++i) { const int ix = tid + 512 * i; if (ix < LUTN) lut4_put(lut, LUTN, ix, lreg[i]); }
            hprev = h; }
        WG_BAR();
        const int itnn = __builtin_amdgcn_readfirstlane((int)nslot[par]);
        unsigned tk = 0u; if (tid == 0) tk = 2u * (unsigned)F.G + __hip_atomic_fetch_add(qctr, 1u, __ATOMIC_RELAXED, __HIP_MEMORY_SCOPE_AGENT);
        const bool hn = itn < total; unsigned en0 = 0u, en1 = 0u; int hnx = 0, jnx = 0, knx = 0, nnx = 0;
        if (hn) { PAST_DEC(itn, h1, j1, k1, n1); const int idx1 = wave * 32 + r32; hnx = h1; jnx = j1; knx = k1; nnx = n1; const unsigned short* lp1 = PAST_LP(h1, j1, k1);
            en0 = lp1[idx1 < n1 ? idx1 : 0]; en1 = lp1[idx1 + 256 < n1 ? idx1 + 256 : 0]; PAST_FETCH(h1, j1); }
        const float cbias = lut[LUTN - 1];
        const bool act1 = (wave + 8) * 32 < n;
#pragma unroll 1
        for (int gi = 0; gi < 2; ++gi) {
            const int g = wave + 8 * gi;
            const bool nx_same = (gi == 0) && act1; const bool nx_any = nx_same || hn;
            const unsigned nx_ent = nx_same ? ec1 : en0; const int nx_h = nx_same ? h : hnx;
            const bf16_t* nx_q = Qa + (size_t)(nx_ent & 0x3fffu) * 512 + nx_h * 64;
            if (g * 32 < n) {
                const unsigned ent_c = gi ? ec1 : ec0;
                const int idx = g * 32 + r32; const bool valid = idx < n;
                const int q = (int)(ent_c & 0x3fffu), s = (int)(ent_c >> 14);
                f32x16 o[2];
#pragma unroll
                for (int r = 0; r < 16; ++r) { o[0][r] = 0.f; o[1][r] = 0.f; }
                float lsum = 0.f;
                const int dfirst = q - j * 256;
                const LutLane LL = lut_lane(lut, LUTN, LUTN, dfirst - 4 * hi);
                bf16x8 qr_n[4];
#pragma unroll
                for (int d0 = 0; d0 < 4; ++d0) qr_n[d0] = qr_c[d0];
                if (__all(dfirst - 255 >= 1513)) {
#pragma unroll 1
                    for (int t = 0; t < 4; ++t) { tile<false, false>(o, lsum, qr_c, lds + L_K + t * 8192, lds + L_V + t * 8192, cbias, LL, dfirst - 64 * t, 0u, r32, hi, lane);
                        if (t == 1 && nx_any) load_q(qr_n, nx_q, hi); }
                } else {
#pragma unroll 1
                    for (int t = 0; t < 4; ++t) { tile<true, false>(o, lsum, qr_c, lds + L_K + t * 8192, lds + L_V + t * 8192, 0.f, LL, dfirst - 64 * t, 0u, r32, hi, lane);
                        if (t == 1 && nx_any) load_q(qr_n, nx_q, hi); }
                }
                lsum += __shfl_xor(lsum, 32);
                if (hi == 0 && valid) Pl[(size_t)(s * 8 + h) * M + q] = lsum;
                stage_o(stg, o, r32, hi);
                LDS_WAIT(); asm volatile("" ::: "memory");
#pragma unroll
                for (int i = 0; i < 4; ++i) { const int row = i * 8 + (lane >> 3), ch = lane & 7;
                    const u32x4 v = *(const LAS u32x4*)(stg + row * 64 + ch * 8);
                    const unsigned en = (unsigned)__shfl((int)ent_c, row);
                    if (g * 32 + row < n) { const int qq = (int)(en & 0x3fffu), ss = (int)(en >> 14);
                        *(u32x4*)(Po + ((size_t)(ss * 8 + h) * M + qq) * 64 + ch * 8) = v; } }
                LDS_WAIT(); asm volatile("" ::: "memory");
#pragma unroll
                for (int d0 = 0; d0 < 4; ++d0) qr_c[d0] = qr_n[d0];
            } else if (gi == 0 && nx_any) load_q(qr_c, nx_q, hi);
        }
        ec0 = en0; ec1 = en1; h = hnx; j = jnx; kc = knx; n = nnx;
        if (tid == 0) nslot[par ^ 1] = tk;
        par ^= 1; it = itn; itn = itnn;
    }
#undef WG_BAR
#undef PAST_FETCH
#undef PAST_DEC
#undef PAST_LP
}

__device__ __forceinline__ void phase_moba_own(Frame& F, const Args& a, int l) {
    using namespace att;
    unsigned char* ws = F.ws; LAS unsigned char* lds = F.lds;
    const int tid = F.tid, lane = F.lane, wave = F.wave, r32 = lane & 31, hi = lane >> 5;
    const bf16_t* Qa = (const bf16_t*)(ws + WS_QA); const bf16_t* Ka = (const bf16_t*)(ws + WS_KA); const bf16_t* Va = (const bf16_t*)(ws + WS_VA);
    const bf16_t* Po = (const bf16_t*)(ws + WS_PO); const float* Pl = (const float*)(ws + WS_PL);
    unsigned char* Y = (unsigned char*)F.out + DO_Y;
    const float* lutg = (const float*)(ws + WS_LUT);
    LAS float* lut = (LAS float*)(lds + L_LUT); LAS float* wsf = (LAS float*)(lds + L_WSF) + wave * 64; LAS bf16_t* stg = (LAS bf16_t*)(lds + L_OST) + wave * 2048;
#define WG_BAR() asm volatile("s_waitcnt lgkmcnt(0)\n\ts_barrier" ::: "memory")
    u32x4 kreg[4], vreg[4]; float lreg;
    const int lw = tid >> 6, kr = lw * 8 + (lane >> 3), kc8 = lane & 7;
#define OWN_FETCH(unit_) do { const int h_ = (unit_) >> 6, qb_ = (unit_) & 63; \
        const bf16_t* Kg_ = Ka + h_ * 64 + (size_t)(qb_ * 256) * 512; const bf16_t* Vg_ = Va + h_ * 64 + (size_t)(qb_ * 256) * 512; \
        _Pragma("unroll") for (int t = 0; t < 4; ++t) { kreg[t] = *(const u32x4*)(Kg_ + (size_t)(64 * t + kr) * 512 + kc8 * 8); \
            vreg[t] = *(const u32x4*)(Vg_ + (size_t)(64 * t + 16 * (lw & 3) + (lane >> 2)) * 512 + (lw >> 2) * 32 + (lane & 3) * 8); } \
        lreg = lutg[(size_t)h_ * LUTN + tid]; } while (0)
    int unit = F.vcu;
    if (unit < 512) OWN_FETCH(unit);
    for (; unit < 512; unit += F.G) {
        const int h = unit >> 6, qb = unit & 63, nsl = qb < 3 ? qb : 3;
        const int q = qb * 256 + 32 * wave + r32;
        bf16x8 qr[4]; load_q(qr, Qa + (size_t)q * 512 + h * 64, hi);
        u32x4 pov[4][3]; float plv[4][3];
#pragma unroll
        for (int i = 0; i < 4; ++i) { const int row = i * 8 + (lane >> 3), ch = lane & 7, qq = qb * 256 + 32 * wave + row;
#pragma unroll
            for (int s = 0; s < 3; ++s) { const size_t pi = (size_t)(s * 8 + h) * M + qq;
                if (s < nsl) { plv[i][s] = Pl[pi]; pov[i][s] = __builtin_nontemporal_load((const u32x4*)(Po + pi * 64 + ch * 8)); } else { plv[i][s] = 0.f; pov[i][s] = (u32x4){0u, 0u, 0u, 0u}; } } }
        WG_BAR();
#pragma unroll
        for (int t = 0; t < 4; ++t) { *(LAS u32x4*)(lds + L_K + t * 8192 + kswz(kr, kc8)) = kreg[t]; *(LAS u32x4*)(lds + L_V + t * 8192 + lw * 1024 + lane * 16) = vreg[t]; }
        lut4_put(lut, 512, tid, lreg);
        WG_BAR();
        if (unit + F.G < 512) OWN_FETCH(unit + F.G);
        f32x16 o[2];
#pragma unroll
        for (int r = 0; r < 16; ++r) { o[0][r] = 0.f; o[1][r] = 0.f; }
        float lsum = 0.f; const int nt = (wave >> 1) + 1; const LutLane LL = lut_lane(lut, 512, 512, r32 - 4 * hi);
#pragma unroll 1
        for (int t = 0; t < nt; ++t)
            tile<true, true>(o, lsum, qr, lds + L_K + t * 8192, lds + L_V + t * 8192, 0.f, LL, 32 * wave + r32 - 64 * t, 0x7fffffffu, r32, hi, lane, t == nt - 1);
        lsum += __shfl_xor(lsum, 32);
        if (hi == 0) wsf[r32] = lsum;
        stage_o(stg, o, r32, hi);
        LDS_WAIT(); asm volatile("" ::: "memory");
#pragma unroll
        for (int i = 0; i < 4; ++i) { const int row = i * 8 + (lane >> 3), ch = lane & 7, qq = qb * 256 + 32 * wave + row;
            const u32x4 v = *(const LAS u32x4*)(stg + row * 64 + ch * 8); float f[8]; unpack8(f, v);
            float L = wsf[row];
#pragma unroll
            for (int s = 0; s < 3; ++s) { L += plv[i][s]; float pf[8]; unpack8(pf, pov[i][s]);
#pragma unroll
                for (int e = 0; e < 8; ++e) f[e] += pf[e]; }
            const float inv = F8_SY / L;
#pragma unroll
            for (int e = 0; e < 8; ++e) f[e] *= inv;
            const size_t yo = (size_t)qq * 1024 + h * 64 + ch * 8;
            if (F8_G2) *(u32x2*)(Y + yo) = pack8f8(f); else *(u32x4*)(Y + 2 * yo) = pack8(f); }
        LDS_WAIT(); asm volatile("" ::: "memory");
    }
#undef OWN_FETCH
#undef WG_BAR
}

__global__ void __launch_bounds__(512, 2) fwd_kernel(Args args) {
    extern __shared__ __attribute__((aligned(16))) unsigned char lds_raw[];
    Frame F;
    F.lds = (LAS unsigned char*)lds_raw;
    F.tid = threadIdx.x; F.lane = F.tid & 63; F.wave = __builtin_amdgcn_readfirstlane(F.tid >> 6);
    F.G = gridDim.x; { const int bx = blockIdx.x; F.vcu = (F.G % 8 == 0) ? (bx % 8) * (F.G / 8) + bx / 8 : bx; }
    F.ws = args.ws; F.out = args.out;
    unsigned char* ws = args.ws;
    volatile LAS unsigned* MISC = (volatile LAS unsigned*)(F.lds + MISC_OFF);
    for (int u = F.tid; u < (LDS_BYTES - LDSCTL_OFF) / 4; u += 512) ((LAS unsigned*)(F.lds + LDSCTL_OFF))[u] = 0u;
    __syncthreads();
    XcdBarrier bar; bar.bar = (unsigned*)(ws + WS_CTL) + 4096; bar.x = 0; bar.st = nullptr;
    const bool multi = (args.ph_hi - args.ph_lo) > 1;
    if (multi) bar = xcd_barrier_post((unsigned*)(ws + WS_CTL) + 4096, MISC + 8);

    const int lo = args.ph_lo, hi = args.ph_hi;
    float* ssq = (float*)(ws + WS_SSQ);
#ifndef PH_MASK
#define PH_MASK 0x1ffff
#endif
#define IN(k) (lo <= (k) && (k) < hi && ((PH_MASK >> ((k) > 8 ? (k) - 8 : (k))) & 1))
#define SEAM(k) do { if (IN(k) && IN((k) + 1)) xcd_barrier(bar); } while (0)
#ifndef REP_MASK
#define REP_MASK 0
#endif
#define RUN(p, l, X) do { if (IN(1 + NPH * (l) + (p))) { X; if ((REP_MASK >> (p)) & 1) { xcd_barrier(bar); X; } } SEAM(1 + NPH * (l) + (p)); } while (0)
#define WB(l) ((l) == 0 ? (unsigned char*)args.out + DO_W : ws + WS_W)
#define PH_G1(l) do { \
        pg8::Gemm g{F8_G1 ? ws + WS_X8 : ws + WS_XB, WB(l) + OFF_WIN, F8_G1 ? D : 2 * D, F8_G1 ? D : 2 * D, F8_G1 ? D : 2 * D, 0}; pg8::StaticOrder S; S.init(M, INW - 256, F.G, (int)blockIdx.x, 1); \
        const int pm0_ = S.first_pm(); const LAS float* rt_ = (const LAS float*)(F.lds + L_RSTD); proj_consts((LAS float*)(F.lds + L_RSTD), args.in[5] + (l) * 64, args.in[6] + (l) * 64, args.in[7] + (l) * 64, args.in[8] + (l) * 64, args.in[4] + (l) * 2048); rstd_table((LAS float*)(F.lds + L_RSTD), ssq, pm0_ < 0 ? 0 : pm0_, F8_G1 ? 1.0f / F8_SW : 1.0f); \
        pg8::EpiProj E{rt_, (bf16_t*)(ws + WS_QA), (bf16_t*)(ws + WS_KA), (bf16_t*)(ws + WS_VA), (bf16_t*)(ws + WS_QB), (bf16_t*)(ws + WS_KB), (bf16_t*)(ws + WS_VB), (bf16_t*)(ws + WS_GT), (float*)(ws + WS_KMP)}; \
        pg8::gemm_phase<F8_G1 != 0, pg8::EpiProj>(F.lds, g, S, E); } while (0)
#define PH_G2(l) do { \
        pg8::Gemm g{(unsigned char*)args.out + DO_Y, WB(l) + OFF_WBR, F8_G2 ? D : 2 * D, F8_G2 ? D : 2 * D, F8_G2 ? 512 : 1024, F8_G2 ? 512 : 1024}; pg8::StaticOrder S; S.init(M, D, F.G, (int)blockIdx.x, 2); \
        pg8::EpiMerge E{(const bf16_t*)(ws + WS_GT), ws + WS_MRG}; \
        pg8::gemm_phase<F8_G2 != 0, pg8::EpiMerge>(F.lds, g, S, E); } while (0)
#define PH_G3(l) do { \
        pg8::Gemm g{ws + WS_MRG, WB(l) + OFF_WOUT, F8_G3 ? D : 2 * D, F8_G3 ? D : 2 * D, F8_G3 ? D : 2 * D, 0}; pg8::StaticOrder S; S.init(M, D, F.G, (int)blockIdx.x, 1); \
        pg8::EpiResid E{(bf16_t*)(ws + WS_XB), ssq, nullptr, 1.0f / (F8_SM * F8_SW3), nullptr}; \
        pg8::gemm_phase<F8_G3 != 0, pg8::EpiResid>(F.lds, g, S, E); } while (0)
#define PH_G4(l) do { \
        pg8::Gemm g{ws + WS_XB, WB(l) + OFF_W1, 2 * D, 2 * D, 2 * D, 0}; pg8::StaticOrder S; S.init(M, FF, F.G, (int)blockIdx.x, 1); \
        const int pm0_ = S.first_pm(); const LAS float* rt_ = (const LAS float*)(F.lds + L_RSTD); rstd_table((LAS float*)(F.lds + L_RSTD), ssq, pm0_ < 0 ? 0 : pm0_, 1.0f); \
        pg8::EpiFfnUp E{rt_, (bf16_t*)(ws + WS_U)}; \
        pg8::gemm_phase<false, pg8::EpiFfnUp>(F.lds, g, S, E); } while (0)
#define PH_G5(l) do { \
        pg8::Gemm g{ws + WS_U, WB(l) + OFF_W2, 2 * FF, 2 * FF, 2 * FF, 0}; pg8::StaticOrder S; S.init(M, D, F.G, (int)blockIdx.x, 1); \
        pg8::EpiResid E{(bf16_t*)(ws + WS_XB), ssq, (l) == NLAYER - 1 ? args.out : nullptr, 1.0f, (l) == NLAYER - 1 || !F8_G1 ? nullptr : ws + WS_X8}; \
        pg8::gemm_phase<false, pg8::EpiResid>(F.lds, g, S, E); } while (0)
#define LAYER(l) do { \
    RUN(0, l, PH_G1(l)); \
    RUN(1, l, phase_swa_select(F, args, (l))); \
    RUN(2, l, phase_moba_past(F, args, (l))); \
    RUN(3, l, phase_moba_own(F, args, (l))); \
    RUN(4, l, PH_G2(l)); \
    if (IN(1 + NPH * (l) + 5)) { PH_G3(l); } SEAM(1 + NPH * (l) + 5); \
    RUN(6, l, PH_G4(l)); \
    if (IN(1 + NPH * (l) + 7)) { PH_G5(l); } SEAM(1 + NPH * (l) + 7); \
    } while (0)
    if (IN(0)) { phase_prologue(F, args); } SEAM(0);
    LAYER(0);
    LAYER(1);
#undef LAYER
#undef RUN
#undef WB
#undef SEAM
#undef IN
}

extern "C" void kernel_launch(void* const* d_in, const int* in_sizes, int n_in, void* d_out, int out_size, void* d_ws, size_t ws_size, hipStream_t stream) {
    static int grid = 0;
    if (grid == 0) {
        if (n_in != 16 || out_size != M * D || ws_size < WS_END) { fprintf(stderr, "kernel_launch: unexpected shapes (n_in %d out %d ws %zu)\n", n_in, out_size, ws_size); grid = -1; return; }
        if (hipFuncSetAttribute((const void*)fwd_kernel, hipFuncAttributeMaxDynamicSharedMemorySize, LDS_BYTES) != hipSuccess) { fprintf(stderr, "kernel_launch: hipFuncSetAttribute failed\n"); grid = -1; return; }
        (void)hipGetLastError();
        grid = 256;
    }
    if (grid < 0) return;
    (void)hipMemsetAsync((char*)d_ws + WS_CTL, 0, CTL_ZERO_BYTES, stream);
    Args a{};
    for (int i = 0; i < 16; ++i) a.in[i] = (const float*)d_in[i];
    a.out = (float*)d_out; a.ws = (unsigned char*)d_ws;
    constexpr int NPHASES = 1 + NLAYER * NPH;
    if (MK_N_LAUNCHES == 1) {
        a.ph_lo = 0; a.ph_hi = NPHASES;
        hipLaunchKernelGGL(fwd_kernel, dim3(grid), dim3(512), LDS_BYTES, stream, a);
    } else {
        for (int p = 0; p < NPHASES; ++p) { a.ph_lo = p; a.ph_hi = p + 1; hipLaunchKernelGGL(fwd_kernel, dim3(grid), dim3(512), LDS_BYTES, stream, a); }
    }
}
```

```cpp
#include <hip/hip_runtime.h>
#include <hip/hip_bf16.h>
#include <cstdint>
#include <cstdio>

#ifndef MK_N_LAUNCHES
#define MK_N_LAUNCHES 1
#endif

#ifndef F8_G1
#define F8_G1 1
#endif
#ifndef F8_G2
#define F8_G2 1
#endif
#ifndef F8_G3
#define F8_G3 0
#endif

#define LAS __attribute__((address_space(3)))
#define GAS __attribute__((address_space(1)))
typedef unsigned short bf16_t;
typedef short bf16x8 __attribute__((ext_vector_type(8)));
typedef float f32x4 __attribute__((ext_vector_type(4)));
typedef float f32x2 __attribute__((ext_vector_type(2)));
typedef float f32x16 __attribute__((ext_vector_type(16)));
typedef unsigned u32x4 __attribute__((ext_vector_type(4)));
typedef unsigned u32x2 __attribute__((ext_vector_type(2)));
typedef short v4i16_t __attribute__((ext_vector_type(4)));
typedef __bf16 bf16x2_t __attribute__((ext_vector_type(2)));
typedef int i32x8 __attribute__((ext_vector_type(8)));
typedef int i32x4 __attribute__((ext_vector_type(4)));

constexpr int M = 16384, D = 1024, INW = 4352, FF = 4096, NLAYER = 2;
constexpr int NPH = 8;
constexpr float NORM_EPS = 1e-6f;
constexpr float LOG2E = 1.4426950408889634f;
constexpr float C2 = 0.125f * LOG2E;
constexpr int LUTN = 2176, LUTPAD = 128;

constexpr size_t MiB = 1u << 20;
constexpr size_t WS_CTL = 0, CTL_ZERO_BYTES = 64 * 1024;
constexpr size_t WS_SSQ = 64 * 1024;
constexpr size_t WS_KMP = WS_SSQ + 1 * MiB;
constexpr size_t WS_LUT = WS_KMP + 256 * 1024;
constexpr size_t WS_CUR = WS_LUT + 256 * 1024;
constexpr size_t WS_PL = WS_CUR + 64 * 1024;
constexpr size_t WS_W = 3 * MiB + 512 * 1024;
constexpr size_t OFF_WIN = 0;
constexpr size_t OFF_WBR = OFF_WIN + (size_t)INW * D * 2;
constexpr size_t OFF_WOUT = OFF_WBR + 2 * MiB;
constexpr size_t OFF_W1 = OFF_WOUT + 2 * MiB;
constexpr size_t OFF_W2 = OFF_W1 + 8 * MiB;
constexpr size_t W_BYTES = OFF_W2 + 8 * MiB;
constexpr size_t WS_XB = WS_W + W_BYTES;
constexpr size_t WS_PROJ = WS_XB + 32 * MiB;
constexpr size_t WS_QA = WS_PROJ, WS_KA = WS_QA + 16 * MiB, WS_VA = WS_KA + 16 * MiB, WS_QB = WS_VA + 16 * MiB;
constexpr size_t WS_KB = WS_QB + 16 * MiB, WS_VB = WS_KB + 4 * MiB, WS_GT = WS_VB + 4 * MiB;
constexpr size_t WS_MRG = WS_PROJ;
constexpr size_t WS_U = WS_PROJ;
constexpr size_t WS_PO = WS_GT + 64 * MiB;
constexpr size_t WS_LISTS = WS_PO + 48 * MiB;
constexpr int LIST_HEAD = 516096;
constexpr size_t WS_END = WS_LISTS + (size_t)8 * LIST_HEAD * 2;
static_assert(WS_END <= 256 * MiB, "ws map");
static_assert(WS_U + (size_t)M * FF * 2 <= WS_PO, "u overlay");
static_assert(WS_PL + 3 * 8 * (size_t)M * 4 <= WS_W, "misc map");
constexpr size_t DO_Y = 0, DO_W = 32 * MiB;
constexpr size_t WS_X8 = WS_PO;

constexpr int RING_BYTES = 131072;
constexpr int LDSCTL_OFF = 145408, MISC_OFF = LDSCTL_OFF + 320;
constexpr int LDS_BYTES = 147456;
constexpr int L_K = 0, L_V = 32768, L_OST = 65536, L_WSF = 98304, L_LUT = 100352, L_TAB = 135168, L_SM = 143360;
constexpr int L_RSTD = 131072;
static_assert(L_RSTD + 2560 * 4 <= LDSCTL_OFF, "epilogue tables");
static_assert(L_LUT + 4 * LUTN * 4 <= L_TAB && L_TAB + 4096 <= L_SM && L_SM + 1024 <= LDSCTL_OFF && MISC_OFF + 128 <= LDS_BYTES, "LDS map");

__device__ __forceinline__ unsigned cvtpk(float lo, float hi) { f32x2 v = {lo, hi}; bf16x2_t b = __builtin_convertvector(v, bf16x2_t); return __builtin_bit_cast(unsigned, b); }
__device__ __forceinline__ float bf_lo(unsigned w) { return __builtin_bit_cast(float, w << 16); }
__device__ __forceinline__ float bf_hi(unsigned w) { return __builtin_bit_cast(float, w & 0xffff0000u); }
__device__ __forceinline__ unsigned f2bf(float f) { unsigned u = __builtin_bit_cast(unsigned, f); return (u + 0x7fffu + ((u >> 16) & 1u)) >> 16; }
__device__ __forceinline__ unsigned pk2(float lo, float hi) { return f2bf(lo) | (f2bf(hi) << 16); }
__device__ __forceinline__ unsigned pk4f8(float a, float b, float c, float d) { int p = __builtin_amdgcn_cvt_pk_fp8_f32(a, b, 0, false); p = __builtin_amdgcn_cvt_pk_fp8_f32(c, d, p, true); return (unsigned)p; }
constexpr float F8_SW = 64.f, F8_SY = F8_G2 ? 16.f : 1.f, F8_SM = F8_G3 ? 16.f : 1.f;
constexpr float F8_SW2 = F8_G2 ? F8_SW : 1.f, F8_SW3 = F8_G3 ? F8_SW : 1.f;

namespace pg8 {
constexpr int BM = 256, BK = 64, HALF = 128, HTB = HALF * BK * 2, NXCD = 8, WGM = 8;
__host__ __device__ __forceinline__ int lds_byte(int r, int c) { const int st = (r >> 4) * 2 + (c >> 5), rr = r & 15, cc = c & 31, ob = rr * 64 + cc * 2; return st * 1024 + (ob ^ (((ob >> 9) & 1) << 5)); }
__host__ __device__ __forceinline__ void stage_rc(int b, int& R, int& C) { const int st = b / 1024, sb = b % 1024, swz = sb ^ (((sb >> 9) & 1) << 5); R = (st >> 1) * 16 + swz / 64; C = (st & 1) * 32 + (swz % 64) / 2; }
__host__ __device__ __forceinline__ int perm32(int rho) { const int n = rho >> 4, i = rho & 15; return 8 * (i >> 2) + 4 * n + (i & 3); }

struct Unit { int pm, pn, part; };
struct Gemm { const void* A; const void* Bt; int lda, ldb, K, kpart; };

struct StaticOrder {
    int nM, nN, nwg, G, c, parts;
    int fixed, fpm, fpn;
    __device__ __forceinline__ void init(int M_, int N_, int G_, int c_, int parts_) { nM = M_ / BM; nN = N_ / BM; nwg = nM * nN; G = G_; c = c_; parts = parts_; fixed = 0; fpm = 0; fpn = 0; }
    __device__ __forceinline__ void init_single(int pm_, int pn_, bool have) { nM = 1; nN = 1; nwg = 1; G = 1; c = 0; parts = 1; fixed = have ? 1 : 2; fpm = pm_; fpn = pn_; }
    __device__ __forceinline__ int first_pm() const {
        if (c >= nwg) return -1;
        int wgid = c; { const int q = nwg / NXCD, r = nwg % NXCD, xcd = wgid % NXCD, off = wgid / NXCD; wgid = (xcd < r ? xcd * (q + 1) : r * (q + 1) + (xcd - r) * q) + off; }
        const int nig = WGM * nN, gid = wgid / nig, fm = gid * WGM, gsz = (nM - fm) < WGM ? (nM - fm) : WGM;
        return fm + ((wgid % nig) % gsz);
    }
    __device__ __forceinline__ bool next(int i, Unit& u) const {
        if (fixed) { u.pm = fpm; u.pn = fpn; u.part = 0; return fixed == 1 && i == 0; }
        const int ti = i / parts; u.part = i - ti * parts;
        const long L = (long)ti * G + c; if (L >= nwg) return false;
        int wgid = (int)L; { const int q = nwg / NXCD, r = nwg % NXCD, xcd = wgid % NXCD, off = wgid / NXCD; wgid = (xcd < r ? xcd * (q + 1) : r * (q + 1) + (xcd - r) * q) + off; }
        const int nig = WGM * nN, gid = wgid / nig, fm = gid * WGM, gsz = (nM - fm) < WGM ? (nM - fm) : WGM;
        u.pm = fm + ((wgid % nig) % gsz); u.pn = (wgid % nig) / gsz; return true;
    }
};

template <bool F8, class Epi>
__device__ __forceinline__ void gemm_phase(LAS unsigned char* lds, const Gemm g, const StaticOrder& S, const Epi& E) {
    const int tid = threadIdx.x, wid = __builtin_amdgcn_readfirstlane(tid >> 6), lane = tid & 63, wr = wid >> 2, wc = wid & 3, fr = lane & 15, fq = lane >> 4;
    const int nt = g.K / 128;
    unsigned voffA, voffB;
    { int R, C; stage_rc(tid * 16, R, C); const int Rb = (R & ~31) + perm32(R & 31); voffA = (unsigned)(R * g.lda + 2 * C); voffB = (unsigned)(Rb * g.ldb + 2 * C); }
    const size_t ivoffA = (size_t)64 * g.lda, ivoffB = (size_t)64 * g.ldb;
    const size_t kstep = (size_t)(BK * 2);
    const size_t hstepA = (size_t)HALF * g.lda, hstepB = (size_t)HALF * g.ldb;
    const size_t tstepA = 2 * hstepA, tstepB = 2 * hstepB;
    const unsigned ldsw = (unsigned)wid * 1024u;
    const int aoff = lds_byte(wr * 64 + fr, fq * 8), boff = lds_byte(wc * 32 + fr, fq * 8);
#define PG8_SA(b, h) (((b) * 2 + (h)) * HTB)
#define PG8_SB(b, h) ((4 + (b) * 2 + (h)) * HTB)
#define PG8_STAGE(bufoff, gbase, voff) do { _Pragma("unroll") for (int _i = 0; _i < 2; ++_i) \
        __builtin_amdgcn_global_load_lds((const unsigned*)((const char*)(gbase) + _i * i##voff + (voff)), (LAS unsigned*)(lds + (bufoff) + ldsw + _i * 8192), 16, 0, 0); } while (0)
#define PG8_LDA(dst, b, h) do { _Pragma("unroll") for (int m = 0; m < 4; ++m) _Pragma("unroll") for (int k = 0; k < 2; ++k) dst[m][k] = *(const LAS bf16x8*)(lds + PG8_SA(b, h) + aoff + m * 2048 + k * 1024); } while (0)
#define PG8_LDB(dst, b, h) do { _Pragma("unroll") for (int n = 0; n < 2; ++n) _Pragma("unroll") for (int k = 0; k < 2; ++k) dst[n][k] = *(const LAS bf16x8*)(lds + PG8_SB(b, h) + boff + n * 2048 + k * 1024); } while (0)
#define PG8_F8CAT(x) __builtin_shufflevector(__builtin_bit_cast(i32x4, x[0]), __builtin_bit_cast(i32x4, x[1]), 0, 1, 2, 3, 4, 5, 6, 7)
#define PG8_MMA(ai, bj, At, Bt) do { __builtin_amdgcn_s_setprio(1); _Pragma("unroll") for (int m = 0; m < 4; ++m) _Pragma("unroll") for (int n = 0; n < 2; ++n) { \
        if (F8) { const i32x8 b8_ = PG8_F8CAT(Bt[n]), a8_ = PG8_F8CAT(At[m]); asm volatile("v_mfma_scale_f32_16x16x128_f8f6f4 %0, %1, %2, %0, %3, %3 op_sel_hi:[0,0,0]" : "+v"(acc[ai][bj][m][n]) : "v"(b8_), "v"(a8_), "v"(f8one)); } \
        else { _Pragma("unroll") for (int k = 0; k < 2; ++k) acc[ai][bj][m][n] = __builtin_amdgcn_mfma_f32_16x16x32_bf16(Bt[n][k], At[m][k], acc[ai][bj][m][n], 0, 0, 0); } } __builtin_amdgcn_s_setprio(0); } while (0)
#define PG8_WAIT_V(n) asm volatile("s_waitcnt vmcnt(" #n ")" ::: "memory")
#define PG8_WAIT_L(n) asm volatile("s_waitcnt lgkmcnt(" #n ")" ::: "memory")
#define PG8_BAR __builtin_amdgcn_s_barrier()
#define PG8_SCHED __builtin_amdgcn_sched_barrier(0)
    Unit cur, nxt; int ui = 0;
    if (!S.next(0, cur)) return;
    const int f8one = 0x7f7f7f7f;
    f32x4 acc[2][2][4][2];
#pragma unroll
    for (int a = 0; a < 2; ++a)
#pragma unroll
        for (int b = 0; b < 2; ++b)
#pragma unroll
            for (int m = 0; m < 4; ++m)
#pragma unroll
                for (int n = 0; n < 2; ++n) acc[a][b][m][n] = (f32x4){0.f, 0.f, 0.f, 0.f};
    bf16x8 At[4][2], B0[2][2], B1[2][2];
    const char* cA = (const char*)g.A + (size_t)cur.pm * tstepA + (size_t)cur.part * g.kpart; const char* cB = (const char*)g.Bt + (size_t)cur.pn * tstepB + (size_t)cur.part * g.kpart;
    PG8_STAGE(PG8_SB(0, 0), cB, voffB); PG8_STAGE(PG8_SB(0, 1), cB + hstepB, voffB); PG8_STAGE(PG8_SA(0, 0), cA, voffA); PG8_STAGE(PG8_SA(0, 1), cA + hstepA, voffA);
    if (wr == 1) PG8_BAR;
    PG8_WAIT_V(2); PG8_BAR;
    PG8_STAGE(PG8_SB(1, 0), cB + kstep, voffB); PG8_STAGE(PG8_SA(1, 0), cA + kstep, voffA); PG8_STAGE(PG8_SB(1, 1), cB + hstepB + kstep, voffB);
    PG8_WAIT_V(6); PG8_BAR;
    for (;;) {
        const bool has_next = S.next(ui + 1, nxt);
        const char* nA = has_next ? (const char*)g.A + (size_t)nxt.pm * tstepA + (size_t)nxt.part * g.kpart : cA;
        const char* nB = has_next ? (const char*)g.Bt + (size_t)nxt.pn * tstepB + (size_t)nxt.part * g.kpart : cB;
#pragma unroll 1
        for (int t = 0; t < nt; t += 2) {
            const bool last = (t == nt - 2);
            const char* a1 = cA + (size_t)(t + 1) * kstep;
            const char* a2 = last ? nA : cA + (size_t)(t + 2) * kstep; const char* b2 = last ? nB : cB + (size_t)(t + 2) * kstep;
            const char* a3 = a2 + kstep; const char* b3 = b2 + kstep;
            PG8_LDB(B0, 0, 0); PG8_LDB(B1, 0, 1); PG8_SCHED; PG8_LDA(At, 0, 0); PG8_STAGE(PG8_SA(1, 1), a1 + hstepA, voffA);
            PG8_WAIT_V(8); PG8_WAIT_L(0); PG8_BAR; PG8_MMA(0, 0, At, B0); PG8_MMA(0, 1, At, B1); PG8_BAR; PG8_SCHED;
            PG8_LDA(At, 0, 1); PG8_STAGE(PG8_SB(0, 0), b2, voffB); PG8_STAGE(PG8_SB(0, 1), b2 + hstepB, voffB); PG8_STAGE(PG8_SA(0, 0), a2, voffA);
            PG8_WAIT_V(8); PG8_WAIT_L(0); PG8_BAR; PG8_MMA(1, 0, At, B0); PG8_MMA(1, 1, At, B1); PG8_BAR; PG8_SCHED;
            PG8_LDB(B0, 1, 0); PG8_LDB(B1, 1, 1); PG8_SCHED; PG8_LDA(At, 1, 0); PG8_STAGE(PG8_SA(0, 1), a2 + hstepA, voffA);
            PG8_WAIT_V(8); PG8_WAIT_L(0); PG8_BAR; PG8_MMA(0, 0, At, B0); PG8_MMA(0, 1, At, B1); PG8_BAR; PG8_SCHED;
            PG8_LDA(At, 1, 1); PG8_STAGE(PG8_SB(1, 0), b3, voffB); PG8_STAGE(PG8_SB(1, 1), b3 + hstepB, voffB); PG8_STAGE(PG8_SA(1, 0), a3, voffA);
            PG8_WAIT_V(8); PG8_WAIT_L(0); PG8_BAR; PG8_MMA(1, 0, At, B0); PG8_MMA(1, 1, At, B1); PG8_BAR; PG8_SCHED;
        }
        if (F8) asm volatile("s_nop 15\n\ts_nop 15" ::: "memory");
        if (wr == 0) PG8_BAR;
        E(acc, cur, wr, wc, fr, fq);
        if (!has_next) break;
        if (!E.keep(cur)) {
#pragma unroll
        for (int a = 0; a < 2; ++a)
#pragma unroll
            for (int b = 0; b < 2; ++b)
#pragma unroll
                for (int m = 0; m < 4; ++m)
#pragma unroll
                    for (int n = 0; n < 2; ++n) acc[a][b][m][n] = (f32x4){0.f, 0.f, 0.f, 0.f};
        }
        cur = nxt; cA = nA; cB = nB; ++ui;
        if (wr == 1) PG8_BAR;
    }
    PG8_WAIT_V(0);
    PG8_BAR;
#undef PG8_SA
#undef PG8_SB
#undef PG8_STAGE
#undef PG8_LDA
#undef PG8_LDB
#undef PG8_MMA
#undef PG8_F8CAT
#undef PG8_WAIT_V
#undef PG8_WAIT_L
#undef PG8_BAR
#undef PG8_SCHED
}

__device__ __forceinline__ float row_rstd(const float* ssq, int row, int fq) {
    const f32x4 s4 = *(const f32x4*)(ssq + (size_t)row * 16 + 4 * fq);
    float s = (s4[0] + s4[1]) + (s4[2] + s4[3]);
    s += __shfl_xor(s, 16); s += __shfl_xor(s, 32);
    return 1.0f / sqrtf(s * (1.0f / 1024.0f) + NORM_EPS);
}
__device__ __forceinline__ void store8(bf16_t* p, const f32x4 a, const f32x4 b) {
    u32x4 w; w.x = cvtpk(a[0], a[1]); w.y = cvtpk(a[2], a[3]); w.z = cvtpk(b[0], b[1]); w.w = cvtpk(b[2], b[3]); *(u32x4*)p = w;
}

struct EpiProj {
    const LAS float* rtab; bf16_t *Qa, *Ka, *Va, *Qb, *Kb, *Vb, *Gt; float* kmp;
    __device__ __forceinline__ bool keep(const Unit&) const { return false; }
    __device__ __forceinline__ void operator()(f32x4 (&acc)[2][2][4][2], const Unit& u, int wr, int wc, int fr, int fq) const {
        const int pn = u.pn, row0 = u.pm * BM + wr * 64 + fr;
        int mode; bf16_t* dst; int ld, col0; const LAS float* w = rtab + 256; int kmhead = -1;
        if (pn < 2) { mode = 0; dst = Qa; ld = 512; col0 = (4 * pn + wc) * 64; }
        else if (pn < 4) { mode = 0; dst = Ka; ld = 512; col0 = (4 * (pn - 2) + wc) * 64; w += 64; kmhead = 4 * (pn - 2) + wc; }
        else if (pn < 6) { mode = 1; dst = Va; ld = 512; col0 = (4 * (pn - 4) + wc) * 64; }
        else if (pn < 8) { mode = 0; dst = Qb; ld = 512; col0 = (4 * (pn - 6) + wc) * 64; w += 128; }
        else if (pn == 8) { if (wc < 2) { mode = 0; dst = Kb; ld = 128; col0 = wc * 64; w += 192; } else { mode = 1; dst = Vb; ld = 128; col0 = (wc - 2) * 64; } }
        else { mode = 2; dst = Gt; ld = 2048; col0 = (pn - 9) * 128 + 32 * wc; }
        f32x4 cw[2][2];
#pragma unroll
        for (int bj = 0; bj < 2; ++bj)
#pragma unroll
            for (int n = 0; n < 2; ++n) {
                if (mode == 0) cw[bj][n] = *(const LAS f32x4*)(w + 32 * bj + 8 * fq + 4 * n);
                else if (mode == 2) cw[bj][n] = *(const LAS f32x4*)(rtab + 512 + 1024 * bj + col0 + 8 * fq + 4 * n);
                else cw[bj][n] = (f32x4){1.f, 1.f, 1.f, 1.f};
            }
        f32x4 ks[2][2];
#pragma unroll
        for (int bj = 0; bj < 2; ++bj)
#pragma unroll
            for (int n = 0; n < 2; ++n) ks[bj][n] = (f32x4){0.f, 0.f, 0.f, 0.f};
#pragma unroll
        for (int ai = 0; ai < 2; ++ai)
#pragma unroll
            for (int m = 0; m < 4; ++m) {
                const int row = row0 + ai * HALF + m * 16;
                const float rs = rtab[ai * HALF + wr * 64 + m * 16 + fr];
                f32x4 v[2][2];
#pragma unroll
                for (int bj = 0; bj < 2; ++bj)
#pragma unroll
                    for (int n = 0; n < 2; ++n) v[bj][n] = acc[ai][bj][m][n] * rs;
                if (mode == 0) {
                    float ss = 0.f;
#pragma unroll
                    for (int bj = 0; bj < 2; ++bj)
#pragma unroll
                        for (int n = 0; n < 2; ++n) { const f32x4 x = v[bj][n]; ss += (x[0] * x[0] + x[1] * x[1]) + (x[2] * x[2] + x[3] * x[3]); }
                    ss += __shfl_xor(ss, 16); ss += __shfl_xor(ss, 32);
                    const float inv = 1.0f / sqrtf(ss * (1.0f / 64.0f) + NORM_EPS);
#pragma unroll
                    for (int bj = 0; bj < 2; ++bj)
#pragma unroll
                        for (int n = 0; n < 2; ++n) { v[bj][n] = v[bj][n] * inv * cw[bj][n]; ks[bj][n] += v[bj][n]; }
                } else if (mode == 2) {
#pragma unroll
                    for (int n = 0; n < 2; ++n) { f32x4 xa = v[0][n] + cw[0][n], xg = v[1][n] + cw[1][n];
#pragma unroll
                        for (int e = 0; e < 4; ++e) { const float da = 1.0f + __builtin_amdgcn_exp2f(-LOG2E * xa[e]), db = fminf(1.0f + __builtin_amdgcn_exp2f(-LOG2E * xg[e]), 1e20f);
                            xg[e] = __builtin_amdgcn_rcpf(db); xa[e] = db * __builtin_amdgcn_rcpf(da); }
                        v[0][n] = xa; v[1][n] = xg; }
                }
                bf16_t* rp = dst + (size_t)row * ld + col0 + 8 * fq;
                if (mode == 2) {
                    constexpr float cG = F8_SM / (F8_SW2 * F8_SY);
                    store8(rp, v[0][0], v[0][1]); store8(rp + 1024, v[1][0] * cG, v[1][1] * cG);
                } else { store8(rp, v[0][0], v[0][1]); store8(rp + 32, v[1][0], v[1][1]); }
            }
        if (kmhead >= 0) {
#pragma unroll
            for (int bj = 0; bj < 2; ++bj)
#pragma unroll
                for (int n = 0; n < 2; ++n) { f32x4 x = ks[bj][n];
#pragma unroll
                    for (int o = 1; o < 16; o <<= 1) { x[0] += __shfl_xor(x[0], o); x[1] += __shfl_xor(x[1], o); x[2] += __shfl_xor(x[2], o); x[3] += __shfl_xor(x[3], o); }
                    if (fr == 0) *(f32x4*)(kmp + ((size_t)(kmhead * 64 + u.pm) * 2 + wr) * 64 + 32 * bj + 8 * fq + 4 * n) = x; }
        }
    }
};

struct EpiMerge {
    const bf16_t* Gt; unsigned char* out;
    __device__ __forceinline__ bool keep(const Unit& u) const { return u.part == 0; }
    __device__ __forceinline__ void operator()(f32x4 (&acc)[2][2][4][2], const Unit& u, int wr, int wc, int fr, int fq) const {
        const int row0 = u.pm * BM + wr * 64 + fr, colb = u.pn * BM + wc * 32 + 8 * fq;
        const bf16_t* gp = Gt + (u.part == 0 ? 0 : 1024);
        u32x4 gw[2][4][2];
#pragma unroll
        for (int ai = 0; ai < 2; ++ai)
#pragma unroll
            for (int m = 0; m < 4; ++m)
#pragma unroll
                for (int bj = 0; bj < 2; ++bj) gw[ai][m][bj] = __builtin_nontemporal_load((const u32x4*)(gp + (size_t)(row0 + ai * HALF + m * 16) * 2048 + colb + bj * HALF));
#pragma unroll
        for (int ai = 0; ai < 2; ++ai)
#pragma unroll
            for (int m = 0; m < 4; ++m) {
                const int row = row0 + ai * HALF + m * 16;
#pragma unroll
                for (int bj = 0; bj < 2; ++bj) {
                    const int col = colb + bj * HALF; const u32x4 w = gw[ai][m][bj];
                    const f32x4 g0 = (f32x4){bf_lo(w.x), bf_hi(w.x), bf_lo(w.y), bf_hi(w.y)}, g1 = (f32x4){bf_lo(w.z), bf_hi(w.z), bf_lo(w.w), bf_hi(w.w)};
                    acc[ai][bj][m][0] *= g0; acc[ai][bj][m][1] *= g1;
                    if (u.part != 0) { const f32x4 a0 = acc[ai][bj][m][0], a1 = acc[ai][bj][m][1]; u32x2 w8; w8.x = pk4f8(a0[0], a0[1], a0[2], a0[3]); w8.y = pk4f8(a1[0], a1[1], a1[2], a1[3]); if (F8_G3) *(u32x2*)(out + (size_t)row * 1024 + col) = w8; else store8((bf16_t*)out + (size_t)row * 1024 + col, a0, a1); }
                }
            }
    }
};

struct EpiResid {
    bf16_t* xb; float* ssq; float* outf; float cs; unsigned char* x8;
    __device__ __forceinline__ bool keep(const Unit&) const { return false; }
    __device__ __forceinline__ void operator()(f32x4 (&acc)[2][2][4][2], const Unit& u, int wr, int wc, int fr, int fq) const {
        const int row0 = u.pm * BM + wr * 64 + fr, colb = u.pn * BM + wc * 32 + 8 * fq;
        u32x4 xw[2][4][2];
#pragma unroll
        for (int ai = 0; ai < 2; ++ai)
#pragma unroll
            for (int m = 0; m < 4; ++m)
#pragma unroll
                for (int bj = 0; bj < 2; ++bj) xw[ai][m][bj] = *(const u32x4*)(xb + (size_t)(row0 + ai * HALF + m * 16) * 1024 + colb + bj * HALF);
#pragma unroll
        for (int ai = 0; ai < 2; ++ai)
#pragma unroll
            for (int m = 0; m < 4; ++m) {
                const int row = row0 + ai * HALF + m * 16; float ss = 0.f;
#pragma unroll
                for (int bj = 0; bj < 2; ++bj) {
                    const size_t off = (size_t)row * 1024 + colb + bj * HALF;
                    const u32x4 w = xw[ai][m][bj];
                    const f32x4 x0 = (f32x4){bf_lo(w.x), bf_hi(w.x), bf_lo(w.y), bf_hi(w.y)} + acc[ai][bj][m][0] * cs, x1 = (f32x4){bf_lo(w.z), bf_hi(w.z), bf_lo(w.w), bf_hi(w.w)} + acc[ai][bj][m][1] * cs;
                    if (outf) { __builtin_nontemporal_store(x0, (f32x4*)(outf + off)); __builtin_nontemporal_store(x1, (f32x4*)(outf + off + 4)); }
                    else { store8(xb + off, x0, x1);
                        if (x8) { u32x2 w8; w8.x = pk4f8(x0[0], x0[1], x0[2], x0[3]); w8.y = pk4f8(x1[0], x1[1], x1[2], x1[3]); *(u32x2*)(x8 + off) = w8; }
                        ss += (x0[0] * x0[0] + x0[1] * x0[1]) + (x0[2] * x0[2] + x0[3] * x0[3]) + (x1[0] * x1[0] + x1[1] * x1[1]) + (x1[2] * x1[2] + x1[3] * x1[3]); }
                }
                if (!outf) { ss += __shfl_xor(ss, 16); ss += __shfl_xor(ss, 32);
                    if (fq == 0) ssq[(size_t)row * 16 + 4 * u.pn + wc] = ss; }
            }
    }
};

struct EpiFfnUp {
    const LAS float* rtab; bf16_t* U;
    __device__ __forceinline__ bool keep(const Unit&) const { return false; }
    __device__ __forceinline__ void operator()(f32x4 (&acc)[2][2][4][2], const Unit& u, int wr, int wc, int fr, int fq) const {
        const int row0 = u.pm * BM + wr * 64 + fr, colb = u.pn * BM + wc * 32 + 8 * fq;
#pragma unroll
        for (int ai = 0; ai < 2; ++ai)
#pragma unroll
            for (int m = 0; m < 4; ++m) {
                const int row = row0 + ai * HALF + m * 16;
                const float rs = rtab[ai * HALF + wr * 64 + m * 16 + fr];
#pragma unroll
                for (int bj = 0; bj < 2; ++bj) {
                    f32x4 a, b;
#pragma unroll
                    for (int e = 0; e < 4; ++e) { const float t0 = fmaxf(acc[ai][bj][m][0][e], 0.f) * rs, t1 = fmaxf(acc[ai][bj][m][1][e], 0.f) * rs; a[e] = t0 * t0; b[e] = t1 * t1; }
                    store8(U + (size_t)row * FF + colb + bj * HALF, a, b);
                }
            }
    }
};
}

namespace att {
__device__ __forceinline__ int crow(int r, int hi) { return (r & 3) + 8 * (r >> 2) + 4 * hi; }
__device__ __forceinline__ bf16x8 vtr2(const LAS char* p) {
    const v4i16_t lo = __builtin_amdgcn_ds_read_tr16_b64_v4i16((LAS v4i16_t*)p), hi = __builtin_amdgcn_ds_read_tr16_b64_v4i16((LAS v4i16_t*)(p + 512));
    return (bf16x8){lo[0], lo[1], lo[2], lo[3], hi[0], hi[1], hi[2], hi[3]};
}
__device__ __forceinline__ int kswz(int row, int chunk) { return chunk * 1024 + ((row & ~7) | ((row ^ chunk) & 7)) * 16; }
__device__ __forceinline__ void load_kv(LAS unsigned char* lds, const bf16_t* Kg, const bf16_t* Vg, int pitch, int row0, int tid) {
    const int lane = tid & 63, w = tid >> 6;
#pragma unroll
    for (int t = 0; t < 4; ++t) {
        const int kr = w * 8 + (lane >> 3), kc = lane & 7, gk = row0 + 64 * t + kr;
        u32x4 kv = (u32x4){0u, 0u, 0u, 0u};
        if (gk >= 0) kv = *(const u32x4*)(Kg + (size_t)gk * pitch + kc * 8);
        *(LAS u32x4*)(lds + L_K + t * 8192 + kswz(kr, kc)) = kv;
        const int gv = row0 + 64 * t + 16 * (w & 3) + (lane >> 2);
        u32x4 vv = (u32x4){0u, 0u, 0u, 0u};
        if (gv >= 0) vv = *(const u32x4*)(Vg + (size_t)gv * pitch + (w >> 2) * 32 + (lane & 3) * 8);
        *(LAS u32x4*)(lds + L_V + t * 8192 + w * 1024 + lane * 16) = vv;
    }
}
__device__ __forceinline__ void load_q(bf16x8 (&qr)[4], const bf16_t* qrow, int hi) {
#pragma unroll
    for (int d0 = 0; d0 < 4; ++d0) qr[d0] = *(const bf16x8*)(qrow + d0 * 16 + hi * 8);
}
__device__ __forceinline__ void qkt(f32x16& p0, f32x16& p1, const LAS unsigned char* Kt, const bf16x8 (&qr)[4], int r32, int hi) {
#pragma unroll
    for (int d0 = 0; d0 < 4; ++d0) {
        const LAS unsigned char* kb = Kt + kswz(r32, 2 * d0 + hi);
        const bf16x8 b0 = *(const LAS bf16x8*)(kb);
        const bf16x8 b1 = *(const LAS bf16x8*)(kb + 512);
        p0 = __builtin_amdgcn_mfma_f32_32x32x16_bf16(b0, qr[d0], p0, 0, 0, 0);
        p1 = __builtin_amdgcn_mfma_f32_32x32x16_bf16(b1, qr[d0], p1, 0, 0, 0);
    }
}
struct LutLane { const LAS float* lutp; int amax; };
__device__ __forceinline__ LutLane lut_lane(const LAS float* lut4, int cstride, int nmax, int dlane) {
    const int k = (dlane - 3 + LUTPAD) & 3; LutLane L; L.lutp = lut4 + k * cstride - k; L.amax = ((nmax - 4 - k) & ~3) + k; return L;
}
template <bool LUTB, bool MASKED>
__device__ __forceinline__ void tile(f32x16 (&o)[2], float& lsum, const bf16x8 (&qr)[4], const LAS unsigned char* Kt, const LAS unsigned char* Vt,
                                     float cbias, const LutLane L, int dbase, unsigned dmax, int r32, int hi, int lane, const bool domask = true) {
    f32x16 p0, p1;
    const int db = dbase - 4 * hi;
    if (LUTB) {
#pragma unroll
        for (int gq = 0; gq < 4; ++gq) {
            int a0 = db - 3 - 8 * gq + LUTPAD, a1 = a0 - 32; a0 = a0 < L.amax ? a0 : L.amax; a1 = a1 < L.amax ? a1 : L.amax;
            const f32x4 x0 = *(const LAS f32x4*)(L.lutp + a0), x1 = *(const LAS f32x4*)(L.lutp + a1);
#pragma unroll
            for (int i = 0; i < 4; ++i) { p0[4 * gq + i] = x0[3 - i]; p1[4 * gq + i] = x1[3 - i]; }
        }
    } else {
#pragma unroll
        for (int r = 0; r < 16; ++r) { p0[r] = cbias; p1[r] = cbias; }
    }
    qkt(p0, p1, Kt, qr, r32, hi);
    if (MASKED && domask) {
#pragma unroll
        for (int r = 0; r < 16; ++r) { const int c = (r & 3) + 8 * (r >> 2);
            if ((unsigned)(db - c) > dmax) p0[r] = -INFINITY;
            if ((unsigned)(db - 32 - c) > dmax) p1[r] = -INFINITY; }
    }
    float s = 0.f;
#pragma unroll
    for (int r = 0; r < 16; ++r) { p0[r] = __builtin_amdgcn_exp2f(p0[r]); p1[r] = __builtin_amdgcn_exp2f(p1[r]); s += p0[r] + p1[r]; }
    lsum += s;
    u32x4 pw[4];
#pragma unroll
    for (int k = 0; k < 4; ++k) { pw[0][k] = cvtpk(p0[2 * k], p0[2 * k + 1]); pw[1][k] = cvtpk(p0[8 + 2 * k], p0[9 + 2 * k]); pw[2][k] = cvtpk(p1[2 * k], p1[2 * k + 1]); pw[3][k] = cvtpk(p1[8 + 2 * k], p1[9 + 2 * k]); }
    const LAS char* vp = (const LAS char*)Vt + ((lane >> 4) & 1) * 32 + (lane & 3) * 8 + (4 * hi + ((lane & 15) >> 2)) * 64;
#pragma unroll
    for (int d0 = 0; d0 < 2; ++d0)
#pragma unroll
        for (int ks = 0; ks < 4; ++ks) {
            const bf16x8 vf = vtr2(vp + d0 * 4096 + ks * 1024);
            o[d0] = __builtin_amdgcn_mfma_f32_32x32x16_bf16(__builtin_bit_cast(bf16x8, pw[ks]), vf, o[d0], 0, 0, 0);
        }
}
__device__ __forceinline__ void lut4_put(LAS float* lut4, int cstride, int ix, float v) {
#pragma unroll
    for (int k = 0; k < 4; ++k) if (ix - k >= 0) lut4[k * cstride + ix - k] = v;
}
__device__ __forceinline__ void stage_o(LAS bf16_t* stg, const f32x16 (&o)[2], int r32, int hi) {
#pragma unroll
    for (int r = 0; r < 16; r += 2) { const int orow0 = crow(r, hi), orow1 = crow(r + 1, hi);
#pragma unroll
        for (int d0 = 0; d0 < 2; ++d0) { const unsigned w = cvtpk(o[d0][r], o[d0][r + 1]); stg[orow0 * 64 + d0 * 32 + r32] = (bf16_t)(w & 0xffffu); stg[orow1 * 64 + d0 * 32 + r32] = (bf16_t)(w >> 16); } }
}
__device__ __forceinline__ void unpack8(float (&f)[8], const u32x4 w) { f[0] = bf_lo(w.x); f[1] = bf_hi(w.x); f[2] = bf_lo(w.y); f[3] = bf_hi(w.y); f[4] = bf_lo(w.z); f[5] = bf_hi(w.z); f[6] = bf_lo(w.w); f[7] = bf_hi(w.w); }
__device__ __forceinline__ u32x2 pack8f8(const float (&f)[8]) { u32x2 w; w.x = pk4f8(f[0], f[1], f[2], f[3]); w.y = pk4f8(f[4], f[5], f[6], f[7]); return w; }
__device__ __forceinline__ u32x4 pack8(const float (&f)[8]) { u32x4 w; w.x = cvtpk(f[0], f[1]); w.y = cvtpk(f[2], f[3]); w.z = cvtpk(f[4], f[5]); w.w = cvtpk(f[6], f[7]); return w; }
}

typedef GAS unsigned gu32;
#define RLX_AGENT __ATOMIC_RELAXED, __HIP_MEMORY_SCOPE_AGENT
#define LDS_WAIT() asm volatile("s_waitcnt lgkmcnt(0)" ::: "memory")
#define VM_WAIT() asm volatile("s_waitcnt vmcnt(0)" ::: "memory")
#define XB_TMO      128
#define XB_XCNT(j)  (256  + 64 * (j))
#define XB_XSUB(j)  (1280 + 64 * (j))
#define XB_XGEN(j)  (2304 + 64 * (j))
#define XB_TOP      3328
#define XB_TOPGEN   3392
#define XCD_BAR_WORDS 3456
#define XB_SPIN_CAP (1u << 22)
__device__ __forceinline__ unsigned xb_ld(unsigned* p)              { return __hip_atomic_load(p, __ATOMIC_RELAXED, __HIP_MEMORY_SCOPE_AGENT); }
__device__ __forceinline__ unsigned xb_add(unsigned* p, unsigned v) { return __hip_atomic_fetch_add(p, v, __ATOMIC_RELAXED, __HIP_MEMORY_SCOPE_AGENT); }
__device__ __forceinline__ unsigned xb_xcc_id() { return (unsigned)__builtin_amdgcn_s_getreg((3 << 11) | 20) & 0xFu; }
#define XB_SPIN(cond, bar) do { unsigned _sp = 0; while (cond) { __builtin_amdgcn_s_sleep(1); \
    if ((++_sp & 255u) == 0u) { if (xb_ld(&(bar)[XB_TMO])) break; if (_sp > XB_SPIN_CAP) { atomicAdd(&(bar)[XB_TMO], 1u); break; } } } } while (0)
struct XcdBarrier { unsigned* bar; unsigned x; volatile LAS unsigned* st; };
__device__ __forceinline__ XcdBarrier xcd_barrier_post(unsigned* bar, volatile LAS unsigned* st) {
    XcdBarrier b; b.bar = bar; b.x = xb_xcc_id(); b.st = st;
    if (threadIdx.x == 0) (void)xb_add(&bar[XB_XCNT(b.x)], 1u);
    return b;
}
__device__ __forceinline__ void xcd_barrier_complete(unsigned* bar, unsigned x, unsigned& nloc, unsigned& nx) {
    const unsigned G = gridDim.x * gridDim.y * gridDim.z;
    unsigned sum, cnt, mine, sp = 0u;
    for (;;) {
        sum = 0u; cnt = 0u; mine = 0u;
#pragma unroll
        for (unsigned j = 0; j < 16; ++j) { const unsigned c = xb_ld(&bar[XB_XCNT(j)]); sum += c; cnt += (c > 0u) ? 1u : 0u; mine = (j == x) ? c : mine; }
        if (sum == G) break;
        __builtin_amdgcn_s_sleep(1);
        if ((++sp & 255u) == 0u) { if (xb_ld(&bar[XB_TMO])) break; if (sp > XB_SPIN_CAP) { atomicAdd(&bar[XB_TMO], 1u); break; } }
    }
    nloc = mine > 0u ? mine : 1u; nx = cnt > 0u ? cnt : 1u;
}
__device__ __forceinline__ void xcd_barrier(const XcdBarrier& b) {
    asm volatile("s_waitcnt vmcnt(0)" ::: "memory");
    __syncthreads();
    if (threadIdx.x == 0) {
        unsigned* bar = b.bar;
        __builtin_amdgcn_s_waitcnt(0);
        unsigned nloc = b.st[0], nx = b.st[1];
        if (nloc == 0u) { xcd_barrier_complete(bar, b.x, nloc, nx); b.st[0] = nloc; b.st[1] = nx; }
        const unsigned old = xb_add(&bar[XB_XSUB(b.x)], 1u);
        const unsigned gen = old / nloc;
        if (old + 1u == (gen + 1u) * nloc) {
            __builtin_amdgcn_fence(__ATOMIC_RELEASE, "agent");
            asm volatile("s_waitcnt vmcnt(0)" ::: "memory");
            const unsigned og = xb_add(&bar[XB_TOP], 1u);
            const unsigned tg = og / nx;
            if (og + 1u == (tg + 1u) * nx) xb_add(&bar[XB_TOPGEN], 1u);
            else XB_SPIN(xb_ld(&bar[XB_TOPGEN]) == tg, bar);
            __builtin_amdgcn_fence(__ATOMIC_ACQUIRE, "agent");
            xb_add(&bar[XB_XGEN(b.x)], 1u);
            asm volatile("s_waitcnt vmcnt(0)" ::: "memory");
        } else {
            XB_SPIN(xb_ld(&bar[XB_XGEN(b.x)]) == gen, bar);
            __builtin_amdgcn_fence(__ATOMIC_ACQUIRE, "agent");
            asm volatile("s_waitcnt vmcnt(0)" ::: "memory");
        }
    }
    __syncthreads();
}

__device__ __forceinline__ void rstd_table(LAS float* rtab, const float* ssq, int pm, const float scale) {
    const int tid = threadIdx.x;
    if (tid < 256) { const f32x4* p = (const f32x4*)(ssq + (size_t)(pm * 256 + tid) * 16); const f32x4 a = p[0], b = p[1], c = p[2], d = p[3];
        const float s = ((a[0] + a[1]) + (a[2] + a[3])) + ((b[0] + b[1]) + (b[2] + b[3])) + ((c[0] + c[1]) + (c[2] + c[3])) + ((d[0] + d[1]) + (d[2] + d[3]));
        rtab[tid] = scale / sqrtf(s * (1.0f / 1024.0f) + NORM_EPS); }
    __syncthreads();
}
__device__ __forceinline__ void proj_consts(LAS float* tab, const float* qna, const float* kna, const float* qnb, const float* knb, const float* bgate) {
    const int tid = threadIdx.x;
    if (tid < 256) { const int k = tid >> 6, i = tid & 63; tab[256 + tid] = (k == 0) ? qna[i] * C2 : (k == 1) ? kna[i] : (k == 2) ? qnb[i] * C2 : knb[i]; }
#pragma unroll
    for (int i = 0; i < 4; ++i) tab[512 + tid + 512 * i] = bgate[tid + 512 * i];
}
struct Args { const float* in[16]; float* out; unsigned char* ws; int ph_lo, ph_hi; };
struct Frame {
    LAS unsigned char* lds;
    int tid, lane, wave, G, vcu;
    unsigned char* ws; float* out;
};

__device__ __forceinline__ float wave_sum(float v) {
#pragma unroll
    for (int o = 1; o < 64; o <<= 1) v += __shfl_xor(v, o);
    return v;
}
__device__ __forceinline__ int rel_bucket(int d) {
    if (d < 16) return d < 0 ? 0 : d;
    int b = 16;
    b += (d >= 22); b += (d >= 30); b += (d >= 40); b += (d >= 54); b += (d >= 73); b += (d >= 99); b += (d >= 134); b += (d >= 182);
    b += (d >= 246); b += (d >= 332); b += (d >= 450); b += (d >= 609); b += (d >= 825); b += (d >= 1117); b += (d >= 1513);
    return b;
}

struct PItem { int type; const float* src; int N; const float* gs; unsigned char* dst; int f8, ldk, kcol, drowA, drowB, m0; };
__device__ __forceinline__ int win_drow(int n0) {
    if (n0 >= 2304) { const int gg = n0 - 2304, isb = gg >= 1024 ? 1 : 0, G0 = gg - 1024 * isb; return (9 + (G0 >> 7)) * 256 + 128 * isb + 32 * ((G0 & 127) >> 5); }
    const int cc = n0 & 255; return (n0 & ~255) + 128 * ((cc >> 5) & 1) + 32 * (cc >> 6);
}
constexpr int PT_LAYER = 16 * 68 + 2 * 8 * 16 + 16 * 16 + 16 * 64 + 64 * 16;
constexpr int PT_X = M / 4;
__device__ __forceinline__ PItem pro_decode(int it, const Args& a, unsigned char* ws, unsigned char* outb) {
    PItem p; p.gs = nullptr; p.m0 = 0; p.ldk = D; p.drowA = 0; p.drowB = 0; p.kcol = 0; p.N = D; p.dst = nullptr; p.src = nullptr; p.f8 = 0;
    if (it >= NLAYER * PT_LAYER) { p.type = 1; p.m0 = (it - NLAYER * PT_LAYER) * 4; p.src = a.in[0] + (size_t)p.m0 * D; return p; }
    p.type = 0;
    const int l = it / PT_LAYER; int r = it - l * PT_LAYER;
    unsigned char* wb = (l == 0) ? outb + DO_W : ws + WS_W;
    if (r < 16 * 68) { const int kb = r / 68, n0 = (r % 68) * 64, k0 = kb * 64; p.src = a.in[3] + (size_t)l * D * INW + (size_t)k0 * INW + n0; p.N = INW; p.gs = a.in[2] + (size_t)l * D + k0;
        p.dst = wb + OFF_WIN; p.f8 = F8_G1; p.kcol = k0; p.drowA = win_drow(n0); p.drowB = win_drow(n0 + 32); return p; } r -= 16 * 68;
    if (r < 128) { const int kb = r / 16, n0 = (r % 16) * 64, k0 = kb * 64; p.src = a.in[10] + (size_t)l * 512 * D + (size_t)k0 * D + n0; p.dst = wb + OFF_WBR; p.f8 = F8_G2; p.kcol = k0; p.drowA = n0; p.drowB = n0 + 32; return p; } r -= 128;
    if (r < 128) { const int kb = r / 16, n0 = (r % 16) * 64, k0 = kb * 64; p.src = a.in[11] + (size_t)l * 512 * D + (size_t)k0 * D + n0; p.dst = wb + OFF_WBR; p.f8 = F8_G2; p.kcol = 512 + k0; p.drowA = n0; p.drowB = n0 + 32; return p; } r -= 128;
    if (r < 256) { const int kb = r / 16, n0 = (r % 16) * 64, k0 = kb * 64; p.src = a.in[12] + (size_t)l * D * D + (size_t)k0 * D + n0; p.dst = wb + OFF_WOUT; p.f8 = F8_G3; p.kcol = k0; p.drowA = n0; p.drowB = n0 + 32; return p; } r -= 256;
    if (r < 1024) { const int kb = r / 64, n0 = (r % 64) * 64, k0 = kb * 64; p.src = a.in[14] + (size_t)l * D * FF + (size_t)k0 * FF + n0; p.N = FF; p.gs = a.in[13] + (size_t)l * D + k0;
        p.dst = wb + OFF_W1; p.kcol = k0; p.drowA = n0; p.drowB = n0 + 32; return p; } r -= 1024;
    { const int kb = r / 16, n0 = (r % 16) * 64, k0 = kb * 64; p.src = a.in[15] + (size_t)l * FF * D + (size_t)k0 * D + n0; p.dst = wb + OFF_W2; p.ldk = FF; p.kcol = k0; p.drowA = n0; p.drowB = n0 + 32; }
    return p;
}
__device__ __forceinline__ void pro_load(f32x4 (&v)[16], const PItem& p, int lane) {
    if (p.type == 0) { const float* s = p.src + (size_t)(lane >> 4) * p.N + (lane & 15) * 4;
#pragma unroll
        for (int i = 0; i < 16; ++i) v[i] = __builtin_nontemporal_load((const f32x4*)(s + (size_t)(4 * i) * p.N));
    } else { const float* s = p.src + lane * 4;
#pragma unroll
        for (int i = 0; i < 16; ++i) v[i] = __builtin_nontemporal_load((const f32x4*)(s + (i >> 2) * D + (i & 3) * 256));
    }
}
__device__ __forceinline__ void pro_process(const f32x4 (&v)[16], const PItem& p, LAS float* scr, int lane, unsigned char* ws, unsigned char* x8) {
    if (p.type == 0) {
        const int c = lane & 7, nl = lane >> 3;
        f32x4 g0 = (f32x4){1.f, 1.f, 1.f, 1.f}, g1 = g0;
        if (p.gs) { g0 = *(const f32x4*)(p.gs + 8 * c); g1 = *(const f32x4*)(p.gs + 8 * c + 4); }
        if (p.f8) { g0 = g0 * F8_SW; g1 = g1 * F8_SW; }
#pragma unroll
        for (int i = 0; i < 16; ++i) { LAS float* w = scr + (4 * i + (lane >> 4)) * 65 + (lane & 15) * 4; w[0] = v[i][0]; w[1] = v[i][1]; w[2] = v[i][2]; w[3] = v[i][3]; }
        LDS_WAIT(); asm volatile("" ::: "memory");
#pragma unroll
        for (int j = 0; j < 8; ++j) { const int n = nl + 8 * j; const LAS float* s = scr + (8 * c) * 65 + n;
            const float t0 = s[0 * 65] * g0[0], t1 = s[1 * 65] * g0[1], t2 = s[2 * 65] * g0[2], t3 = s[3 * 65] * g0[3], t4 = s[4 * 65] * g1[0], t5 = s[5 * 65] * g1[1], t6 = s[6 * 65] * g1[2], t7 = s[7 * 65] * g1[3];
            const int drow = (j < 4) ? p.drowA + n : p.drowB + n - 32;
            const size_t eo = (size_t)drow * p.ldk + p.kcol + 8 * c;
            if (p.f8) { u32x2 o; o.x = pk4f8(t0, t1, t2, t3); o.y = pk4f8(t4, t5, t6, t7); *(u32x2*)(p.dst + eo) = o; }
            else { u32x4 o; o.x = cvtpk(t0, t1); o.y = cvtpk(t2, t3); o.z = cvtpk(t4, t5); o.w = cvtpk(t6, t7); *(u32x4*)(p.dst + eo * 2) = o; } }
        LDS_WAIT(); asm volatile("" ::: "memory");
    } else {
        bf16_t* xb = (bf16_t*)(ws + WS_XB); float* ssq = (float*)(ws + WS_SSQ);
#pragma unroll
        for (int r = 0; r < 4; ++r) { float s = 0.f;
#pragma unroll
            for (int q = 0; q < 4; ++q) { const f32x4 x = v[4 * r + q]; s += (x[0] * x[0] + x[1] * x[1]) + (x[2] * x[2] + x[3] * x[3]); }
            s = wave_sum(s);
            u32x2* o8 = (u32x2*)(xb + (size_t)(p.m0 + r) * D) + lane;
#pragma unroll
            for (int q = 0; q < 4; ++q) { const f32x4 x = v[4 * r + q]; u32x2 w; w.x = cvtpk(x[0], x[1]); w.y = cvtpk(x[2], x[3]); o8[64 * q] = w;
                if (F8_G1) ((unsigned*)(x8 + (size_t)(p.m0 + r) * D))[lane + 64 * q] = pk4f8(x[0], x[1], x[2], x[3]); }
            if (lane < 16) ssq[(size_t)(p.m0 + r) * 16 + lane] = (lane == 0) ? s : 0.f; }
    }
}
__device__ __forceinline__ void phase_prologue(Frame& F, const Args& a) {
    LAS float* scr = (LAS float*)(F.lds + F.wave * 16640);
    const int gw = F.vcu * 8 + F.wave, NGW = F.G * 8;
    unsigned char* ws = F.ws; unsigned char* outb = (unsigned char*)F.out;
    {
        if (gw == 0) { unsigned* cur = (unsigned*)(ws + WS_CUR); for (int i = F.lane; i < NLAYER * 512; i += 64) cur[i] = 0u; }
        const float* rel_bias = a.in[1]; float* lut = (float*)(ws + WS_LUT);
        for (int i = gw * 64 + F.lane; i < 16 * LUTN; i += NGW * 64) { const int hh = i / LUTN, k = i % LUTN, d = k - LUTPAD;
            lut[i] = (d < 0) ? 0.f : rel_bias[rel_bucket(d) * 16 + hh] * LOG2E; }
    }
    constexpr int NTOT = NLAYER * PT_LAYER + PT_X;
    f32x4 va[16], vb[16]; PItem pa, pb;
    int it = gw;
    if (it < NTOT) { pa = pro_decode(it, a, ws, outb); pro_load(va, pa, F.lane); }
    while (it < NTOT) {
        const int i1 = it + NGW; if (i1 < NTOT) { pb = pro_decode(i1, a, ws, outb); pro_load(vb, pb, F.lane); }
        pro_process(va, pa, scr, F.lane, ws, ws + WS_X8);
        if (i1 >= NTOT) break;
        const int i2 = i1 + NGW; if (i2 < NTOT) { pa = pro_decode(i2, a, ws, outb); pro_load(va, pa, F.lane); }
        pro_process(vb, pb, scr, F.lane, ws, ws + WS_X8);
        it = i2;
    }
}

__device__ __forceinline__ void phase_swa_select(Frame& F, const Args& a, int l) {
    using namespace att;
    const bool tailwg = (F.G == 256) && (blockIdx.x < 64);
    if (F.G == 256) {
        unsigned char* ws_ = F.ws; unsigned char* wb_ = (l == 0) ? (unsigned char*)F.out + DO_W : ws_ + WS_W;
        pg8::Gemm g{F8_G1 ? ws_ + WS_X8 : ws_ + WS_XB, wb_ + OFF_WIN, F8_G1 ? D : 2 * D, F8_G1 ? D : 2 * D, F8_G1 ? D : 2 * D, 0}; pg8::StaticOrder S; S.init_single((int)blockIdx.x, 16, tailwg);
        if (tailwg) { proj_consts((LAS float*)(F.lds + L_RSTD), a.in[5] + l * 64, a.in[6] + l * 64, a.in[7] + l * 64, a.in[8] + l * 64, a.in[4] + l * 2048); rstd_table((LAS float*)(F.lds + L_RSTD), (const float*)(ws_ + WS_SSQ), (int)blockIdx.x, F8_G1 ? 1.0f / F8_SW : 1.0f); }
        pg8::EpiProj E{(const LAS float*)(F.lds + L_RSTD), (bf16_t*)(ws_ + WS_QA), (bf16_t*)(ws_ + WS_KA), (bf16_t*)(ws_ + WS_VA), (bf16_t*)(ws_ + WS_QB), (bf16_t*)(ws_ + WS_KB), (bf16_t*)(ws_ + WS_VB), (bf16_t*)(ws_ + WS_GT), (float*)(ws_ + WS_KMP)};
        if (tailwg) pg8::gemm_phase<F8_G1 != 0, pg8::EpiProj>(F.lds, g, S, E);
    }
    unsigned char* ws = F.ws; LAS unsigned char* lds = F.lds;
    const int tid = F.tid, lane = F.lane, wave = F.wave, r32 = lane & 31, hi = lane >> 5;
    const bf16_t* Qb = (const bf16_t*)(ws + WS_QB); const bf16_t* Kb = (const bf16_t*)(ws + WS_KB); const bf16_t* Vb = (const bf16_t*)(ws + WS_VB);
    unsigned char* Y = (unsigned char*)F.out + DO_Y;
    const float* lutg = (const float*)(ws + WS_LUT); const float* sinks = a.in[9] + l * 8;
    LAS float* lut = (LAS float*)(lds + L_LUT); LAS float* wsf = (LAS float*)(lds + L_WSF) + wave * 64; LAS bf16_t* stg = (LAS bf16_t*)(lds + L_OST) + wave * 2048;
    const int bxi = (int)blockIdx.x; const bool swa_split = (F.G == 256);
    for (int ui = 0; ui < 2; ++ui) {
        int unit, gi_lo = 0, gi_hi = 16;
        if (swa_split) { if (tailwg) break;
            if (ui == 0) unit = bxi;
            else if (bxi < 128) { unit = bxi - 64; gi_hi = 8; }
            else if (bxi < 192) { unit = bxi - 128; gi_lo = 8; }
            else break; }
        else { if (ui == 1) break; unit = F.vcu; if (unit >= 256) break; }
        const int kvh = unit >> 7, c = unit & 127;
        bf16x8 qsw[2][4];
#pragma unroll
        for (int k2 = 0; k2 < 2; ++k2) { const int gi_ = gi_lo + wave + 8 * k2; const int gg_ = gi_ < gi_hi ? gi_ : gi_lo + wave;
            load_q(qsw[k2], Qb + (size_t)(128 * c + 32 * (gg_ & 3) + r32) * 512 + (kvh * 4 + (gg_ >> 2)) * 64, hi); }
        __syncthreads();
        load_kv(lds, Kb + kvh * 64, Vb + kvh * 64, 128, 128 * c - 128, tid);
        for (int i = tid; i < 4 * 512; i += 512) lut4_put(lut + (i >> 9) * 2048, 512, i & 511, lutg[(size_t)(8 + kvh * 4 + (i >> 9)) * LUTN + (i & 511)]);
        __syncthreads();
        for (int gi = gi_lo + wave; gi < gi_hi; gi += 8) {
            const int hl = gi >> 2, g = gi & 3, hq = kvh * 4 + hl, q = 128 * c + 32 * g + r32;
            bf16x8 qr[4];
#pragma unroll
            for (int d0 = 0; d0 < 4; ++d0) qr[d0] = (gi - gi_lo - wave) ? qsw[1][d0] : qsw[0][d0];
            f32x16 o[2];
#pragma unroll
            for (int r = 0; r < 16; ++r) { o[0][r] = 0.f; o[1][r] = 0.f; }
            float lsum = 0.f; const unsigned dmax = (unsigned)(q < 127 ? q : 127);
            const int t0 = g < 2 ? 0 : 1; const LutLane LL = lut_lane(lut + hl * 2048, 512, 512, r32 - 4 * hi);
            for (int t = t0; t < t0 + 3; ++t)
                tile<true, true>(o, lsum, qr, lds + L_K + t * 8192, lds + L_V + t * 8192, 0.f, LL, 32 * g + r32 + 128 - 64 * t, dmax, r32, hi, lane, t != t0 + 1 || c == 0);
            lsum += __shfl_xor(lsum, 32);
            lsum += __builtin_amdgcn_exp2f(sinks[hq] * LOG2E);
            if (hi == 0) wsf[r32] = lsum;
            stage_o(stg, o, r32, hi);
            LDS_WAIT(); asm volatile("" ::: "memory");
#pragma unroll
            for (int i = 0; i < 4; ++i) { const int row = i * 8 + (lane >> 3), ch = lane & 7;
                const u32x4 v = *(const LAS u32x4*)(stg + row * 64 + ch * 8); float f[8]; unpack8(f, v);
                const float inv = F8_SY / wsf[row];
#pragma unroll
                for (int e = 0; e < 8; ++e) f[e] *= inv;
                const size_t yo = (size_t)(128 * c + 32 * g + row) * 1024 + 512 + hq * 64 + ch * 8;
                if (F8_G2) *(u32x2*)(Y + yo) = pack8f8(f); else *(u32x4*)(Y + 2 * yo) = pack8(f); }
            LDS_WAIT(); asm volatile("" ::: "memory");
        }
    }
    const bf16_t* Qa = (const bf16_t*)(ws + WS_QA); const float* kmp = (const float*)(ws + WS_KMP);
    unsigned* cursor = (unsigned*)(ws + WS_CUR) + l * 512; unsigned short* lists = (unsigned short*)(ws + WS_LISTS);
    LAS unsigned* hist = (LAS unsigned*)(lds + L_SM); LAS unsigned* lbase = hist + 64;
    int sel0, selstep, selend;
    if (F.G == 256) { const int bx_ = (int)blockIdx.x;
        if (bx_ < 64) { sel0 = bx_; selstep = 512; selend = 64; }
        else if (bx_ < 192) { sel0 = bx_; selstep = 128; selend = 320; }
        else { sel0 = 320 + (bx_ - 192); selstep = 64; selend = 512; } }
    else { sel0 = F.vcu; selstep = F.G; selend = 512; }
    f32x4 kmr[4]; bf16x8 qsel[4];
#define SEL_FETCH(unit_) do { const int h_ = (unit_) >> 6, qb_ = (unit_) & 63; const float* p_ = kmp + ((size_t)(h_ * 64 + (tid >> 3)) * 2) * 64 + (tid & 7) * 8; \
        kmr[0] = *(const f32x4*)(p_); kmr[1] = *(const f32x4*)(p_ + 4); kmr[2] = *(const f32x4*)(p_ + 64); kmr[3] = *(const f32x4*)(p_ + 68); \
        load_q(qsel, Qa + (size_t)(qb_ * 256 + 32 * wave + r32) * 512 + h_ * 64, hi); } while (0)
    if (sel0 < selend) SEL_FETCH(sel0);
    for (int unit = sel0; unit < selend; unit += selstep) {
        const int h = unit >> 6, qb = unit & 63;
        __syncthreads();
        { const int j = tid >> 3, cch = tid & 7;
          float hi8[8], lo8[8];
#pragma unroll
          for (int e = 0; e < 8; ++e) { const float km = (kmr[e >> 2][e & 3] + kmr[2 + (e >> 2)][e & 3]) * (1.0f / 256.0f); const unsigned hb = f2bf(km); const float hf = __builtin_bit_cast(float, hb << 16); hi8[e] = hf; lo8[e] = km - hf; }
          *(LAS u32x4*)(lds + L_K + kswz(j, cch)) = pack8(hi8); *(LAS u32x4*)(lds + L_K + 8192 + kswz(j, cch)) = pack8(lo8); }
        if (tid < 64) hist[tid] = 0u;
        __syncthreads();
        const int q = qb * 256 + 32 * wave + r32;
        int i1 = 255, i2 = 255, i3 = 255;
        {
            bf16x8 qr[4];
#pragma unroll
            for (int d0 = 0; d0 < 4; ++d0) qr[d0] = qsel[d0];
            if (unit + selstep < selend) SEL_FETCH(unit + selstep);
            f32x16 p0, p1;
#pragma unroll
            for (int r = 0; r < 16; ++r) { p0[r] = 0.f; p1[r] = 0.f; }
            qkt(p0, p1, lds + L_K, qr, r32, hi); qkt(p0, p1, lds + L_K + 8192, qr, r32, hi);
            float v1 = -INFINITY, v2 = -INFINITY, v3 = -INFINITY;
#define TOP_INS(v_, i_) do { const float vv = (v_); const int ii = (i_); if (vv > v3) { if (vv > v2) { v3 = v2; i3 = i2; if (vv > v1) { v2 = v1; i2 = i1; v1 = vv; i1 = ii; } else { v2 = vv; i2 = ii; } } else { v3 = vv; i3 = ii; } } } while (0)
#pragma unroll
            for (int r = 0; r < 16; ++r) { const int j0 = crow(r, hi), j1 = 32 + j0;
                TOP_INS(j0 < qb ? p0[r] : -INFINITY, j0); TOP_INS(j1 < qb ? p1[r] : -INFINITY, j1); }
            const float w1 = __shfl_xor(v1, 32), w2 = __shfl_xor(v2, 32), w3 = __shfl_xor(v3, 32);
            const int k1 = __shfl_xor(i1, 32), k2 = __shfl_xor(i2, 32), k3 = __shfl_xor(i3, 32);
            TOP_INS(w1, k1); TOP_INS(w2, k2); TOP_INS(w3, k3);
#undef TOP_INS
            if (hi == 0) {
                if (i1 < 64) __hip_atomic_fetch_add(hist + i1, 1u, __ATOMIC_RELAXED, __HIP_MEMORY_SCOPE_WORKGROUP);
                if (i2 < 64) __hip_atomic_fetch_add(hist + i2, 1u, __ATOMIC_RELAXED, __HIP_MEMORY_SCOPE_WORKGROUP);
                if (i3 < 64) __hip_atomic_fetch_add(hist + i3, 1u, __ATOMIC_RELAXED, __HIP_MEMORY_SCOPE_WORKGROUP);
            }
        }
        __syncthreads();
        if (tid < 64) { const unsigned c = hist[tid]; unsigned bs = 0u; if (c) bs = __hip_atomic_fetch_add(cursor + h * 64 + tid, c, __ATOMIC_RELAXED, __HIP_MEMORY_SCOPE_AGENT); lbase[tid] = bs; hist[tid] = 0u; }
        __syncthreads();
        if (hi == 0) {
            const int pick[3] = {i1, i2, i3};
#pragma unroll
            for (int s = 0; s < 3; ++s) { const int j = pick[s];
                if (j < 64) { const unsigned rk = __hip_atomic_fetch_add(hist + j, 1u, __ATOMIC_RELAXED, __HIP_MEMORY_SCOPE_WORKGROUP);
                    lists[(size_t)h * LIST_HEAD + 256 * (63 * j - (j * (j - 1)) / 2) + lbase[j] + rk] = (unsigned short)(q | (s << 14)); } }
        }
    }
#undef SEL_FETCH
}

__device__ __forceinline__ void phase_moba_past(Frame& F, const Args& a, int l) {
    using namespace att;
    constexpr int PCH = 512;
    unsigned char* ws = F.ws; LAS unsigned char* lds = F.lds;
    const int tid = F.tid, lane = F.lane, wave = F.wave, r32 = lane & 31, hi = lane >> 5;
    const bf16_t* Qa = (const bf16_t*)(ws + WS_QA); const bf16_t* Ka = (const bf16_t*)(ws + WS_KA); const bf16_t* Va = (const bf16_t*)(ws + WS_VA);
    const unsigned* cursor = (const unsigned*)(ws + WS_CUR) + l * 512; const unsigned short* lists = (const unsigned short*)(ws + WS_LISTS);
    bf16_t* Po = (bf16_t*)(ws + WS_PO); float* Pl = (float*)(ws + WS_PL);
    const float* lutg = (const float*)(ws + WS_LUT);
    LAS float* lut = (LAS float*)(lds + L_LUT); LAS bf16_t* stg = (LAS bf16_t*)(lds + L_OST) + wave * 2048;
    LAS unsigned* pfx = (LAS unsigned*)(lds + L_TAB); LAS unsigned* nls = pfx + 512; LAS unsigned* pfs = pfx + 1024;
    LAS unsigned* scan = (LAS unsigned*)(lds + L_SM);
    __syncthreads();
    const int nlist = (int)cursor[tid];
    const int nrem = nlist % PCH, nbig = nlist / PCH + (nrem > PCH / 2 ? 1 : 0), nsml = (nrem > 0 && nrem <= PCH / 2) ? 1 : 0;
    int inc = nbig | (nsml << 16);
#pragma unroll
    for (int o = 1; o < 64; o <<= 1) { const int v = __shfl_up(inc, o); if (lane >= o) inc += v; }
    if (lane == 63) scan[wave] = (unsigned)inc;
    __syncthreads();
    { int base = 0; for (int w = 0; w < wave; ++w) base += (int)scan[w]; const int tot_ = base + inc; pfx[tid] = (unsigned)(tot_ & 0xffff); pfs[tid] = (unsigned)(tot_ >> 16); nls[tid] = (unsigned)nlist; }
    int totb = 0; for (int w = 0; w < 8; ++w) totb += (int)scan[w];
    totb = __builtin_amdgcn_readfirstlane(totb);
    const int nbigtot = totb & 0xffff; const int total = nbigtot + (totb >> 16);
    __syncthreads();
    u32x4 kreg[4], vreg[4]; float lreg[5];
    const int lw = tid >> 6, kr = lw * 8 + (lane >> 3), kc8 = lane & 7;
#define PAST_FETCH(h_, j_) do { \
        const bf16_t* Kg_ = Ka + (h_) * 64 + (size_t)((j_) * 256) * 512; const bf16_t* Vg_ = Va + (h_) * 64 + (size_t)((j_) * 256) * 512; \
        _Pragma("unroll") for (int t = 0; t < 4; ++t) { kreg[t] = *(const u32x4*)(Kg_ + (size_t)(64 * t + kr) * 512 + kc8 * 8); \
            vreg[t] = *(const u32x4*)(Vg_ + (size_t)(64 * t + 16 * (lw & 3) + (lane >> 2)) * 512 + (lw >> 2) * 32 + (lane & 3) * 8); } \
        _Pragma("unroll") for (int i = 0; i < 5; ++i) { const int ix = tid + 512 * i; lreg[i] = lutg[(size_t)(h_) * LUTN + (ix < LUTN ? ix : LUTN - 1)]; } } while (0)
#define PAST_DEC(it_, h_, j_, k_, n_) int h_, j_, k_, n_; { const bool big_ = (it_) < nbigtot; const int iq_ = big_ ? (it_) : (it_) - nbigtot; const LAS unsigned* px_ = big_ ? pfx : pfs; \
        int lo_ = 0, hi_ = 511; while (lo_ < hi_) { const int mid_ = (lo_ + hi_) >> 1; if ((int)px_[mid_] > iq_) hi_ = mid_; else lo_ = mid_ + 1; } \
        h_ = lo_ >> 6; j_ = lo_ & 63; k_ = big_ ? iq_ - (lo_ ? (int)pfx[lo_ - 1] : 0) : (int)nls[lo_] / PCH; n_ = (int)nls[lo_] - PCH * k_; n_ = n_ > PCH ? PCH : n_; \
        h_ = __builtin_amdgcn_readfirstlane(h_); j_ = __builtin_amdgcn_readfirstlane(j_); k_ = __builtin_amdgcn_readfirstlane(k_); n_ = __builtin_amdgcn_readfirstlane(n_); }
#define PAST_LP(h_, j_, k_) (lists + (size_t)(h_) * LIST_HEAD + 256 * (63 * (j_) - ((j_) * ((j_) - 1)) / 2) + (k_) * PCH)
#define WG_BAR() asm volatile("s_waitcnt lgkmcnt(0)\n\ts_barrier" ::: "memory")
    int it = F.vcu;
    unsigned ec0 = 0u, ec1 = 0u; bf16x8 qr_c[4]; int hprev = -1;
#pragma unroll
    for (int d0 = 0; d0 < 4; ++d0) qr_c[d0] = (bf16x8){0, 0, 0, 0, 0, 0, 0, 0};
    int h = 0, j = 0, kc = 0, n = 0;
    if (it < total) { PAST_DEC(it, h0, j0, k0, n0); h = h0; j = j0; kc = k0; n = n0; const int idx0 = wave * 32 + r32; const unsigned short* lp0 = PAST_LP(h0, j0, k0);
        ec0 = lp0[idx0 < n0 ? idx0 : 0]; ec1 = lp0[idx0 + 256 < n0 ? idx0 + 256 : 0]; PAST_FETCH(h0, j0); load_q(qr_c, Qa + (size_t)(ec0 & 0x3fffu) * 512 + h0 * 64, hi); }
    for (; it < total; it += F.G) {
        WG_BAR();
#pragma unroll
        for (int t = 0; t < 4; ++t) { *(LAS u32x4*)(lds + L_K + t * 8192 + kswz(kr, kc8)) = kreg[t]; *(LAS u32x4*)(lds + L_V + t * 8192 + lw * 1024 + lane * 16) = vreg[t]; }
        if (h != hprev) {
#pragma unroll
            for (int i = 0; i < 5; ++i) { const int ix = tid + 512 * i; if (ix < LUTN) lut4_put(lut, LUTN, ix, lreg[i]); }
            hprev = h; }
        WG_BAR();
        const bool hn = it + F.G < total; unsigned en0 = 0u, en1 = 0u; int hnx = 0, jnx = 0, knx = 0, nnx = 0;
        if (hn) { PAST_DEC(it + F.G, h1, j1, k1, n1); const int idx1 = wave * 32 + r32; hnx = h1; jnx = j1; knx = k1; nnx = n1; const unsigned short* lp1 = PAST_LP(h1, j1, k1);
            en0 = lp1[idx1 < n1 ? idx1 : 0]; en1 = lp1[idx1 + 256 < n1 ? idx1 + 256 : 0]; PAST_FETCH(h1, j1); }
        const float cbias = lut[LUTN - 1];
        const bool act1 = (wave + 8) * 32 < n;
#pragma unroll 1
        for (int gi = 0; gi < 2; ++gi) {
            const int g = wave + 8 * gi;
            const bool nx_same = (gi == 0) && act1; const bool nx_any = nx_same || hn;
            const unsigned nx_ent = nx_same ? ec1 : en0; const int nx_h = nx_same ? h : hnx;
            const bf16_t* nx_q = Qa + (size_t)(nx_ent & 0x3fffu) * 512 + nx_h * 64;
            if (g * 32 < n) {
                const unsigned ent_c = gi ? ec1 : ec0;
                const int idx = g * 32 + r32; const bool valid = idx < n;
                const int q = (int)(ent_c & 0x3fffu), s = (int)(ent_c >> 14);
                f32x16 o[2];
#pragma unroll
                for (int r = 0; r < 16; ++r) { o[0][r] = 0.f; o[1][r] = 0.f; }
                float lsum = 0.f;
                const int dfirst = q - j * 256;
                const LutLane LL = lut_lane(lut, LUTN, LUTN, dfirst - 4 * hi);
                bf16x8 qr_n[4];
#pragma unroll
                for (int d0 = 0; d0 < 4; ++d0) qr_n[d0] = qr_c[d0];
                if (__all(dfirst - 255 >= 1513)) {
#pragma unroll 1
                    for (int t = 0; t < 4; ++t) { tile<false, false>(o, lsum, qr_c, lds + L_K + t * 8192, lds + L_V + t * 8192, cbias, LL, dfirst - 64 * t, 0u, r32, hi, lane);
                        if (t == 1 && nx_any) load_q(qr_n, nx_q, hi); }
                } else {
#pragma unroll 1
                    for (int t = 0; t < 4; ++t) { tile<true, false>(o, lsum, qr_c, lds + L_K + t * 8192, lds + L_V + t * 8192, 0.f, LL, dfirst - 64 * t, 0u, r32, hi, lane);
                        if (t == 1 && nx_any) load_q(qr_n, nx_q, hi); }
                }
                lsum += __shfl_xor(lsum, 32);
                if (hi == 0 && valid) Pl[(size_t)(s * 8 + h) * M + q] = lsum;
                stage_o(stg, o, r32, hi);
                LDS_WAIT(); asm volatile("" ::: "memory");
#pragma unroll
                for (int i = 0; i < 4; ++i) { const int row = i * 8 + (lane >> 3), ch = lane & 7;
                    const u32x4 v = *(const LAS u32x4*)(stg + row * 64 + ch * 8);
                    const unsigned en = (unsigned)__shfl((int)ent_c, row);
                    if (g * 32 + row < n) { const int qq = (int)(en & 0x3fffu), ss = (int)(en >> 14);
                        *(u32x4*)(Po + ((size_t)(ss * 8 + h) * M + qq) * 64 + ch * 8) = v; } }
                LDS_WAIT(); asm volatile("" ::: "memory");
#pragma unroll
                for (int d0 = 0; d0 < 4; ++d0) qr_c[d0] = qr_n[d0];
            } else if (gi == 0 && nx_any) load_q(qr_c, nx_q, hi);
        }
        ec0 = en0; ec1 = en1; h = hnx; j = jnx; kc = knx; n = nnx;
    }
#undef WG_BAR
#undef PAST_FETCH
#undef PAST_DEC
#undef PAST_LP
}

__device__ __forceinline__ void phase_moba_own(Frame& F, const Args& a, int l) {
    using namespace att;
    unsigned char* ws = F.ws; LAS unsigned char* lds = F.lds;
    const int tid = F.tid, lane = F.lane, wave = F.wave, r32 = lane & 31, hi = lane >> 5;
    const bf16_t* Qa = (const bf16_t*)(ws + WS_QA); const bf16_t* Ka = (const bf16_t*)(ws + WS_KA); const bf16_t* Va = (const bf16_t*)(ws + WS_VA);
    const bf16_t* Po = (const bf16_t*)(ws + WS_PO); const float* Pl = (const float*)(ws + WS_PL);
    unsigned char* Y = (unsigned char*)F.out + DO_Y;
    const float* lutg = (const float*)(ws + WS_LUT);
    LAS float* lut = (LAS float*)(lds + L_LUT); LAS float* wsf = (LAS float*)(lds + L_WSF) + wave * 64; LAS bf16_t* stg = (LAS bf16_t*)(lds + L_OST) + wave * 2048;
#define WG_BAR() asm volatile("s_waitcnt lgkmcnt(0)\n\ts_barrier" ::: "memory")
    u32x4 kreg[4], vreg[4]; float lreg;
    const int lw = tid >> 6, kr = lw * 8 + (lane >> 3), kc8 = lane & 7;
#define OWN_FETCH(unit_) do { const int h_ = (unit_) >> 6, qb_ = (unit_) & 63; \
        const bf16_t* Kg_ = Ka + h_ * 64 + (size_t)(qb_ * 256) * 512; const bf16_t* Vg_ = Va + h_ * 64 + (size_t)(qb_ * 256) * 512; \
        _Pragma("unroll") for (int t = 0; t < 4; ++t) { kreg[t] = *(const u32x4*)(Kg_ + (size_t)(64 * t + kr) * 512 + kc8 * 8); \
            vreg[t] = *(const u32x4*)(Vg_ + (size_t)(64 * t + 16 * (lw & 3) + (lane >> 2)) * 512 + (lw >> 2) * 32 + (lane & 3) * 8); } \
        lreg = lutg[(size_t)h_ * LUTN + tid]; } while (0)
    int unit = F.vcu;
    if (unit < 512) OWN_FETCH(unit);
    for (; unit < 512; unit += F.G) {
        const int h = unit >> 6, qb = unit & 63, nsl = qb < 3 ? qb : 3;
        const int q = qb * 256 + 32 * wave + r32;
        bf16x8 qr[4]; load_q(qr, Qa + (size_t)q * 512 + h * 64, hi);
        u32x4 pov[4][3]; float plv[4][3];
#pragma unroll
        for (int i = 0; i < 4; ++i) { const int row = i * 8 + (lane >> 3), ch = lane & 7, qq = qb * 256 + 32 * wave + row;
#pragma unroll
            for (int s = 0; s < 3; ++s) { const size_t pi = (size_t)(s * 8 + h) * M + qq;
                if (s < nsl) { plv[i][s] = Pl[pi]; pov[i][s] = __builtin_nontemporal_load((const u32x4*)(Po + pi * 64 + ch * 8)); } else { plv[i][s] = 0.f; pov[i][s] = (u32x4){0u, 0u, 0u, 0u}; } } }
        WG_BAR();
#pragma unroll
        for (int t = 0; t < 4; ++t) { *(LAS u32x4*)(lds + L_K + t * 8192 + kswz(kr, kc8)) = kreg[t]; *(LAS u32x4*)(lds + L_V + t * 8192 + lw * 1024 + lane * 16) = vreg[t]; }
        lut4_put(lut, 512, tid, lreg);
        WG_BAR();
        if (unit + F.G < 512) OWN_FETCH(unit + F.G);
        f32x16 o[2];
#pragma unroll
        for (int r = 0; r < 16; ++r) { o[0][r] = 0.f; o[1][r] = 0.f; }
        float lsum = 0.f; const int nt = (wave >> 1) + 1; const LutLane LL = lut_lane(lut, 512, 512, r32 - 4 * hi);
#pragma unroll 1
        for (int t = 0; t < nt; ++t)
            tile<true, true>(o, lsum, qr, lds + L_K + t * 8192, lds + L_V + t * 8192, 0.f, LL, 32 * wave + r32 - 64 * t, 0x7fffffffu, r32, hi, lane, t == nt - 1);
        lsum += __shfl_xor(lsum, 32);
        if (hi == 0) wsf[r32] = lsum;
        stage_o(stg, o, r32, hi);
        LDS_WAIT(); asm volatile("" ::: "memory");
#pragma unroll
        for (int i = 0; i < 4; ++i) { const int row = i * 8 + (lane >> 3), ch = lane & 7, qq = qb * 256 + 32 * wave + row;
            const u32x4 v = *(const LAS u32x4*)(stg + row * 64 + ch * 8); float f[8]; unpack8(f, v);
            float L = wsf[row];
#pragma unroll
            for (int s = 0; s < 3; ++s) { L += plv[i][s]; float pf[8]; unpack8(pf, pov[i][s]);
#pragma unroll
                for (int e = 0; e < 8; ++e) f[e] += pf[e]; }
            const float inv = F8_SY / L;
#pragma unroll
            for (int e = 0; e < 8; ++e) f[e] *= inv;
            const size_t yo = (size_t)qq * 1024 + h * 64 + ch * 8;
            if (F8_G2) *(u32x2*)(Y + yo) = pack8f8(f); else *(u32x4*)(Y + 2 * yo) = pack8(f); }
        LDS_WAIT(); asm volatile("" ::: "memory");
    }
#undef OWN_FETCH
#undef WG_BAR
}

__global__ void __launch_bounds__(512, 2) fwd_kernel(Args args) {
    extern __shared__ __attribute__((aligned(16))) unsigned char lds_raw[];
    Frame F;
    F.lds = (LAS unsigned char*)lds_raw;
    F.tid = threadIdx.x; F.lane = F.tid & 63; F.wave = __builtin_amdgcn_readfirstlane(F.tid >> 6);
    F.G = gridDim.x; { const int bx = blockIdx.x; F.vcu = (F.G % 8 == 0) ? (bx % 8) * (F.G / 8) + bx / 8 : bx; }
    F.ws = args.ws; F.out = args.out;
    unsigned char* ws = args.ws;
    volatile LAS unsigned* MISC = (volatile LAS unsigned*)(F.lds + MISC_OFF);
    for (int u = F.tid; u < (LDS_BYTES - LDSCTL_OFF) / 4; u += 512) ((LAS unsigned*)(F.lds + LDSCTL_OFF))[u] = 0u;
    __syncthreads();
    XcdBarrier bar; bar.bar = (unsigned*)(ws + WS_CTL) + 4096; bar.x = 0; bar.st = nullptr;
    const bool multi = (args.ph_hi - args.ph_lo) > 1;
    if (multi) bar = xcd_barrier_post((unsigned*)(ws + WS_CTL) + 4096, MISC + 8);

    const int lo = args.ph_lo, hi = args.ph_hi;
    float* ssq = (float*)(ws + WS_SSQ);
#ifndef PH_MASK
#define PH_MASK 0x1ffff
#endif
#define IN(k) (lo <= (k) && (k) < hi && ((PH_MASK >> ((k) > 8 ? (k) - 8 : (k))) & 1))
#define SEAM(k) do { if (IN(k) && IN((k) + 1)) xcd_barrier(bar); } while (0)
#ifndef REP_MASK
#define REP_MASK 0
#endif
#define RUN(p, l, X) do { if (IN(1 + NPH * (l) + (p))) { X; if ((REP_MASK >> (p)) & 1) { xcd_barrier(bar); X; } } SEAM(1 + NPH * (l) + (p)); } while (0)
#define WB(l) ((l) == 0 ? (unsigned char*)args.out + DO_W : ws + WS_W)
#define PH_G1(l) do { \
        pg8::Gemm g{F8_G1 ? ws + WS_X8 : ws + WS_XB, WB(l) + OFF_WIN, F8_G1 ? D : 2 * D, F8_G1 ? D : 2 * D, F8_G1 ? D : 2 * D, 0}; pg8::StaticOrder S; S.init(M, INW - 256, F.G, (int)blockIdx.x, 1); \
        const int pm0_ = S.first_pm(); const LAS float* rt_ = (const LAS float*)(F.lds + L_RSTD); proj_consts((LAS float*)(F.lds + L_RSTD), args.in[5] + (l) * 64, args.in[6] + (l) * 64, args.in[7] + (l) * 64, args.in[8] + (l) * 64, args.in[4] + (l) * 2048); rstd_table((LAS float*)(F.lds + L_RSTD), ssq, pm0_ < 0 ? 0 : pm0_, F8_G1 ? 1.0f / F8_SW : 1.0f); \
        pg8::EpiProj E{rt_, (bf16_t*)(ws + WS_QA), (bf16_t*)(ws + WS_KA), (bf16_t*)(ws + WS_VA), (bf16_t*)(ws + WS_QB), (bf16_t*)(ws + WS_KB), (bf16_t*)(ws + WS_VB), (bf16_t*)(ws + WS_GT), (float*)(ws + WS_KMP)}; \
        pg8::gemm_phase<F8_G1 != 0, pg8::EpiProj>(F.lds, g, S, E); } while (0)
#define PH_G2(l) do { \
        pg8::Gemm g{(unsigned char*)args.out + DO_Y, WB(l) + OFF_WBR, F8_G2 ? D : 2 * D, F8_G2 ? D : 2 * D, F8_G2 ? 512 : 1024, F8_G2 ? 512 : 1024}; pg8::StaticOrder S; S.init(M, D, F.G, (int)blockIdx.x, 2); \
        pg8::EpiMerge E{(const bf16_t*)(ws + WS_GT), ws + WS_MRG}; \
        pg8::gemm_phase<F8_G2 != 0, pg8::EpiMerge>(F.lds, g, S, E); } while (0)
#define PH_G3(l) do { \
        pg8::Gemm g{ws + WS_MRG, WB(l) + OFF_WOUT, F8_G3 ? D : 2 * D, F8_G3 ? D : 2 * D, F8_G3 ? D : 2 * D, 0}; pg8::StaticOrder S; S.init(M, D, F.G, (int)blockIdx.x, 1); \
        pg8::EpiResid E{(bf16_t*)(ws + WS_XB), ssq, nullptr, 1.0f / (F8_SM * F8_SW3), nullptr}; \
        pg8::gemm_phase<F8_G3 != 0, pg8::EpiResid>(F.lds, g, S, E); } while (0)
#define PH_G4(l) do { \
        pg8::Gemm g{ws + WS_XB, WB(l) + OFF_W1, 2 * D, 2 * D, 2 * D, 0}; pg8::StaticOrder S; S.init(M, FF, F.G, (int)blockIdx.x, 1); \
        const int pm0_ = S.first_pm(); const LAS float* rt_ = (const LAS float*)(F.lds + L_RSTD); rstd_table((LAS float*)(F.lds + L_RSTD), ssq, pm0_ < 0 ? 0 : pm0_, 1.0f); \
        pg8::EpiFfnUp E{rt_, (bf16_t*)(ws + WS_U)}; \
        pg8::gemm_phase<false, pg8::EpiFfnUp>(F.lds, g, S, E); } while (0)
#define PH_G5(l) do { \
        pg8::Gemm g{ws + WS_U, WB(l) + OFF_W2, 2 * FF, 2 * FF, 2 * FF, 0}; pg8::StaticOrder S; S.init(M, D, F.G, (int)blockIdx.x, 1); \
        pg8::EpiResid E{(bf16_t*)(ws + WS_XB), ssq, (l) == NLAYER - 1 ? args.out : nullptr, 1.0f, (l) == NLAYER - 1 || !F8_G1 ? nullptr : ws + WS_X8}; \
        pg8::gemm_phase<false, pg8::EpiResid>(F.lds, g, S, E); } while (0)
#define LAYER(l) do { \
    RUN(0, l, PH_G1(l)); \
    RUN(1, l, phase_swa_select(F, args, (l))); \
    RUN(2, l, phase_moba_past(F, args, (l))); \
    RUN(3, l, phase_moba_own(F, args, (l))); \
    RUN(4, l, PH_G2(l)); \
    if (IN(1 + NPH * (l) + 5)) { PH_G3(l); } SEAM(1 + NPH * (l) + 5); \
    RUN(6, l, PH_G4(l)); \
    if (IN(1 + NPH * (l) + 7)) { PH_G5(l); } SEAM(1 + NPH * (l) + 7); \
    } while (0)
    if (IN(0)) { phase_prologue(F, args); } SEAM(0);
    LAYER(0);
    LAYER(1);
#undef LAYER
#undef RUN
#undef WB
#undef SEAM
#undef IN
}

extern "C" void kernel_launch(void* const* d_in, const int* in_sizes, int n_in, void* d_out, int out_size, void* d_ws, size_t ws_size, hipStream_t stream) {
    static int grid = 0;
    if (grid == 0) {
        if (n_in != 16 || out_size != M * D || ws_size < WS_END) { fprintf(stderr, "kernel_launch: unexpected shapes (n_in %d out %d ws %zu)\n", n_in, out_size, ws_size); grid = -1; return; }
        if (hipFuncSetAttribute((const void*)fwd_kernel, hipFuncAttributeMaxDynamicSharedMemorySize, LDS_BYTES) != hipSuccess) { fprintf(stderr, "kernel_launch: hipFuncSetAttribute failed\n"); grid = -1; return; }
        (void)hipGetLastError();
        grid = 256;
    }
    if (grid < 0) return;
    (void)hipMemsetAsync((char*)d_ws + WS_CTL, 0, CTL_ZERO_BYTES, stream);
    Args a{};
    for (int i = 0; i < 16; ++i) a.in[i] = (const float*)d_in[i];
    a.out = (float*)d_out; a.ws = (unsigned char*)d_ws;
    constexpr int NPHASES = 1 + NLAYER * NPH;
    if (MK_N_LAUNCHES == 1) {
        a.ph_lo = 0; a.ph_hi = NPHASES;
        hipLaunchKernelGGL(fwd_kernel, dim3(grid), dim3(512), LDS_BYTES, stream, a);
    } else {
        for (int p = 0; p < NPHASES; ++p) { a.ph_lo = p; a.ph_hi = p + 1; hipLaunchKernelGGL(fwd_kernel, dim3(grid), dim3(512), LDS_BYTES, stream, a); }
    }
}
```

```cpp
#include <hip/hip_runtime.h>
#include <hip/hip_bf16.h>
#include <cstdint>
#include <cstdio>

#ifndef MK_N_LAUNCHES
#define MK_N_LAUNCHES 1
#endif

#ifndef F8_G1
#define F8_G1 1
#endif
#ifndef F8_G2
#define F8_G2 1
#endif
#ifndef F8_G3
#define F8_G3 1
#endif

#define LAS __attribute__((address_space(3)))
#define GAS __attribute__((address_space(1)))
typedef unsigned short bf16_t;
typedef short bf16x8 __attribute__((ext_vector_type(8)));
typedef float f32x4 __attribute__((ext_vector_type(4)));
typedef float f32x2 __attribute__((ext_vector_type(2)));
typedef float f32x16 __attribute__((ext_vector_type(16)));
typedef unsigned u32x4 __attribute__((ext_vector_type(4)));
typedef unsigned u32x2 __attribute__((ext_vector_type(2)));
typedef short v4i16_t __attribute__((ext_vector_type(4)));
typedef __bf16 bf16x2_t __attribute__((ext_vector_type(2)));
typedef int i32x8 __attribute__((ext_vector_type(8)));
typedef int i32x4 __attribute__((ext_vector_type(4)));

constexpr int M = 16384, D = 1024, INW = 4352, FF = 4096, NLAYER = 2;
constexpr int NPH = 8;
constexpr float NORM_EPS = 1e-6f;
constexpr float LOG2E = 1.4426950408889634f;
constexpr float C2 = 0.125f * LOG2E;
constexpr int LUTN = 2176, LUTPAD = 128;

constexpr size_t MiB = 1u << 20;
constexpr size_t WS_CTL = 0, CTL_ZERO_BYTES = 64 * 1024;
constexpr size_t WS_SSQ = 64 * 1024;
constexpr size_t WS_KMP = WS_SSQ + 1 * MiB;
constexpr size_t WS_LUT = WS_KMP + 256 * 1024;
constexpr size_t WS_CUR = WS_LUT + 256 * 1024;
constexpr size_t WS_PL = WS_CUR + 64 * 1024;
constexpr size_t WS_W = 3 * MiB + 512 * 1024;
constexpr size_t OFF_WIN = 0;
constexpr size_t OFF_WBR = OFF_WIN + (size_t)INW * D * 2;
constexpr size_t OFF_WOUT = OFF_WBR + 2 * MiB;
constexpr size_t OFF_W1 = OFF_WOUT + 2 * MiB;
constexpr size_t OFF_W2 = OFF_W1 + 8 * MiB;
constexpr size_t W_BYTES = OFF_W2 + 8 * MiB;
constexpr size_t WS_XB = WS_W + W_BYTES;
constexpr size_t WS_PROJ = WS_XB + 32 * MiB;
constexpr size_t WS_QA = WS_PROJ, WS_KA = WS_QA + 16 * MiB, WS_VA = WS_KA + 16 * MiB, WS_QB = WS_VA + 16 * MiB;
constexpr size_t WS_KB = WS_QB + 16 * MiB, WS_VB = WS_KB + 4 * MiB, WS_GT = WS_VB + 4 * MiB;
constexpr size_t WS_MRG = WS_PROJ;
constexpr size_t WS_U = WS_PROJ;
constexpr size_t WS_PO = WS_GT + 64 * MiB;
constexpr size_t WS_LISTS = WS_PO + 48 * MiB;
constexpr int LIST_HEAD = 516096;
constexpr size_t WS_END = WS_LISTS + (size_t)8 * LIST_HEAD * 2;
static_assert(WS_END <= 256 * MiB, "ws map");
static_assert(WS_U + (size_t)M * FF * 2 <= WS_PO, "u overlay");
static_assert(WS_PL + 3 * 8 * (size_t)M * 4 <= WS_W, "misc map");
constexpr size_t DO_Y = 0, DO_W = 32 * MiB;
constexpr size_t WS_X8 = WS_PO;

constexpr int RING_BYTES = 131072;
constexpr int LDSCTL_OFF = 145408, MISC_OFF = LDSCTL_OFF + 320;
constexpr int LDS_BYTES = 147456;
constexpr int L_K = 0, L_V = 32768, L_OST = 65536, L_WSF = 98304, L_LUT = 100352, L_TAB = 135168, L_SM = 143360;
constexpr int L_RSTD = 131072;
static_assert(L_RSTD + 2560 * 4 <= LDSCTL_OFF, "epilogue tables");
static_assert(L_LUT + 4 * LUTN * 4 <= L_TAB && L_TAB + 4096 <= L_SM && L_SM + 1024 <= LDSCTL_OFF && MISC_OFF + 128 <= LDS_BYTES, "LDS map");

__device__ __forceinline__ unsigned cvtpk(float lo, float hi) { f32x2 v = {lo, hi}; bf16x2_t b = __builtin_convertvector(v, bf16x2_t); return __builtin_bit_cast(unsigned, b); }
__device__ __forceinline__ float bf_lo(unsigned w) { return __builtin_bit_cast(float, w << 16); }
__device__ __forceinline__ float bf_hi(unsigned w) { return __builtin_bit_cast(float, w & 0xffff0000u); }
__device__ __forceinline__ unsigned f2bf(float f) { unsigned u = __builtin_bit_cast(unsigned, f); return (u + 0x7fffu + ((u >> 16) & 1u)) >> 16; }
__device__ __forceinline__ unsigned pk2(float lo, float hi) { return f2bf(lo) | (f2bf(hi) << 16); }
__device__ __forceinline__ unsigned pk4f8(float a, float b, float c, float d) { int p = __builtin_amdgcn_cvt_pk_fp8_f32(a, b, 0, false); p = __builtin_amdgcn_cvt_pk_fp8_f32(c, d, p, true); return (unsigned)p; }
constexpr float F8_SW = 40.f, F8_SY = F8_G2 ? 10.f : 1.f, F8_SM = F8_G3 ? 10.f : 1.f;
constexpr float F8_SW2 = F8_G2 ? F8_SW : 1.f, F8_SW3 = F8_G3 ? F8_SW : 1.f;

namespace pg8 {
constexpr int BM = 256, BK = 64, HALF = 128, HTB = HALF * BK * 2, NXCD = 8, WGM = 8;
__host__ __device__ __forceinline__ int lds_byte(int r, int c) { const int st = (r >> 4) * 2 + (c >> 5), rr = r & 15, cc = c & 31, ob = rr * 64 + cc * 2; return st * 1024 + (ob ^ (((ob >> 9) & 1) << 5)); }
__host__ __device__ __forceinline__ void stage_rc(int b, int& R, int& C) { const int st = b / 1024, sb = b % 1024, swz = sb ^ (((sb >> 9) & 1) << 5); R = (st >> 1) * 16 + swz / 64; C = (st & 1) * 32 + (swz % 64) / 2; }
__host__ __device__ __forceinline__ int perm32(int rho) { const int n = rho >> 4, i = rho & 15; return 8 * (i >> 2) + 4 * n + (i & 3); }

struct Unit { int pm, pn, part; };
struct Gemm { const void* A; const void* Bt; int lda, ldb, K, kpart; };

struct StaticOrder {
    int nM, nN, nwg, G, c, parts;
    int fixed, fpm, fpn;
    __device__ __forceinline__ void init(int M_, int N_, int G_, int c_, int parts_) { nM = M_ / BM; nN = N_ / BM; nwg = nM * nN; G = G_; c = c_; parts = parts_; fixed = 0; fpm = 0; fpn = 0; }
    __device__ __forceinline__ void init_single(int pm_, int pn_, bool have) { nM = 1; nN = 1; nwg = 1; G = 1; c = 0; parts = 1; fixed = have ? 1 : 2; fpm = pm_; fpn = pn_; }
    __device__ __forceinline__ int first_pm() const {
        if (c >= nwg) return -1;
        int wgid = c; { const int q = nwg / NXCD, r = nwg % NXCD, xcd = wgid % NXCD, off = wgid / NXCD; wgid = (xcd < r ? xcd * (q + 1) : r * (q + 1) + (xcd - r) * q) + off; }
        const int nig = WGM * nN, gid = wgid / nig, fm = gid * WGM, gsz = (nM - fm) < WGM ? (nM - fm) : WGM;
        return fm + ((wgid % nig) % gsz);
    }
    __device__ __forceinline__ bool next(int i, Unit& u) const {
        if (fixed) { u.pm = fpm; u.pn = fpn; u.part = 0; return fixed == 1 && i == 0; }
        const int ti = i / parts; u.part = i - ti * parts;
        const long L = (long)ti * G + c; if (L >= nwg) return false;
        int wgid = (int)L; { const int q = nwg / NXCD, r = nwg % NXCD, xcd = wgid % NXCD, off = wgid / NXCD; wgid = (xcd < r ? xcd * (q + 1) : r * (q + 1) + (xcd - r) * q) + off; }
        const int nig = WGM * nN, gid = wgid / nig, fm = gid * WGM, gsz = (nM - fm) < WGM ? (nM - fm) : WGM;
        u.pm = fm + ((wgid % nig) % gsz); u.pn = (wgid % nig) / gsz; return true;
    }
};

template <bool F8, class Epi>
__device__ __forceinline__ void gemm_phase(LAS unsigned char* lds, const Gemm g, const StaticOrder& S, const Epi& E) {
    const int tid = threadIdx.x, wid = __builtin_amdgcn_readfirstlane(tid >> 6), lane = tid & 63, wr = wid >> 2, wc = wid & 3, fr = lane & 15, fq = lane >> 4;
    const int nt = g.K / 128;
    unsigned voffA, voffB;
    { int R, C; stage_rc(tid * 16, R, C); const int Rb = (R & ~31) + perm32(R & 31); voffA = (unsigned)(R * g.lda + 2 * C); voffB = (unsigned)(Rb * g.ldb + 2 * C); }
    const size_t ivoffA = (size_t)64 * g.lda, ivoffB = (size_t)64 * g.ldb;
    const size_t kstep = (size_t)(BK * 2);
    const size_t hstepA = (size_t)HALF * g.lda, hstepB = (size_t)HALF * g.ldb;
    const size_t tstepA = 2 * hstepA, tstepB = 2 * hstepB;
    const unsigned ldsw = (unsigned)wid * 1024u;
    const int aoff = lds_byte(wr * 64 + fr, fq * 8), boff = lds_byte(wc * 32 + fr, fq * 8);
#define PG8_SA(b, h) (((b) * 2 + (h)) * HTB)
#define PG8_SB(b, h) ((4 + (b) * 2 + (h)) * HTB)
#define PG8_STAGE(bufoff, gbase, voff) do { _Pragma("unroll") for (int _i = 0; _i < 2; ++_i) \
        __builtin_amdgcn_global_load_lds((const unsigned*)((const char*)(gbase) + _i * i##voff + (voff)), (LAS unsigned*)(lds + (bufoff) + ldsw + _i * 8192), 16, 0, 0); } while (0)
#define PG8_LDA(dst, b, h) do { _Pragma("unroll") for (int m = 0; m < 4; ++m) _Pragma("unroll") for (int k = 0; k < 2; ++k) dst[m][k] = *(const LAS bf16x8*)(lds + PG8_SA(b, h) + aoff + m * 2048 + k * 1024); } while (0)
#define PG8_LDB(dst, b, h) do { _Pragma("unroll") for (int n = 0; n < 2; ++n) _Pragma("unroll") for (int k = 0; k < 2; ++k) dst[n][k] = *(const LAS bf16x8*)(lds + PG8_SB(b, h) + boff + n * 2048 + k * 1024); } while (0)
#define PG8_F8CAT(x) __builtin_shufflevector(__builtin_bit_cast(i32x4, x[0]), __builtin_bit_cast(i32x4, x[1]), 0, 1, 2, 3, 4, 5, 6, 7)
#define PG8_MMA(ai, bj, At, Bt) do { __builtin_amdgcn_s_setprio(1); _Pragma("unroll") for (int m = 0; m < 4; ++m) _Pragma("unroll") for (int n = 0; n < 2; ++n) { \
        if (F8) { const i32x8 b8_ = PG8_F8CAT(Bt[n]), a8_ = PG8_F8CAT(At[m]); asm volatile("v_mfma_scale_f32_16x16x128_f8f6f4 %0, %1, %2, %0, %3, %3 op_sel_hi:[0,0,0]" : "+v"(acc[ai][bj][m][n]) : "v"(b8_), "v"(a8_), "v"(f8one)); } \
        else { _Pragma("unroll") for (int k = 0; k < 2; ++k) acc[ai][bj][m][n] = __builtin_amdgcn_mfma_f32_16x16x32_bf16(Bt[n][k], At[m][k], acc[ai][bj][m][n], 0, 0, 0); } } __builtin_amdgcn_s_setprio(0); } while (0)
#define PG8_WAIT_V(n) asm volatile("s_waitcnt vmcnt(" #n ")" ::: "memory")
#define PG8_WAIT_L(n) asm volatile("s_waitcnt lgkmcnt(" #n ")" ::: "memory")
#define PG8_BAR __builtin_amdgcn_s_barrier()
#define PG8_SCHED __builtin_amdgcn_sched_barrier(0)
    Unit cur, nxt; int ui = 0;
    if (!S.next(0, cur)) return;
    const int f8one = 0x7f7f7f7f;
    f32x4 acc[2][2][4][2];
#pragma unroll
    for (int a = 0; a < 2; ++a)
#pragma unroll
        for (int b = 0; b < 2; ++b)
#pragma unroll
            for (int m = 0; m < 4; ++m)
#pragma unroll
                for (int n = 0; n < 2; ++n) acc[a][b][m][n] = (f32x4){0.f, 0.f, 0.f, 0.f};
    bf16x8 At[4][2], B0[2][2], B1[2][2];
    const char* cA = (const char*)g.A + (size_t)cur.pm * tstepA + (size_t)cur.part * g.kpart; const char* cB = (const char*)g.Bt + (size_t)cur.pn * tstepB + (size_t)cur.part * g.kpart;
    PG8_STAGE(PG8_SB(0, 0), cB, voffB); PG8_STAGE(PG8_SB(0, 1), cB + hstepB, voffB); PG8_STAGE(PG8_SA(0, 0), cA, voffA); PG8_STAGE(PG8_SA(0, 1), cA + hstepA, voffA);
    if (wr == 1) PG8_BAR;
    PG8_WAIT_V(2); PG8_BAR;
    PG8_STAGE(PG8_SB(1, 0), cB + kstep, voffB); PG8_STAGE(PG8_SA(1, 0), cA + kstep, voffA); PG8_STAGE(PG8_SB(1, 1), cB + hstepB + kstep, voffB);
    PG8_WAIT_V(6); PG8_BAR;
    for (;;) {
        const bool has_next = S.next(ui + 1, nxt);
        const char* nA = has_next ? (const char*)g.A + (size_t)nxt.pm * tstepA + (size_t)nxt.part * g.kpart : cA;
        const char* nB = has_next ? (const char*)g.Bt + (size_t)nxt.pn * tstepB + (size_t)nxt.part * g.kpart : cB;
#pragma unroll 1
        for (int t = 0; t < nt; t += 2) {
            const bool last = (t == nt - 2);
            const char* a1 = cA + (size_t)(t + 1) * kstep;
            const char* a2 = last ? nA : cA + (size_t)(t + 2) * kstep; const char* b2 = last ? nB : cB + (size_t)(t + 2) * kstep;
            const char* a3 = a2 + kstep; const char* b3 = b2 + kstep;
            PG8_LDB(B0, 0, 0); PG8_LDB(B1, 0, 1); PG8_SCHED; PG8_LDA(At, 0, 0); PG8_STAGE(PG8_SA(1, 1), a1 + hstepA, voffA);
            PG8_WAIT_V(8); PG8_WAIT_L(0); PG8_BAR; PG8_MMA(0, 0, At, B0); PG8_MMA(0, 1, At, B1); PG8_BAR; PG8_SCHED;
            PG8_LDA(At, 0, 1); PG8_STAGE(PG8_SB(0, 0), b2, voffB); PG8_STAGE(PG8_SB(0, 1), b2 + hstepB, voffB); PG8_STAGE(PG8_SA(0, 0), a2, voffA);
            PG8_WAIT_V(8); PG8_WAIT_L(0); PG8_BAR; PG8_MMA(1, 0, At, B0); PG8_MMA(1, 1, At, B1); PG8_BAR; PG8_SCHED;
            PG8_LDB(B0, 1, 0); PG8_LDB(B1, 1, 1); PG8_SCHED; PG8_LDA(At, 1, 0); PG8_STAGE(PG8_SA(0, 1), a2 + hstepA, voffA);
            PG8_WAIT_V(8); PG8_WAIT_L(0); PG8_BAR; PG8_MMA(0, 0, At, B0); PG8_MMA(0, 1, At, B1); PG8_BAR; PG8_SCHED;
            PG8_LDA(At, 1, 1); PG8_STAGE(PG8_SB(1, 0), b3, voffB); PG8_STAGE(PG8_SB(1, 1), b3 + hstepB, voffB); PG8_STAGE(PG8_SA(1, 0), a3, voffA);
            PG8_WAIT_V(8); PG8_WAIT_L(0); PG8_BAR; PG8_MMA(1, 0, At, B0); PG8_MMA(1, 1, At, B1); PG8_BAR; PG8_SCHED;
        }
        if (F8) asm volatile("s_nop 15\n\ts_nop 15" ::: "memory");
        if (wr == 0) PG8_BAR;
        E(acc, cur, wr, wc, fr, fq);
        if (!has_next) break;
        if (!E.keep(cur)) {
#pragma unroll
        for (int a = 0; a < 2; ++a)
#pragma unroll
            for (int b = 0; b < 2; ++b)
#pragma unroll
                for (int m = 0; m < 4; ++m)
#pragma unroll
                    for (int n = 0; n < 2; ++n) acc[a][b][m][n] = (f32x4){0.f, 0.f, 0.f, 0.f};
        }
        cur = nxt; cA = nA; cB = nB; ++ui;
        if (wr == 1) PG8_BAR;
    }
    PG8_WAIT_V(0);
    PG8_BAR;
#undef PG8_SA
#undef PG8_SB
#undef PG8_STAGE
#undef PG8_LDA
#undef PG8_LDB
#undef PG8_MMA
#undef PG8_F8CAT
#undef PG8_WAIT_V
#undef PG8_WAIT_L
#undef PG8_BAR
#undef PG8_SCHED
}

__device__ __forceinline__ float row_rstd(const float* ssq, int row, int fq) {
    const f32x4 s4 = *(const f32x4*)(ssq + (size_t)row * 16 + 4 * fq);
    float s = (s4[0] + s4[1]) + (s4[2] + s4[3]);
    s += __shfl_xor(s, 16); s += __shfl_xor(s, 32);
    return 1.0f / sqrtf(s * (1.0f / 1024.0f) + NORM_EPS);
}
__device__ __forceinline__ void store8(bf16_t* p, const f32x4 a, const f32x4 b) {
    u32x4 w; w.x = cvtpk(a[0], a[1]); w.y = cvtpk(a[2], a[3]); w.z = cvtpk(b[0], b[1]); w.w = cvtpk(b[2], b[3]); *(u32x4*)p = w;
}

struct EpiProj {
    const LAS float* rtab; bf16_t *Qa, *Ka, *Va, *Qb, *Kb, *Vb, *Gt; float* kmp;
    __device__ __forceinline__ bool keep(const Unit&) const { return false; }
    __device__ __forceinline__ void operator()(f32x4 (&acc)[2][2][4][2], const Unit& u, int wr, int wc, int fr, int fq) const {
        const int pn = u.pn, row0 = u.pm * BM + wr * 64 + fr;
        int mode; bf16_t* dst; int ld, col0; const LAS float* w = rtab + 256; int kmhead = -1;
        if (pn < 2) { mode = 0; dst = Qa; ld = 512; col0 = (4 * pn + wc) * 64; }
        else if (pn < 4) { mode = 0; dst = Ka; ld = 512; col0 = (4 * (pn - 2) + wc) * 64; w += 64; kmhead = 4 * (pn - 2) + wc; }
        else if (pn < 6) { mode = 1; dst = Va; ld = 512; col0 = (4 * (pn - 4) + wc) * 64; }
        else if (pn < 8) { mode = 0; dst = Qb; ld = 512; col0 = (4 * (pn - 6) + wc) * 64; w += 128; }
        else if (pn == 8) { if (wc < 2) { mode = 0; dst = Kb; ld = 128; col0 = wc * 64; w += 192; } else { mode = 1; dst = Vb; ld = 128; col0 = (wc - 2) * 64; } }
        else { mode = 2; dst = Gt; ld = 2048; col0 = (pn - 9) * 128 + 32 * wc; }
        f32x4 cw[2][2];
#pragma unroll
        for (int bj = 0; bj < 2; ++bj)
#pragma unroll
            for (int n = 0; n < 2; ++n) {
                if (mode == 0) cw[bj][n] = *(const LAS f32x4*)(w + 32 * bj + 8 * fq + 4 * n);
                else if (mode == 2) cw[bj][n] = *(const LAS f32x4*)(rtab + 512 + 1024 * bj + col0 + 8 * fq + 4 * n);
                else cw[bj][n] = (f32x4){1.f, 1.f, 1.f, 1.f};
            }
        f32x4 ks[2][2];
#pragma unroll
        for (int bj = 0; bj < 2; ++bj)
#pragma unroll
            for (int n = 0; n < 2; ++n) ks[bj][n] = (f32x4){0.f, 0.f, 0.f, 0.f};
#pragma unroll
        for (int ai = 0; ai < 2; ++ai)
#pragma unroll
            for (int m = 0; m < 4; ++m) {
                const int row = row0 + ai * HALF + m * 16;
                const float rs = rtab[ai * HALF + wr * 64 + m * 16 + fr];
                f32x4 v[2][2];
#pragma unroll
                for (int bj = 0; bj < 2; ++bj)
#pragma unroll
                    for (int n = 0; n < 2; ++n) v[bj][n] = acc[ai][bj][m][n] * rs;
                if (mode == 0) {
                    float ss = 0.f;
#pragma unroll
                    for (int bj = 0; bj < 2; ++bj)
#pragma unroll
                        for (int n = 0; n < 2; ++n) { const f32x4 x = v[bj][n]; ss += (x[0] * x[0] + x[1] * x[1]) + (x[2] * x[2] + x[3] * x[3]); }
                    ss += __shfl_xor(ss, 16); ss += __shfl_xor(ss, 32);
                    const float inv = 1.0f / sqrtf(ss * (1.0f / 64.0f) + NORM_EPS);
#pragma unroll
                    for (int bj = 0; bj < 2; ++bj)
#pragma unroll
                        for (int n = 0; n < 2; ++n) { v[bj][n] = v[bj][n] * inv * cw[bj][n]; ks[bj][n] += v[bj][n]; }
                } else if (mode == 2) {
#pragma unroll
                    for (int n = 0; n < 2; ++n) { f32x4 xa = v[0][n] + cw[0][n], xg = v[1][n] + cw[1][n];
#pragma unroll
                        for (int e = 0; e < 4; ++e) { const float da = 1.0f + __builtin_amdgcn_exp2f(-LOG2E * xa[e]), db = fminf(1.0f + __builtin_amdgcn_exp2f(-LOG2E * xg[e]), 1e20f);
                            xg[e] = __builtin_amdgcn_rcpf(db); xa[e] = db * __builtin_amdgcn_rcpf(da); }
                        v[0][n] = xa; v[1][n] = xg; }
                }
                bf16_t* rp = dst + (size_t)row * ld + col0 + 8 * fq;
                if (mode == 2) {
                    constexpr float cG = F8_SM / (F8_SW2 * F8_SY);
                    store8(rp, v[0][0], v[0][1]); store8(rp + 1024, v[1][0] * cG, v[1][1] * cG);
                } else { store8(rp, v[0][0], v[0][1]); store8(rp + 32, v[1][0], v[1][1]); }
            }
        if (kmhead >= 0) {
#pragma unroll
            for (int bj = 0; bj < 2; ++bj)
#pragma unroll
                for (int n = 0; n < 2; ++n) { f32x4 x = ks[bj][n];
#pragma unroll
                    for (int o = 1; o < 16; o <<= 1) { x[0] += __shfl_xor(x[0], o); x[1] += __shfl_xor(x[1], o); x[2] += __shfl_xor(x[2], o); x[3] += __shfl_xor(x[3], o); }
                    if (fr == 0) *(f32x4*)(kmp + ((size_t)(kmhead * 64 + u.pm) * 2 + wr) * 64 + 32 * bj + 8 * fq + 4 * n) = x; }
        }
    }
};

struct EpiMerge {
    const bf16_t* Gt; unsigned char* out;
    __device__ __forceinline__ bool keep(const Unit& u) const { return u.part == 0; }
    __device__ __forceinline__ void operator()(f32x4 (&acc)[2][2][4][2], const Unit& u, int wr, int wc, int fr, int fq) const {
        const int row0 = u.pm * BM + wr * 64 + fr, colb = u.pn * BM + wc * 32 + 8 * fq;
        const bf16_t* gp = Gt + (u.part == 0 ? 0 : 1024);
        u32x4 gw[2][4][2];
#pragma unroll
        for (int ai = 0; ai < 2; ++ai)
#pragma unroll
            for (int m = 0; m < 4; ++m)
#pragma unroll
                for (int bj = 0; bj < 2; ++bj) gw[ai][m][bj] = __builtin_nontemporal_load((const u32x4*)(gp + (size_t)(row0 + ai * HALF + m * 16) * 2048 + colb + bj * HALF));
#pragma unroll
        for (int ai = 0; ai < 2; ++ai)
#pragma unroll
            for (int m = 0; m < 4; ++m) {
                const int row = row0 + ai * HALF + m * 16;
#pragma unroll
                for (int bj = 0; bj < 2; ++bj) {
                    const int col = colb + bj * HALF; const u32x4 w = gw[ai][m][bj];
                    const f32x4 g0 = (f32x4){bf_lo(w.x), bf_hi(w.x), bf_lo(w.y), bf_hi(w.y)}, g1 = (f32x4){bf_lo(w.z), bf_hi(w.z), bf_lo(w.w), bf_hi(w.w)};
                    acc[ai][bj][m][0] *= g0; acc[ai][bj][m][1] *= g1;
                    if (u.part != 0) { const f32x4 a0 = acc[ai][bj][m][0], a1 = acc[ai][bj][m][1]; u32x2 w8; w8.x = pk4f8(a0[0], a0[1], a0[2], a0[3]); w8.y = pk4f8(a1[0], a1[1], a1[2], a1[3]); if (F8_G3) *(u32x2*)(out + (size_t)row * 1024 + col) = w8; else store8((bf16_t*)out + (size_t)row * 1024 + col, a0, a1); }
                }
            }
    }
};

struct EpiResid {
    bf16_t* xb; float* ssq; float* outf; float cs; unsigned char* x8;
    __device__ __forceinline__ bool keep(const Unit&) const { return false; }
    __device__ __forceinline__ void operator()(f32x4 (&acc)[2][2][4][2], const Unit& u, int wr, int wc, int fr, int fq) const {
        const int row0 = u.pm * BM + wr * 64 + fr, colb = u.pn * BM + wc * 32 + 8 * fq;
        u32x4 xw[2][4][2];
#pragma unroll
        for (int ai = 0; ai < 2; ++ai)
#pragma unroll
            for (int m = 0; m < 4; ++m)
#pragma unroll
                for (int bj = 0; bj < 2; ++bj) xw[ai][m][bj] = *(const u32x4*)(xb + (size_t)(row0 + ai * HALF + m * 16) * 1024 + colb + bj * HALF);
#pragma unroll
        for (int ai = 0; ai < 2; ++ai)
#pragma unroll
            for (int m = 0; m < 4; ++m) {
                const int row = row0 + ai * HALF + m * 16; float ss = 0.f;
#pragma unroll
                for (int bj = 0; bj < 2; ++bj) {
                    const size_t off = (size_t)row * 1024 + colb + bj * HALF;
                    const u32x4 w = xw[ai][m][bj];
                    const f32x4 x0 = (f32x4){bf_lo(w.x), bf_hi(w.x), bf_lo(w.y), bf_hi(w.y)} + acc[ai][bj][m][0] * cs, x1 = (f32x4){bf_lo(w.z), bf_hi(w.z), bf_lo(w.w), bf_hi(w.w)} + acc[ai][bj][m][1] * cs;
                    if (outf) { __builtin_nontemporal_store(x0, (f32x4*)(outf + off)); __builtin_nontemporal_store(x1, (f32x4*)(outf + off + 4)); }
                    else { store8(xb + off, x0, x1);
                        if (x8) { u32x2 w8; w8.x = pk4f8(x0[0], x0[1], x0[2], x0[3]); w8.y = pk4f8(x1[0], x1[1], x1[2], x1[3]); *(u32x2*)(x8 + off) = w8; }
                        ss += (x0[0] * x0[0] + x0[1] * x0[1]) + (x0[2] * x0[2] + x0[3] * x0[3]) + (x1[0] * x1[0] + x1[1] * x1[1]) + (x1[2] * x1[2] + x1[3] * x1[3]); }
                }
                if (!outf) { ss += __shfl_xor(ss, 16); ss += __shfl_xor(ss, 32);
                    if (fq == 0) ssq[(size_t)row * 16 + 4 * u.pn + wc] = ss; }
            }
    }
};

struct EpiFfnUp {
    const LAS float* rtab; bf16_t* U;
    __device__ __forceinline__ bool keep(const Unit&) const { return false; }
    __device__ __forceinline__ void operator()(f32x4 (&acc)[2][2][4][2], const Unit& u, int wr, int wc, int fr, int fq) const {
        const int row0 = u.pm * BM + wr * 64 + fr, colb = u.pn * BM + wc * 32 + 8 * fq;
#pragma unroll
        for (int ai = 0; ai < 2; ++ai)
#pragma unroll
            for (int m = 0; m < 4; ++m) {
                const int row = row0 + ai * HALF + m * 16;
                const float rs = rtab[ai * HALF + wr * 64 + m * 16 + fr];
#pragma unroll
                for (int bj = 0; bj < 2; ++bj) {
                    f32x4 a, b;
#pragma unroll
                    for (int e = 0; e < 4; ++e) { const float t0 = fmaxf(acc[ai][bj][m][0][e], 0.f) * rs, t1 = fmaxf(acc[ai][bj][m][1][e], 0.f) * rs; a[e] = t0 * t0; b[e] = t1 * t1; }
                    store8(U + (size_t)row * FF + colb + bj * HALF, a, b);
                }
            }
    }
};
}

namespace att {
__device__ __forceinline__ int crow(int r, int hi) { return (r & 3) + 8 * (r >> 2) + 4 * hi; }
__device__ __forceinline__ bf16x8 vtr2(const LAS char* p) {
    const v4i16_t lo = __builtin_amdgcn_ds_read_tr16_b64_v4i16((LAS v4i16_t*)p), hi = __builtin_amdgcn_ds_read_tr16_b64_v4i16((LAS v4i16_t*)(p + 512));
    return (bf16x8){lo[0], lo[1], lo[2], lo[3], hi[0], hi[1], hi[2], hi[3]};
}
__device__ __forceinline__ int kswz(int row, int chunk) { return chunk * 1024 + ((row & ~7) | ((row ^ chunk) & 7)) * 16; }
__device__ __forceinline__ void load_kv(LAS unsigned char* lds, const bf16_t* Kg, const bf16_t* Vg, int pitch, int row0, int tid) {
    const int lane = tid & 63, w = tid >> 6;
#pragma unroll
    for (int t = 0; t < 4; ++t) {
        const int kr = w * 8 + (lane >> 3), kc = lane & 7, gk = row0 + 64 * t + kr;
        u32x4 kv = (u32x4){0u, 0u, 0u, 0u};
        if (gk >= 0) kv = *(const u32x4*)(Kg + (size_t)gk * pitch + kc * 8);
        *(LAS u32x4*)(lds + L_K + t * 8192 + kswz(kr, kc)) = kv;
        const int gv = row0 + 64 * t + 16 * (w & 3) + (lane >> 2);
        u32x4 vv = (u32x4){0u, 0u, 0u, 0u};
        if (gv >= 0) vv = *(const u32x4*)(Vg + (size_t)gv * pitch + (w >> 2) * 32 + (lane & 3) * 8);
        *(LAS u32x4*)(lds + L_V + t * 8192 + w * 1024 + lane * 16) = vv;
    }
}
__device__ __forceinline__ void load_q(bf16x8 (&qr)[4], const bf16_t* qrow, int hi) {
#pragma unroll
    for (int d0 = 0; d0 < 4; ++d0) qr[d0] = *(const bf16x8*)(qrow + d0 * 16 + hi * 8);
}
__device__ __forceinline__ void qkt(f32x16& p0, f32x16& p1, const LAS unsigned char* Kt, const bf16x8 (&qr)[4], int r32, int hi) {
#pragma unroll
    for (int d0 = 0; d0 < 4; ++d0) {
        const LAS unsigned char* kb = Kt + kswz(r32, 2 * d0 + hi);
        const bf16x8 b0 = *(const LAS bf16x8*)(kb);
        const bf16x8 b1 = *(const LAS bf16x8*)(kb + 512);
        p0 = __builtin_amdgcn_mfma_f32_32x32x16_bf16(b0, qr[d0], p0, 0, 0, 0);
        p1 = __builtin_amdgcn_mfma_f32_32x32x16_bf16(b1, qr[d0], p1, 0, 0, 0);
    }
}
struct LutLane { const LAS float* lutp; int amax; };
__device__ __forceinline__ LutLane lut_lane(const LAS float* lut4, int cstride, int nmax, int dlane) {
    const int k = (dlane - 3 + LUTPAD) & 3; LutLane L; L.lutp = lut4 + k * cstride - k; L.amax = ((nmax - 4 - k) & ~3) + k; return L;
}
template <bool LUTB, bool MASKED>
__device__ __forceinline__ void tile(f32x16 (&o)[2], float& lsum, const bf16x8 (&qr)[4], const LAS unsigned char* Kt, const LAS unsigned char* Vt,
                                     float cbias, const LutLane L, int dbase, unsigned dmax, int r32, int hi, int lane, const bool domask = true) {
    f32x16 p0, p1;
    const int db = dbase - 4 * hi;
    if (LUTB) {
#pragma unroll
        for (int gq = 0; gq < 4; ++gq) {
            int a0 = db - 3 - 8 * gq + LUTPAD, a1 = a0 - 32; a0 = a0 < L.amax ? a0 : L.amax; a1 = a1 < L.amax ? a1 : L.amax;
            const f32x4 x0 = *(const LAS f32x4*)(L.lutp + a0), x1 = *(const LAS f32x4*)(L.lutp + a1);
#pragma unroll
            for (int i = 0; i < 4; ++i) { p0[4 * gq + i] = x0[3 - i]; p1[4 * gq + i] = x1[3 - i]; }
        }
    } else {
#pragma unroll
        for (int r = 0; r < 16; ++r) { p0[r] = cbias; p1[r] = cbias; }
    }
    qkt(p0, p1, Kt, qr, r32, hi);
    if (MASKED && domask) {
#pragma unroll
        for (int r = 0; r < 16; ++r) { const int c = (r & 3) + 8 * (r >> 2);
            if ((unsigned)(db - c) > dmax) p0[r] = -INFINITY;
            if ((unsigned)(db - 32 - c) > dmax) p1[r] = -INFINITY; }
    }
    float s = 0.f;
#pragma unroll
    for (int r = 0; r < 16; ++r) { p0[r] = __builtin_amdgcn_exp2f(p0[r]); p1[r] = __builtin_amdgcn_exp2f(p1[r]); s += p0[r] + p1[r]; }
    lsum += s;
    u32x4 pw[4];
#pragma unroll
    for (int k = 0; k < 4; ++k) { pw[0][k] = cvtpk(p0[2 * k], p0[2 * k + 1]); pw[1][k] = cvtpk(p0[8 + 2 * k], p0[9 + 2 * k]); pw[2][k] = cvtpk(p1[2 * k], p1[2 * k + 1]); pw[3][k] = cvtpk(p1[8 + 2 * k], p1[9 + 2 * k]); }
    const LAS char* vp = (const LAS char*)Vt + ((lane >> 4) & 1) * 32 + (lane & 3) * 8 + (4 * hi + ((lane & 15) >> 2)) * 64;
#pragma unroll
    for (int d0 = 0; d0 < 2; ++d0)
#pragma unroll
        for (int ks = 0; ks < 4; ++ks) {
            const bf16x8 vf = vtr2(vp + d0 * 4096 + ks * 1024);
            o[d0] = __builtin_amdgcn_mfma_f32_32x32x16_bf16(__builtin_bit_cast(bf16x8, pw[ks]), vf, o[d0], 0, 0, 0);
        }
}
__device__ __forceinline__ void lut4_put(LAS float* lut4, int cstride, int ix, float v) {
#pragma unroll
    for (int k = 0; k < 4; ++k) if (ix - k >= 0) lut4[k * cstride + ix - k] = v;
}
__device__ __forceinline__ void stage_o(LAS bf16_t* stg, const f32x16 (&o)[2], int r32, int hi) {
#pragma unroll
    for (int r = 0; r < 16; r += 2) { const int orow0 = crow(r, hi), orow1 = crow(r + 1, hi);
#pragma unroll
        for (int d0 = 0; d0 < 2; ++d0) { const unsigned w = cvtpk(o[d0][r], o[d0][r + 1]); stg[orow0 * 64 + d0 * 32 + r32] = (bf16_t)(w & 0xffffu); stg[orow1 * 64 + d0 * 32 + r32] = (bf16_t)(w >> 16); } }
}
__device__ __forceinline__ void unpack8(float (&f)[8], const u32x4 w) { f[0] = bf_lo(w.x); f[1] = bf_hi(w.x); f[2] = bf_lo(w.y); f[3] = bf_hi(w.y); f[4] = bf_lo(w.z); f[5] = bf_hi(w.z); f[6] = bf_lo(w.w); f[7] = bf_hi(w.w); }
__device__ __forceinline__ u32x2 pack8f8(const float (&f)[8]) { u32x2 w; w.x = pk4f8(f[0], f[1], f[2], f[3]); w.y = pk4f8(f[4], f[5], f[6], f[7]); return w; }
__device__ __forceinline__ u32x4 pack8(const float (&f)[8]) { u32x4 w; w.x = cvtpk(f[0], f[1]); w.y = cvtpk(f[2], f[3]); w.z = cvtpk(f[4], f[5]); w.w = cvtpk(f[6], f[7]); return w; }
}

typedef GAS unsigned gu32;
#define RLX_AGENT __ATOMIC_RELAXED, __HIP_MEMORY_SCOPE_AGENT
#define LDS_WAIT() asm volatile("s_waitcnt lgkmcnt(0)" ::: "memory")
#define VM_WAIT() asm volatile("s_waitcnt vmcnt(0)" ::: "memory")
#define XB_TMO      128
#define XB_XCNT(j)  (256  + 64 * (j))
#define XB_XSUB(j)  (1280 + 64 * (j))
#define XB_XGEN(j)  (2304 + 64 * (j))
#define XB_TOP      3328
#define XB_TOPGEN   3392
#define XCD_BAR_WORDS 3456
#define XB_SPIN_CAP (1u << 22)
__device__ __forceinline__ unsigned xb_ld(unsigned* p)              { return __hip_atomic_load(p, __ATOMIC_RELAXED, __HIP_MEMORY_SCOPE_AGENT); }
__device__ __forceinline__ unsigned xb_add(unsigned* p, unsigned v) { return __hip_atomic_fetch_add(p, v, __ATOMIC_RELAXED, __HIP_MEMORY_SCOPE_AGENT); }
__device__ __forceinline__ unsigned xb_xcc_id() { return (unsigned)__builtin_amdgcn_s_getreg((3 << 11) | 20) & 0xFu; }
#define XB_SPIN(cond, bar) do { unsigned _sp = 0; while (cond) { __builtin_amdgcn_s_sleep(1); \
    if ((++_sp & 255u) == 0u) { if (xb_ld(&(bar)[XB_TMO])) break; if (_sp > XB_SPIN_CAP) { atomicAdd(&(bar)[XB_TMO], 1u); break; } } } } while (0)
struct XcdBarrier { unsigned* bar; unsigned x; volatile LAS unsigned* st; };
__device__ __forceinline__ XcdBarrier xcd_barrier_post(unsigned* bar, volatile LAS unsigned* st) {
    XcdBarrier b; b.bar = bar; b.x = xb_xcc_id(); b.st = st;
    if (threadIdx.x == 0) (void)xb_add(&bar[XB_XCNT(b.x)], 1u);
    return b;
}
__device__ __forceinline__ void xcd_barrier_complete(unsigned* bar, unsigned x, unsigned& nloc, unsigned& nx) {
    const unsigned G = gridDim.x * gridDim.y * gridDim.z;
    unsigned sum, cnt, mine, sp = 0u;
    for (;;) {
        sum = 0u; cnt = 0u; mine = 0u;
#pragma unroll
        for (unsigned j = 0; j < 16; ++j) { const unsigned c = xb_ld(&bar[XB_XCNT(j)]); sum += c; cnt += (c > 0u) ? 1u : 0u; mine = (j == x) ? c : mine; }
        if (sum == G) break;
        __builtin_amdgcn_s_sleep(1);
        if ((++sp & 255u) == 0u) { if (xb_ld(&bar[XB_TMO])) break; if (sp > XB_SPIN_CAP) { atomicAdd(&bar[XB_TMO], 1u); break; } }
    }
    nloc = mine > 0u ? mine : 1u; nx = cnt > 0u ? cnt : 1u;
}
__device__ __forceinline__ void xcd_barrier(const XcdBarrier& b) {
    asm volatile("s_waitcnt vmcnt(0)" ::: "memory");
    __syncthreads();
    if (threadIdx.x == 0) {
        unsigned* bar = b.bar;
        __builtin_amdgcn_s_waitcnt(0);
        unsigned nloc = b.st[0], nx = b.st[1];
        if (nloc == 0u) { xcd_barrier_complete(bar, b.x, nloc, nx); b.st[0] = nloc; b.st[1] = nx; }
        const unsigned old = xb_add(&bar[XB_XSUB(b.x)], 1u);
        const unsigned gen = old / nloc;
        if (old + 1u == (gen + 1u) * nloc) {
            __builtin_amdgcn_fence(__ATOMIC_RELEASE, "agent");
            asm volatile("s_waitcnt vmcnt(0)" ::: "memory");
            const unsigned og = xb_add(&bar[XB_TOP], 1u);
            const unsigned tg = og / nx;
            if (og + 1u == (tg + 1u) * nx) xb_add(&bar[XB_TOPGEN], 1u);
            else XB_SPIN(xb_ld(&bar[XB_TOPGEN]) == tg, bar);
            __builtin_amdgcn_fence(__ATOMIC_ACQUIRE, "agent");
            xb_add(&bar[XB_XGEN(b.x)], 1u);
            asm volatile("s_waitcnt vmcnt(0)" ::: "memory");
        } else {
            XB_SPIN(xb_ld(&bar[XB_XGEN(b.x)]) == gen, bar);
            __builtin_amdgcn_fence(__ATOMIC_ACQUIRE, "agent");
            asm volatile("s_waitcnt vmcnt(0)" ::: "memory");
        }
    }
    __syncthreads();
}

__device__ __forceinline__ void rstd_table(LAS float* rtab, const float* ssq, int pm, const float scale) {
    const int tid = threadIdx.x;
    if (tid < 256) { const f32x4* p = (const f32x4*)(ssq + (size_t)(pm * 256 + tid) * 16); const f32x4 a = p[0], b = p[1], c = p[2], d = p[3];
        const float s = ((a[0] + a[1]) + (a[2] + a[3])) + ((b[0] + b[1]) + (b[2] + b[3])) + ((c[0] + c[1]) + (c[2] + c[3])) + ((d[0] + d[1]) + (d[2] + d[3]));
        rtab[tid] = scale / sqrtf(s * (1.0f / 1024.0f) + NORM_EPS); }
    __syncthreads();
}
__device__ __forceinline__ void proj_consts(LAS float* tab, const float* qna, const float* kna, const float* qnb, const float* knb, const float* bgate) {
    const int tid = threadIdx.x;
    if (tid < 256) { const int k = tid >> 6, i = tid & 63; tab[256 + tid] = (k == 0) ? qna[i] * C2 : (k == 1) ? kna[i] : (k == 2) ? qnb[i] * C2 : knb[i]; }
#pragma unroll
    for (int i = 0; i < 4; ++i) tab[512 + tid + 512 * i] = bgate[tid + 512 * i];
}
struct Args { const float* in[16]; float* out; unsigned char* ws; int ph_lo, ph_hi; };
struct Frame {
    LAS unsigned char* lds;
    int tid, lane, wave, G, vcu;
    unsigned char* ws; float* out;
};

__device__ __forceinline__ float wave_sum(float v) {
#pragma unroll
    for (int o = 1; o < 64; o <<= 1) v += __shfl_xor(v, o);
    return v;
}
__device__ __forceinline__ int rel_bucket(int d) {
    if (d < 16) return d < 0 ? 0 : d;
    int b = 16;
    b += (d >= 22); b += (d >= 30); b += (d >= 40); b += (d >= 54); b += (d >= 73); b += (d >= 99); b += (d >= 134); b += (d >= 182);
    b += (d >= 246); b += (d >= 332); b += (d >= 450); b += (d >= 609); b += (d >= 825); b += (d >= 1117); b += (d >= 1513);
    return b;
}

struct PItem { int type; const float* src; int N; const float* gs; unsigned char* dst; int f8, ldk, kcol, drowA, drowB, m0; };
__device__ __forceinline__ int win_drow(int n0) {
    if (n0 >= 2304) { const int gg = n0 - 2304, isb = gg >= 1024 ? 1 : 0, G0 = gg - 1024 * isb; return (9 + (G0 >> 7)) * 256 + 128 * isb + 32 * ((G0 & 127) >> 5); }
    const int cc = n0 & 255; return (n0 & ~255) + 128 * ((cc >> 5) & 1) + 32 * (cc >> 6);
}
constexpr int PT_LAYER = 16 * 68 + 2 * 8 * 16 + 16 * 16 + 16 * 64 + 64 * 16;
constexpr int PT_X = M / 4;
__device__ __forceinline__ PItem pro_decode(int it, const Args& a, unsigned char* ws, unsigned char* outb) {
    PItem p; p.gs = nullptr; p.m0 = 0; p.ldk = D; p.drowA = 0; p.drowB = 0; p.kcol = 0; p.N = D; p.dst = nullptr; p.src = nullptr; p.f8 = 0;
    if (it >= NLAYER * PT_LAYER) { p.type = 1; p.m0 = (it - NLAYER * PT_LAYER) * 4; p.src = a.in[0] + (size_t)p.m0 * D; return p; }
    p.type = 0;
    const int l = it / PT_LAYER; int r = it - l * PT_LAYER;
    unsigned char* wb = (l == 0) ? outb + DO_W : ws + WS_W;
    if (r < 16 * 68) { const int kb = r / 68, n0 = (r % 68) * 64, k0 = kb * 64; p.src = a.in[3] + (size_t)l * D * INW + (size_t)k0 * INW + n0; p.N = INW; p.gs = a.in[2] + (size_t)l * D + k0;
        p.dst = wb + OFF_WIN; p.f8 = F8_G1; p.kcol = k0; p.drowA = win_drow(n0); p.drowB = win_drow(n0 + 32); return p; } r -= 16 * 68;
    if (r < 128) { const int kb = r / 16, n0 = (r % 16) * 64, k0 = kb * 64; p.src = a.in[10] + (size_t)l * 512 * D + (size_t)k0 * D + n0; p.dst = wb + OFF_WBR; p.f8 = F8_G2; p.kcol = k0; p.drowA = n0; p.drowB = n0 + 32; return p; } r -= 128;
    if (r < 128) { const int kb = r / 16, n0 = (r % 16) * 64, k0 = kb * 64; p.src = a.in[11] + (size_t)l * 512 * D + (size_t)k0 * D + n0; p.dst = wb + OFF_WBR; p.f8 = F8_G2; p.kcol = 512 + k0; p.drowA = n0; p.drowB = n0 + 32; return p; } r -= 128;
    if (r < 256) { const int kb = r / 16, n0 = (r % 16) * 64, k0 = kb * 64; p.src = a.in[12] + (size_t)l * D * D + (size_t)k0 * D + n0; p.dst = wb + OFF_WOUT; p.f8 = F8_G3; p.kcol = k0; p.drowA = n0; p.drowB = n0 + 32; return p; } r -= 256;
    if (r < 1024) { const int kb = r / 64, n0 = (r % 64) * 64, k0 = kb * 64; p.src = a.in[14] + (size_t)l * D * FF + (size_t)k0 * FF + n0; p.N = FF; p.gs = a.in[13] + (size_t)l * D + k0;
        p.dst = wb + OFF_W1; p.kcol = k0; p.drowA = n0; p.drowB = n0 + 32; return p; } r -= 1024;
    { const int kb = r / 16, n0 = (r % 16) * 64, k0 = kb * 64; p.src = a.in[15] + (size_t)l * FF * D + (size_t)k0 * D + n0; p.dst = wb + OFF_W2; p.ldk = FF; p.kcol = k0; p.drowA = n0; p.drowB = n0 + 32; }
    return p;
}
__device__ __forceinline__ void pro_load(f32x4 (&v)[16], const PItem& p, int lane) {
    if (p.type == 0) { const float* s = p.src + (size_t)(lane >> 4) * p.N + (lane & 15) * 4;
#pragma unroll
        for (int i = 0; i < 16; ++i) v[i] = __builtin_nontemporal_load((const f32x4*)(s + (size_t)(4 * i) * p.N));
    } else { const float* s = p.src + lane * 4;
#pragma unroll
        for (int i = 0; i < 16; ++i) v[i] = __builtin_nontemporal_load((const f32x4*)(s + (i >> 2) * D + (i & 3) * 256));
    }
}
__device__ __forceinline__ void pro_process(const f32x4 (&v)[16], const PItem& p, LAS float* scr, int lane, unsigned char* ws, unsigned char* x8) {
    if (p.type == 0) {
        const int c = lane & 7, nl = lane >> 3;
        f32x4 g0 = (f32x4){1.f, 1.f, 1.f, 1.f}, g1 = g0;
        if (p.gs) { g0 = *(const f32x4*)(p.gs + 8 * c); g1 = *(const f32x4*)(p.gs + 8 * c + 4); }
        if (p.f8) { g0 = g0 * F8_SW; g1 = g1 * F8_SW; }
#pragma unroll
        for (int i = 0; i < 16; ++i) { LAS float* w = scr + (4 * i + (lane >> 4)) * 65 + (lane & 15) * 4; w[0] = v[i][0]; w[1] = v[i][1]; w[2] = v[i][2]; w[3] = v[i][3]; }
        LDS_WAIT(); asm volatile("" ::: "memory");
#pragma unroll
        for (int j = 0; j < 8; ++j) { const int n = nl + 8 * j; const LAS float* s = scr + (8 * c) * 65 + n;
            const float t0 = s[0 * 65] * g0[0], t1 = s[1 * 65] * g0[1], t2 = s[2 * 65] * g0[2], t3 = s[3 * 65] * g0[3], t4 = s[4 * 65] * g1[0], t5 = s[5 * 65] * g1[1], t6 = s[6 * 65] * g1[2], t7 = s[7 * 65] * g1[3];
            const int drow = (j < 4) ? p.drowA + n : p.drowB + n - 32;
            const size_t eo = (size_t)drow * p.ldk + p.kcol + 8 * c;
            if (p.f8) { u32x2 o; o.x = pk4f8(t0, t1, t2, t3); o.y = pk4f8(t4, t5, t6, t7); *(u32x2*)(p.dst + eo) = o; }
            else { u32x4 o; o.x = cvtpk(t0, t1); o.y = cvtpk(t2, t3); o.z = cvtpk(t4, t5); o.w = cvtpk(t6, t7); *(u32x4*)(p.dst + eo * 2) = o; } }
        LDS_WAIT(); asm volatile("" ::: "memory");
    } else {
        bf16_t* xb = (bf16_t*)(ws + WS_XB); float* ssq = (float*)(ws + WS_SSQ);
#pragma unroll
        for (int r = 0; r < 4; ++r) { float s = 0.f;
#pragma unroll
            for (int q = 0; q < 4; ++q) { const f32x4 x = v[4 * r + q]; s += (x[0] * x[0] + x[1] * x[1]) + (x[2] * x[2] + x[3] * x[3]); }
            s = wave_sum(s);
            u32x2* o8 = (u32x2*)(xb + (size_t)(p.m0 + r) * D) + lane;
#pragma unroll
            for (int q = 0; q < 4; ++q) { const f32x4 x = v[4 * r + q]; u32x2 w; w.x = cvtpk(x[0], x[1]); w.y = cvtpk(x[2], x[3]); o8[64 * q] = w;
                if (F8_G1) ((unsigned*)(x8 + (size_t)(p.m0 + r) * D))[lane + 64 * q] = pk4f8(x[0], x[1], x[2], x[3]); }
            if (lane < 16) ssq[(size_t)(p.m0 + r) * 16 + lane] = (lane == 0) ? s : 0.f; }
    }
}
__device__ __forceinline__ void phase_prologue(Frame& F, const Args& a) {
    LAS float* scr = (LAS float*)(F.lds + F.wave * 16640);
    const int gw = F.vcu * 8 + F.wave, NGW = F.G * 8;
    unsigned char* ws = F.ws; unsigned char* outb = (unsigned char*)F.out;
    {
        if (gw == 0) { unsigned* cur = (unsigned*)(ws + WS_CUR); for (int i = F.lane; i < NLAYER * 512; i += 64) cur[i] = 0u; }
        const float* rel_bias = a.in[1]; float* lut = (float*)(ws + WS_LUT);
        for (int i = gw * 64 + F.lane; i < 16 * LUTN; i += NGW * 64) { const int hh = i / LUTN, k = i % LUTN, d = k - LUTPAD;
            lut[i] = (d < 0) ? 0.f : rel_bias[rel_bucket(d) * 16 + hh] * LOG2E; }
    }
    constexpr int NTOT = NLAYER * PT_LAYER + PT_X;
    f32x4 va[16], vb[16]; PItem pa, pb;
    int it = gw;
    if (it < NTOT) { pa = pro_decode(it, a, ws, outb); pro_load(va, pa, F.lane); }
    while (it < NTOT) {
        const int i1 = it + NGW; if (i1 < NTOT) { pb = pro_decode(i1, a, ws, outb); pro_load(vb, pb, F.lane); }
        pro_process(va, pa, scr, F.lane, ws, ws + WS_X8);
        if (i1 >= NTOT) break;
        const int i2 = i1 + NGW; if (i2 < NTOT) { pa = pro_decode(i2, a, ws, outb); pro_load(va, pa, F.lane); }
        pro_process(vb, pb, scr, F.lane, ws, ws + WS_X8);
        it = i2;
    }
}

__device__ __forceinline__ void phase_swa_select(Frame& F, const Args& a, int l) {
    using namespace att;
    const bool tailwg = (F.G == 256) && (blockIdx.x < 64);
    if (F.G == 256) {
        unsigned char* ws_ = F.ws; unsigned char* wb_ = (l == 0) ? (unsigned char*)F.out + DO_W : ws_ + WS_W;
        pg8::Gemm g{F8_G1 ? ws_ + WS_X8 : ws_ + WS_XB, wb_ + OFF_WIN, F8_G1 ? D : 2 * D, F8_G1 ? D : 2 * D, F8_G1 ? D : 2 * D, 0}; pg8::StaticOrder S; S.init_single((int)blockIdx.x, 16, tailwg);
        if (tailwg) { proj_consts((LAS float*)(F.lds + L_RSTD), a.in[5] + l * 64, a.in[6] + l * 64, a.in[7] + l * 64, a.in[8] + l * 64, a.in[4] + l * 2048); rstd_table((LAS float*)(F.lds + L_RSTD), (const float*)(ws_ + WS_SSQ), (int)blockIdx.x, F8_G1 ? 1.0f / F8_SW : 1.0f); }
        pg8::EpiProj E{(const LAS float*)(F.lds + L_RSTD), (bf16_t*)(ws_ + WS_QA), (bf16_t*)(ws_ + WS_KA), (bf16_t*)(ws_ + WS_VA), (bf16_t*)(ws_ + WS_QB), (bf16_t*)(ws_ + WS_KB), (bf16_t*)(ws_ + WS_VB), (bf16_t*)(ws_ + WS_GT), (float*)(ws_ + WS_KMP)};
        if (tailwg) pg8::gemm_phase<F8_G1 != 0, pg8::EpiProj>(F.lds, g, S, E);
    }
    unsigned char* ws = F.ws; LAS unsigned char* lds = F.lds;
    const int tid = F.tid, lane = F.lane, wave = F.wave, r32 = lane & 31, hi = lane >> 5;
    const bf16_t* Qb = (const bf16_t*)(ws + WS_QB); const bf16_t* Kb = (const bf16_t*)(ws + WS_KB); const bf16_t* Vb = (const bf16_t*)(ws + WS_VB);
    unsigned char* Y = (unsigned char*)F.out + DO_Y;
    const float* lutg = (const float*)(ws + WS_LUT); const float* sinks = a.in[9] + l * 8;
    LAS float* lut = (LAS float*)(lds + L_LUT); LAS float* wsf = (LAS float*)(lds + L_WSF) + wave * 64; LAS bf16_t* stg = (LAS bf16_t*)(lds + L_OST) + wave * 2048;
    const int bxi = (int)blockIdx.x; const bool swa_split = (F.G == 256);
    for (int ui = 0; ui < 2; ++ui) {
        int unit, gi_lo = 0, gi_hi = 16;
        if (swa_split) { if (tailwg) break;
            if (ui == 0) unit = bxi;
            else if (bxi < 128) { unit = bxi - 64; gi_hi = 8; }
            else if (bxi < 192) { unit = bxi - 128; gi_lo = 8; }
            else break; }
        else { if (ui == 1) break; unit = F.vcu; if (unit >= 256) break; }
        const int kvh = unit >> 7, c = unit & 127;
        bf16x8 qsw[2][4];
#pragma unroll
        for (int k2 = 0; k2 < 2; ++k2) { const int gi_ = gi_lo + wave + 8 * k2; const int gg_ = gi_ < gi_hi ? gi_ : gi_lo + wave;
            load_q(qsw[k2], Qb + (size_t)(128 * c + 32 * (gg_ & 3) + r32) * 512 + (kvh * 4 + (gg_ >> 2)) * 64, hi); }
        __syncthreads();
        load_kv(lds, Kb + kvh * 64, Vb + kvh * 64, 128, 128 * c - 128, tid);
        for (int i = tid; i < 4 * 512; i += 512) lut4_put(lut + (i >> 9) * 2048, 512, i & 511, lutg[(size_t)(8 + kvh * 4 + (i >> 9)) * LUTN + (i & 511)]);
        __syncthreads();
        for (int gi = gi_lo + wave; gi < gi_hi; gi += 8) {
            const int hl = gi >> 2, g = gi & 3, hq = kvh * 4 + hl, q = 128 * c + 32 * g + r32;
            bf16x8 qr[4];
#pragma unroll
            for (int d0 = 0; d0 < 4; ++d0) qr[d0] = (gi - gi_lo - wave) ? qsw[1][d0] : qsw[0][d0];
            f32x16 o[2];
#pragma unroll
            for (int r = 0; r < 16; ++r) { o[0][r] = 0.f; o[1][r] = 0.f; }
            float lsum = 0.f; const unsigned dmax = (unsigned)(q < 127 ? q : 127);
            const int t0 = g < 2 ? 0 : 1; const LutLane LL = lut_lane(lut + hl * 2048, 512, 512, r32 - 4 * hi);
            for (int t = t0; t < t0 + 3; ++t)
                tile<true, true>(o, lsum, qr, lds + L_K + t * 8192, lds + L_V + t * 8192, 0.f, LL, 32 * g + r32 + 128 - 64 * t, dmax, r32, hi, lane, t != t0 + 1 || c == 0);
            lsum += __shfl_xor(lsum, 32);
            lsum += __builtin_amdgcn_exp2f(sinks[hq] * LOG2E);
            if (hi == 0) wsf[r32] = lsum;
            stage_o(stg, o, r32, hi);
            LDS_WAIT(); asm volatile("" ::: "memory");
#pragma unroll
            for (int i = 0; i < 4; ++i) { const int row = i * 8 + (lane >> 3), ch = lane & 7;
                const u32x4 v = *(const LAS u32x4*)(stg + row * 64 + ch * 8); float f[8]; unpack8(f, v);
                const float inv = F8_SY / wsf[row];
#pragma unroll
                for (int e = 0; e < 8; ++e) f[e] *= inv;
                const size_t yo = (size_t)(128 * c + 32 * g + row) * 1024 + 512 + hq * 64 + ch * 8;
                if (F8_G2) *(u32x2*)(Y + yo) = pack8f8(f); else *(u32x4*)(Y + 2 * yo) = pack8(f); }
            LDS_WAIT(); asm volatile("" ::: "memory");
        }
    }
    const bf16_t* Qa = (const bf16_t*)(ws + WS_QA); const float* kmp = (const float*)(ws + WS_KMP);
    unsigned* cursor = (unsigned*)(ws + WS_CUR) + l * 512; unsigned short* lists = (unsigned short*)(ws + WS_LISTS);
    LAS unsigned* hist = (LAS unsigned*)(lds + L_SM); LAS unsigned* lbase = hist + 64;
    int sel0, selstep, selend;
    if (F.G == 256) { const int bx_ = (int)blockIdx.x;
        if (bx_ < 64) { sel0 = bx_; selstep = 512; selend = 64; }
        else if (bx_ < 192) { sel0 = bx_; selstep = 128; selend = 320; }
        else { sel0 = 320 + (bx_ - 192); selstep = 64; selend = 512; } }
    else { sel0 = F.vcu; selstep = F.G; selend = 512; }
    f32x4 kmr[4]; bf16x8 qsel[4];
#define SEL_FETCH(unit_) do { const int h_ = (unit_) >> 6, qb_ = (unit_) & 63; const float* p_ = kmp + ((size_t)(h_ * 64 + (tid >> 3)) * 2) * 64 + (tid & 7) * 8; \
        kmr[0] = *(const f32x4*)(p_); kmr[1] = *(const f32x4*)(p_ + 4); kmr[2] = *(const f32x4*)(p_ + 64); kmr[3] = *(const f32x4*)(p_ + 68); \
        load_q(qsel, Qa + (size_t)(qb_ * 256 + 32 * wave + r32) * 512 + h_ * 64, hi); } while (0)
    if (sel0 < selend) SEL_FETCH(sel0);
    for (int unit = sel0; unit < selend; unit += selstep) {
        const int h = unit >> 6, qb = unit & 63;
        __syncthreads();
        { const int j = tid >> 3, cch = tid & 7;
          float hi8[8], lo8[8];
#pragma unroll
          for (int e = 0; e < 8; ++e) { const float km = (kmr[e >> 2][e & 3] + kmr[2 + (e >> 2)][e & 3]) * (1.0f / 256.0f); const unsigned hb = f2bf(km); const float hf = __builtin_bit_cast(float, hb << 16); hi8[e] = hf; lo8[e] = km - hf; }
          *(LAS u32x4*)(lds + L_K + kswz(j, cch)) = pack8(hi8); *(LAS u32x4*)(lds + L_K + 8192 + kswz(j, cch)) = pack8(lo8); }
        if (tid < 64) hist[tid] = 0u;
        __syncthreads();
        const int q = qb * 256 + 32 * wave + r32;
        int i1 = 255, i2 = 255, i3 = 255;
        {
            bf16x8 qr[4];
#pragma unroll
            for (int d0 = 0; d0 < 4; ++d0) qr[d0] = qsel[d0];
            if (unit + selstep < selend) SEL_FETCH(unit + selstep);
            f32x16 p0, p1;
#pragma unroll
            for (int r = 0; r < 16; ++r) { p0[r] = 0.f; p1[r] = 0.f; }
            qkt(p0, p1, lds + L_K, qr, r32, hi); qkt(p0, p1, lds + L_K + 8192, qr, r32, hi);
            float v1 = -INFINITY, v2 = -INFINITY, v3 = -INFINITY;
#define TOP_INS(v_, i_) do { const float vv = (v_); const int ii = (i_); if (vv > v3) { if (vv > v2) { v3 = v2; i3 = i2; if (vv > v1) { v2 = v1; i2 = i1; v1 = vv; i1 = ii; } else { v2 = vv; i2 = ii; } } else { v3 = vv; i3 = ii; } } } while (0)
#pragma unroll
            for (int r = 0; r < 16; ++r) { const int j0 = crow(r, hi), j1 = 32 + j0;
                TOP_INS(j0 < qb ? p0[r] : -INFINITY, j0); TOP_INS(j1 < qb ? p1[r] : -INFINITY, j1); }
            const float w1 = __shfl_xor(v1, 32), w2 = __shfl_xor(v2, 32), w3 = __shfl_xor(v3, 32);
            const int k1 = __shfl_xor(i1, 32), k2 = __shfl_xor(i2, 32), k3 = __shfl_xor(i3, 32);
            TOP_INS(w1, k1); TOP_INS(w2, k2); TOP_INS(w3, k3);
#undef TOP_INS
            if (hi == 0) {
                if (i1 < 64) __hip_atomic_fetch_add(hist + i1, 1u, __ATOMIC_RELAXED, __HIP_MEMORY_SCOPE_WORKGROUP);
                if (i2 < 64) __hip_atomic_fetch_add(hist + i2, 1u, __ATOMIC_RELAXED, __HIP_MEMORY_SCOPE_WORKGROUP);
                if (i3 < 64) __hip_atomic_fetch_add(hist + i3, 1u, __ATOMIC_RELAXED, __HIP_MEMORY_SCOPE_WORKGROUP);
            }
        }
        __syncthreads();
        if (tid < 64) { const unsigned c = hist[tid]; unsigned bs = 0u; if (c) bs = __hip_atomic_fetch_add(cursor + h * 64 + tid, c, __ATOMIC_RELAXED, __HIP_MEMORY_SCOPE_AGENT); lbase[tid] = bs; hist[tid] = 0u; }
        __syncthreads();
        if (hi == 0) {
            const int pick[3] = {i1, i2, i3};
#pragma unroll
            for (int s = 0; s < 3; ++s) { const int j = pick[s];
                if (j < 64) { const unsigned rk = __hip_atomic_fetch_add(hist + j, 1u, __ATOMIC_RELAXED, __HIP_MEMORY_SCOPE_WORKGROUP);
                    lists[(size_t)h * LIST_HEAD + 256 * (63 * j - (j * (j - 1)) / 2) + lbase[j] + rk] = (unsigned short)(q | (s << 14)); } }
        }
    }
#undef SEL_FETCH
}

__device__ __forceinline__ void phase_moba_past(Frame& F, const Args& a, int l) {
    using namespace att;
    constexpr int PCH = 512;
    unsigned char* ws = F.ws; LAS unsigned char* lds = F.lds;
    const int tid = F.tid, lane = F.lane, wave = F.wave, r32 = lane & 31, hi = lane >> 5;
    const bf16_t* Qa = (const bf16_t*)(ws + WS_QA); const bf16_t* Ka = (const bf16_t*)(ws + WS_KA); const bf16_t* Va = (const bf16_t*)(ws + WS_VA);
    const unsigned* cursor = (const unsigned*)(ws + WS_CUR) + l * 512; const unsigned short* lists = (const unsigned short*)(ws + WS_LISTS);
    bf16_t* Po = (bf16_t*)(ws + WS_PO); float* Pl = (float*)(ws + WS_PL);
    const float* lutg = (const float*)(ws + WS_LUT);
    LAS float* lut = (LAS float*)(lds + L_LUT); LAS bf16_t* stg = (LAS bf16_t*)(lds + L_OST) + wave * 2048;
    LAS unsigned* pfx = (LAS unsigned*)(lds + L_TAB); LAS unsigned* nls = pfx + 512; LAS unsigned* pfs = pfx + 1024;
    LAS unsigned* scan = (LAS unsigned*)(lds + L_SM);
    __syncthreads();
    const int nlist = (int)cursor[tid];
    const int nrem = nlist % PCH, nbig = nlist / PCH + (nrem > PCH / 2 ? 1 : 0), nsml = (nrem > 0 && nrem <= PCH / 2) ? 1 : 0;
    int inc = nbig | (nsml << 16);
#pragma unroll
    for (int o = 1; o < 64; o <<= 1) { const int v = __shfl_up(inc, o); if (lane >= o) inc += v; }
    if (lane == 63) scan[wave] = (unsigned)inc;
    __syncthreads();
    { int base = 0; for (int w = 0; w < wave; ++w) base += (int)scan[w]; const int tot_ = base + inc; pfx[tid] = (unsigned)(tot_ & 0xffff); pfs[tid] = (unsigned)(tot_ >> 16); nls[tid] = (unsigned)nlist; }
    int totb = 0; for (int w = 0; w < 8; ++w) totb += (int)scan[w];
    totb = __builtin_amdgcn_readfirstlane(totb);
    const int nbigtot = totb & 0xffff; const int total = nbigtot + (totb >> 16);
    __syncthreads();
    u32x4 kreg[4], vreg[4]; float lreg[5];
    const int lw = tid >> 6, kr = lw * 8 + (lane >> 3), kc8 = lane & 7;
#define PAST_FETCH(h_, j_) do { \
        const bf16_t* Kg_ = Ka + (h_) * 64 + (size_t)((j_) * 256) * 512; const bf16_t* Vg_ = Va + (h_) * 64 + (size_t)((j_) * 256) * 512; \
        _Pragma("unroll") for (int t = 0; t < 4; ++t) { kreg[t] = *(const u32x4*)(Kg_ + (size_t)(64 * t + kr) * 512 + kc8 * 8); \
            vreg[t] = *(const u32x4*)(Vg_ + (size_t)(64 * t + 16 * (lw & 3) + (lane >> 2)) * 512 + (lw >> 2) * 32 + (lane & 3) * 8); } \
        _Pragma("unroll") for (int i = 0; i < 5; ++i) { const int ix = tid + 512 * i; lreg[i] = lutg[(size_t)(h_) * LUTN + (ix < LUTN ? ix : LUTN - 1)]; } } while (0)
#define PAST_DEC(it_, h_, j_, k_, n_) int h_, j_, k_, n_; { const bool big_ = (it_) < nbigtot; const int iq_ = big_ ? (it_) : (it_) - nbigtot; const LAS unsigned* px_ = big_ ? pfx : pfs; \
        int lo_ = 0, hi_ = 511; while (lo_ < hi_) { const int mid_ = (lo_ + hi_) >> 1; if ((int)px_[mid_] > iq_) hi_ = mid_; else lo_ = mid_ + 1; } \
        h_ = lo_ >> 6; j_ = lo_ & 63; k_ = big_ ? iq_ - (lo_ ? (int)pfx[lo_ - 1] : 0) : (int)nls[lo_] / PCH; n_ = (int)nls[lo_] - PCH * k_; n_ = n_ > PCH ? PCH : n_; \
        h_ = __builtin_amdgcn_readfirstlane(h_); j_ = __builtin_amdgcn_readfirstlane(j_); k_ = __builtin_amdgcn_readfirstlane(k_); n_ = __builtin_amdgcn_readfirstlane(n_); }
#define PAST_LP(h_, j_, k_) (lists + (size_t)(h_) * LIST_HEAD + 256 * (63 * (j_) - ((j_) * ((j_) - 1)) / 2) + (k_) * PCH)
#define WG_BAR() asm volatile("s_waitcnt lgkmcnt(0)\n\ts_barrier" ::: "memory")
    int it = F.vcu;
    unsigned ec0 = 0u, ec1 = 0u; bf16x8 qr_c[4]; int hprev = -1;
#pragma unroll
    for (int d0 = 0; d0 < 4; ++d0) qr_c[d0] = (bf16x8){0, 0, 0, 0, 0, 0, 0, 0};
    int h = 0, j = 0, kc = 0, n = 0;
    if (it < total) { PAST_DEC(it, h0, j0, k0, n0); h = h0; j = j0; kc = k0; n = n0; const int idx0 = wave * 32 + r32; const unsigned short* lp0 = PAST_LP(h0, j0, k0);
        ec0 = lp0[idx0 < n0 ? idx0 : 0]; ec1 = lp0[idx0 + 256 < n0 ? idx0 + 256 : 0]; PAST_FETCH(h0, j0); load_q(qr_c, Qa + (size_t)(ec0 & 0x3fffu) * 512 + h0 * 64, hi); }
    for (; it < total; it += F.G) {
        WG_BAR();
#pragma unroll
        for (int t = 0; t < 4; ++t) { *(LAS u32x4*)(lds + L_K + t * 8192 + kswz(kr, kc8)) = kreg[t]; *(LAS u32x4*)(lds + L_V + t * 8192 + lw * 1024 + lane * 16) = vreg[t]; }
        if (h != hprev) {
#pragma unroll
            for (int i = 0; i < 5; ++i) { const int ix = tid + 512 * i; if (ix < LUTN) lut4_put(lut, LUTN, ix, lreg[i]); }
            hprev = h; }
        WG_BAR();
        const bool hn = it + F.G < total; unsigned en0 = 0u, en1 = 0u; int hnx = 0, jnx = 0, knx = 0, nnx = 0;
        if (hn) { PAST_DEC(it + F.G, h1, j1, k1, n1); const int idx1 = wave * 32 + r32; hnx = h1; jnx = j1; knx = k1; nnx = n1; const unsigned short* lp1 = PAST_LP(h1, j1, k1);
            en0 = lp1[idx1 < n1 ? idx1 : 0]; en1 = lp1[idx1 + 256 < n1 ? idx1 + 256 : 0]; PAST_FETCH(h1, j1); }
        const float cbias = lut[LUTN - 1];
        const bool act1 = (wave + 8) * 32 < n;
#pragma unroll 1
        for (int gi = 0; gi < 2; ++gi) {
            const int g = wave + 8 * gi;
            const bool nx_same = (gi == 0) && act1; const bool nx_any = nx_same || hn;
            const unsigned nx_ent = nx_same ? ec1 : en0; const int nx_h = nx_same ? h : hnx;
            const bf16_t* nx_q = Qa + (size_t)(nx_ent & 0x3fffu) * 512 + nx_h * 64;
            if (g * 32 < n) {
                const unsigned ent_c = gi ? ec1 : ec0;
                const int idx = g * 32 + r32; const bool valid = idx < n;
                const int q = (int)(ent_c & 0x3fffu), s = (int)(ent_c >> 14);
                f32x16 o[2];
#pragma unroll
                for (int r = 0; r < 16; ++r) { o[0][r] = 0.f; o[1][r] = 0.f; }
                float lsum = 0.f;
                const int dfirst = q - j * 256;
                const LutLane LL = lut_lane(lut, LUTN, LUTN, dfirst - 4 * hi);
                bf16x8 qr_n[4];
#pragma unroll
                for (int d0 = 0; d0 < 4; ++d0) qr_n[d0] = qr_c[d0];
                if (__all(dfirst - 255 >= 1513)) {
#pragma unroll 1
                    for (int t = 0; t < 4; ++t) { tile<false, false>(o, lsum, qr_c, lds + L_K + t * 8192, lds + L_V + t * 8192, cbias, LL, dfirst - 64 * t, 0u, r32, hi, lane);
                        if (t == 1 && nx_any) load_q(qr_n, nx_q, hi); }
                } else {
#pragma unroll 1
                    for (int t = 0; t < 4; ++t) { tile<true, false>(o, lsum, qr_c, lds + L_K + t * 8192, lds + L_V + t * 8192, 0.f, LL, dfirst - 64 * t, 0u, r32, hi, lane);
                        if (t == 1 && nx_any) load_q(qr_n, nx_q, hi); }
                }
                lsum += __shfl_xor(lsum, 32);
                if (hi == 0 && valid) Pl[(size_t)(s * 8 + h) * M + q] = lsum;
                stage_o(stg, o, r32, hi);
                LDS_WAIT(); asm volatile("" ::: "memory");
#pragma unroll
                for (int i = 0; i < 4; ++i) { const int row = i * 8 + (lane >> 3), ch = lane & 7;
                    const u32x4 v = *(const LAS u32x4*)(stg + row * 64 + ch * 8);
                    const unsigned en = (unsigned)__shfl((int)ent_c, row);
                    if (g * 32 + row < n) { const int qq = (int)(en & 0x3fffu), ss = (int)(en >> 14);
                        *(u32x4*)(Po + ((size_t)(ss * 8 + h) * M + qq) * 64 + ch * 8) = v; } }
                LDS_WAIT(); asm volatile("" ::: "memory");
#pragma unroll
                for (int d0 = 0; d0 < 4; ++d0) qr_c[d0] = qr_n[d0];
            } else if (gi == 0 && nx_any) load_q(qr_c, nx_q, hi);
        }
        ec0 = en0; ec1 = en1; h = hnx; j = jnx; kc = knx; n = nnx;
    }
#undef WG_BAR
#undef PAST_FETCH
#undef PAST_DEC
#undef PAST_LP
}

__device__ __forceinline__ void phase_moba_own(Frame& F, const Args& a, int l) {
    using namespace att;
    unsigned char* ws = F.ws; LAS unsigned char* lds = F.lds;
    const int tid = F.tid, lane = F.lane, wave = F.wave, r32 = lane & 31, hi = lane >> 5;
    const bf16_t* Qa = (const bf16_t*)(ws + WS_QA); const bf16_t* Ka = (const bf16_t*)(ws + WS_KA); const bf16_t* Va = (const bf16_t*)(ws + WS_VA);
    const bf16_t* Po = (const bf16_t*)(ws + WS_PO); const float* Pl = (const float*)(ws + WS_PL);
    unsigned char* Y = (unsigned char*)F.out + DO_Y;
    const float* lutg = (const float*)(ws + WS_LUT);
    LAS float* lut = (LAS float*)(lds + L_LUT); LAS float* wsf = (LAS float*)(lds + L_WSF) + wave * 64; LAS bf16_t* stg = (LAS bf16_t*)(lds + L_OST) + wave * 2048;
#define WG_BAR() asm volatile("s_waitcnt lgkmcnt(0)\n\ts_barrier" ::: "memory")
    u32x4 kreg[4], vreg[4]; float lreg;
    const int lw = tid >> 6, kr = lw * 8 + (lane >> 3), kc8 = lane & 7;
#define OWN_FETCH(unit_) do { const int h_ = (unit_) >> 6, qb_ = (unit_) & 63; \
        const bf16_t* Kg_ = Ka + h_ * 64 + (size_t)(qb_ * 256) * 512; const bf16_t* Vg_ = Va + h_ * 64 + (size_t)(qb_ * 256) * 512; \
        _Pragma("unroll") for (int t = 0; t < 4; ++t) { kreg[t] = *(const u32x4*)(Kg_ + (size_t)(64 * t + kr) * 512 + kc8 * 8); \
            vreg[t] = *(const u32x4*)(Vg_ + (size_t)(64 * t + 16 * (lw & 3) + (lane >> 2)) * 512 + (lw >> 2) * 32 + (lane & 3) * 8); } \
        lreg = lutg[(size_t)h_ * LUTN + tid]; } while (0)
    int unit = F.vcu;
    if (unit < 512) OWN_FETCH(unit);
    for (; unit < 512; unit += F.G) {
        const int h = unit >> 6, qb = unit & 63, nsl = qb < 3 ? qb : 3;
        const int q = qb * 256 + 32 * wave + r32;
        bf16x8 qr[4]; load_q(qr, Qa + (size_t)q * 512 + h * 64, hi);
        u32x4 pov[4][3]; float plv[4][3];
#pragma unroll
        for (int i = 0; i < 4; ++i) { const int row = i * 8 + (lane >> 3), ch = lane & 7, qq = qb * 256 + 32 * wave + row;
#pragma unroll
            for (int s = 0; s < 3; ++s) { const size_t pi = (size_t)(s * 8 + h) * M + qq;
                if (s < nsl) { plv[i][s] = Pl[pi]; pov[i][s] = __builtin_nontemporal_load((const u32x4*)(Po + pi * 64 + ch * 8)); } else { plv[i][s] = 0.f; pov[i][s] = (u32x4){0u, 0u, 0u, 0u}; } } }
        WG_BAR();
#pragma unroll
        for (int t = 0; t < 4; ++t) { *(LAS u32x4*)(lds + L_K + t * 8192 + kswz(kr, kc8)) = kreg[t]; *(LAS u32x4*)(lds + L_V + t * 8192 + lw * 1024 + lane * 16) = vreg[t]; }
        lut4_put(lut, 512, tid, lreg);
        WG_BAR();
        if (unit + F.G < 512) OWN_FETCH(unit + F.G);
        f32x16 o[2];
#pragma unroll
        for (int r = 0; r < 16; ++r) { o[0][r] = 0.f; o[1][r] = 0.f; }
        float lsum = 0.f; const int nt = (wave >> 1) + 1; const LutLane LL = lut_lane(lut, 512, 512, r32 - 4 * hi);
#pragma unroll 1
        for (int t = 0; t < nt; ++t)
            tile<true, true>(o, lsum, qr, lds + L_K + t * 8192, lds + L_V + t * 8192, 0.f, LL, 32 * wave + r32 - 64 * t, 0x7fffffffu, r32, hi, lane, t == nt - 1);
        lsum += __shfl_xor(lsum, 32);
        if (hi == 0) wsf[r32] = lsum;
        stage_o(stg, o, r32, hi);
        LDS_WAIT(); asm volatile("" ::: "memory");
#pragma unroll
        for (int i = 0; i < 4; ++i) { const int row = i * 8 + (lane >> 3), ch = lane & 7, qq = qb * 256 + 32 * wave + row;
            const u32x4 v = *(const LAS u32x4*)(stg + row * 64 + ch * 8); float f[8]; unpack8(f, v);
            float L = wsf[row];
#pragma unroll
            for (int s = 0; s < 3; ++s) { L += plv[i][s]; float pf[8]; unpack8(pf, pov[i][s]);
#pragma unroll
                for (int e = 0; e < 8; ++e) f[e] += pf[e]; }
            const float inv = F8_SY / L;
#pragma unroll
            for (int e = 0; e < 8; ++e) f[e] *= inv;
            const size_t yo = (size_t)qq * 1024 + h * 64 + ch * 8;
            if (F8_G2) *(u32x2*)(Y + yo) = pack8f8(f); else *(u32x4*)(Y + 2 * yo) = pack8(f); }
        LDS_WAIT(); asm volatile("" ::: "memory");
    }
#undef OWN_FETCH
#undef WG_BAR
}

__global__ void __launch_bounds__(512, 2) fwd_kernel(Args args) {
    extern __shared__ __attribute__((aligned(16))) unsigned char lds_raw[];
    Frame F;
    F.lds = (LAS unsigned char*)lds_raw;
    F.tid = threadIdx.x; F.lane = F.tid & 63; F.wave = __builtin_amdgcn_readfirstlane(F.tid >> 6);
    F.G = gridDim.x; { const int bx = blockIdx.x; F.vcu = (F.G % 8 == 0) ? (bx % 8) * (F.G / 8) + bx / 8 : bx; }
    F.ws = args.ws; F.out = args.out;
    unsigned char* ws = args.ws;
    volatile LAS unsigned* MISC = (volatile LAS unsigned*)(F.lds + MISC_OFF);
    for (int u = F.tid; u < (LDS_BYTES - LDSCTL_OFF) / 4; u += 512) ((LAS unsigned*)(F.lds + LDSCTL_OFF))[u] = 0u;
    __syncthreads();
    XcdBarrier bar; bar.bar = (unsigned*)(ws + WS_CTL) + 4096; bar.x = 0; bar.st = nullptr;
    const bool multi = (args.ph_hi - args.ph_lo) > 1;
    if (multi) bar = xcd_barrier_post((unsigned*)(ws + WS_CTL) + 4096, MISC + 8);

    const int lo = args.ph_lo, hi = args.ph_hi;
    float* ssq = (float*)(ws + WS_SSQ);
#ifndef PH_MASK
#define PH_MASK 0x1ffff
#endif
#define IN(k) (lo <= (k) && (k) < hi && ((PH_MASK >> ((k) > 8 ? (k) - 8 : (k))) & 1))
#define SEAM(k) do { if (IN(k) && IN((k) + 1)) xcd_barrier(bar); } while (0)
#ifndef REP_MASK
#define REP_MASK 0
#endif
#define RUN(p, l, X) do { if (IN(1 + NPH * (l) + (p))) { X; if ((REP_MASK >> (p)) & 1) { xcd_barrier(bar); X; } } SEAM(1 + NPH * (l) + (p)); } while (0)
#define WB(l) ((l) == 0 ? (unsigned char*)args.out + DO_W : ws + WS_W)
#define PH_G1(l) do { \
        pg8::Gemm g{F8_G1 ? ws + WS_X8 : ws + WS_XB, WB(l) + OFF_WIN, F8_G1 ? D : 2 * D, F8_G1 ? D : 2 * D, F8_G1 ? D : 2 * D, 0}; pg8::StaticOrder S; S.init(M, INW - 256, F.G, (int)blockIdx.x, 1); \
        const int pm0_ = S.first_pm(); const LAS float* rt_ = (const LAS float*)(F.lds + L_RSTD); proj_consts((LAS float*)(F.lds + L_RSTD), args.in[5] + (l) * 64, args.in[6] + (l) * 64, args.in[7] + (l) * 64, args.in[8] + (l) * 64, args.in[4] + (l) * 2048); rstd_table((LAS float*)(F.lds + L_RSTD), ssq, pm0_ < 0 ? 0 : pm0_, F8_G1 ? 1.0f / F8_SW : 1.0f); \
        pg8::EpiProj E{rt_, (bf16_t*)(ws + WS_QA), (bf16_t*)(ws + WS_KA), (bf16_t*)(ws + WS_VA), (bf16_t*)(ws + WS_QB), (bf16_t*)(ws + WS_KB), (bf16_t*)(ws + WS_VB), (bf16_t*)(ws + WS_GT), (float*)(ws + WS_KMP)}; \
        pg8::gemm_phase<F8_G1 != 0, pg8::EpiProj>(F.lds, g, S, E); } while (0)
#define PH_G2(l) do { \
        pg8::Gemm g{(unsigned char*)args.out + DO_Y, WB(l) + OFF_WBR, F8_G2 ? D : 2 * D, F8_G2 ? D : 2 * D, F8_G2 ? 512 : 1024, F8_G2 ? 512 : 1024}; pg8::StaticOrder S; S.init(M, D, F.G, (int)blockIdx.x, 2); \
        pg8::EpiMerge E{(const bf16_t*)(ws + WS_GT), ws + WS_MRG}; \
        pg8::gemm_phase<F8_G2 != 0, pg8::EpiMerge>(F.lds, g, S, E); } while (0)
#define PH_G3(l) do { \
        pg8::Gemm g{ws + WS_MRG, WB(l) + OFF_WOUT, F8_G3 ? D : 2 * D, F8_G3 ? D : 2 * D, F8_G3 ? D : 2 * D, 0}; pg8::StaticOrder S; S.init(M, D, F.G, (int)blockIdx.x, 1); \
        pg8::EpiResid E{(bf16_t*)(ws + WS_XB), ssq, nullptr, 1.0f / (F8_SM * F8_SW3), nullptr}; \
        pg8::gemm_phase<F8_G3 != 0, pg8::EpiResid>(F.lds, g, S, E); } while (0)
#define PH_G4(l) do { \
        pg8::Gemm g{ws + WS_XB, WB(l) + OFF_W1, 2 * D, 2 * D, 2 * D, 0}; pg8::StaticOrder S; S.init(M, FF, F.G, (int)blockIdx.x, 1); \
        const int pm0_ = S.first_pm(); const LAS float* rt_ = (const LAS float*)(F.lds + L_RSTD); rstd_table((LAS float*)(F.lds + L_RSTD), ssq, pm0_ < 0 ? 0 : pm0_, 1.0f); \
        pg8::EpiFfnUp E{rt_, (bf16_t*)(ws + WS_U)}; \
        pg8::gemm_phase<false, pg8::EpiFfnUp>(F.lds, g, S, E); } while (0)
#define PH_G5(l) do { \
        pg8::Gemm g{ws + WS_U, WB(l) + OFF_W2, 2 * FF, 2 * FF, 2 * FF, 0}; pg8::StaticOrder S; S.init(M, D, F.G, (int)blockIdx.x, 1); \
        pg8::EpiResid E{(bf16_t*)(ws + WS_XB), ssq, (l) == NLAYER - 1 ? args.out : nullptr, 1.0f, (l) == NLAYER - 1 || !F8_G1 ? nullptr : ws + WS_X8}; \
        pg8::gemm_phase<false, pg8::EpiResid>(F.lds, g, S, E); } while (0)
#define LAYER(l) do { \
    RUN(0, l, PH_G1(l)); \
    RUN(1, l, phase_swa_select(F, args, (l))); \
    RUN(2, l, phase_moba_past(F, args, (l))); \
    RUN(3, l, phase_moba_own(F, args, (l))); \
    RUN(4, l, PH_G2(l)); \
    if (IN(1 + NPH * (l) + 5)) { PH_G3(l); } SEAM(1 + NPH * (l) + 5); \
    RUN(6, l, PH_G4(l)); \
    if (IN(1 + NPH * (l) + 7)) { PH_G5(l); } SEAM(1 + NPH * (l) + 7); \
    } while (0)
    if (IN(0)) { phase_prologue(F, args); } SEAM(0);
    LAYER(0);
    LAYER(1);
#undef LAYER
#undef RUN
#undef WB
#undef SEAM
#undef IN
}

extern "C" void kernel_launch(void* const* d_in, const int* in_sizes, int n_in, void* d_out, int out_size, void* d_ws, size_t ws_size, hipStream_t stream) {
    static int grid = 0;
    if (grid == 0) {
        if (n_in != 16 || out_size != M * D || ws_size < WS_END) { fprintf(stderr, "kernel_launch: unexpected shapes (n_in %d out %d ws %zu)\n", n_in, out_size, ws_size); grid = -1; return; }
        if (hipFuncSetAttribute((const void*)fwd_kernel, hipFuncAttributeMaxDynamicSharedMemorySize, LDS_BYTES) != hipSuccess) { fprintf(stderr, "kernel_launch: hipFuncSetAttribute failed\n"); grid = -1; return; }
        (void)hipGetLastError();
        grid = 256;
    }
    if (grid < 0) return;
    (void)hipMemsetAsync((char*)d_ws + WS_CTL, 0, CTL_ZERO_BYTES, stream);
    Args a{};
    for (int i = 0; i < 16; ++i) a.in[i] = (const float*)d_in[i];
    a.out = (float*)d_out; a.ws = (unsigned char*)d_ws;
    constexpr int NPHASES = 1 + NLAYER * NPH;
    if (MK_N_LAUNCHES == 1) {
        a.ph_lo = 0; a.ph_hi = NPHASES;
        hipLaunchKernelGGL(fwd_kernel, dim3(grid), dim3(512), LDS_BYTES, stream, a);
    } else {
        for (int p = 0; p < NPHASES; ++p) { a.ph_lo = p; a.ph_hi = p + 1; hipLaunchKernelGGL(fwd_kernel, dim3(grid), dim3(512), LDS_BYTES, stream, a); }
    }
}
```

```cpp
#include <hip/hip_runtime.h>
#include <hip/hip_bf16.h>
#include <cstdint>
#include <cstdio>

#ifndef MK_N_LAUNCHES
#define MK_N_LAUNCHES 1
#endif

#ifndef F8_G1
#define F8_G1 1
#endif
#ifndef F8_G2
#define F8_G2 1
#endif
#ifndef F8_G3
#define F8_G3 1
#endif

#define LAS __attribute__((address_space(3)))
#define GAS __attribute__((address_space(1)))
typedef unsigned short bf16_t;
typedef short bf16x8 __attribute__((ext_vector_type(8)));
typedef float f32x4 __attribute__((ext_vector_type(4)));
typedef float f32x2 __attribute__((ext_vector_type(2)));
typedef float f32x16 __attribute__((ext_vector_type(16)));
typedef unsigned u32x4 __attribute__((ext_vector_type(4)));
typedef unsigned u32x2 __attribute__((ext_vector_type(2)));
typedef short v4i16_t __attribute__((ext_vector_type(4)));
typedef __bf16 bf16x2_t __attribute__((ext_vector_type(2)));
typedef int i32x8 __attribute__((ext_vector_type(8)));
typedef int i32x4 __attribute__((ext_vector_type(4)));

constexpr int M = 16384, D = 1024, INW = 4352, FF = 4096, NLAYER = 2;
constexpr int NPH = 8;
constexpr float NORM_EPS = 1e-6f;
constexpr float LOG2E = 1.4426950408889634f;
constexpr float C2 = 0.125f * LOG2E;
constexpr int LUTN = 2176, LUTPAD = 128;

constexpr size_t MiB = 1u << 20;
constexpr size_t WS_CTL = 0, CTL_ZERO_BYTES = 64 * 1024;
constexpr size_t WS_SSQ = 64 * 1024;
constexpr size_t WS_KMP = WS_SSQ + 1 * MiB;
constexpr size_t WS_LUT = WS_KMP + 256 * 1024;
constexpr size_t WS_CUR = WS_LUT + 256 * 1024;
constexpr size_t WS_PL = WS_CUR + 64 * 1024;
constexpr size_t WS_W = 3 * MiB + 512 * 1024;
constexpr size_t OFF_WIN = 0;
constexpr size_t OFF_WBR = OFF_WIN + (size_t)INW * D * 2;
constexpr size_t OFF_WOUT = OFF_WBR + 2 * MiB;
constexpr size_t OFF_W1 = OFF_WOUT + 2 * MiB;
constexpr size_t OFF_W2 = OFF_W1 + 8 * MiB;
constexpr size_t W_BYTES = OFF_W2 + 8 * MiB;
constexpr size_t WS_XB = WS_W + W_BYTES;
constexpr size_t WS_PROJ = WS_XB + 32 * MiB;
constexpr size_t WS_QA = WS_PROJ, WS_KA = WS_QA + 16 * MiB, WS_VA = WS_KA + 16 * MiB, WS_QB = WS_VA + 16 * MiB;
constexpr size_t WS_KB = WS_QB + 16 * MiB, WS_VB = WS_KB + 4 * MiB, WS_GT = WS_VB + 4 * MiB;
constexpr size_t WS_MRG = WS_PROJ;
constexpr size_t WS_U = WS_PROJ;
constexpr size_t WS_PO = WS_GT + 64 * MiB;
constexpr size_t WS_LISTS = WS_PO + 48 * MiB;
constexpr int LIST_HEAD = 516096;
constexpr size_t WS_END = WS_LISTS + (size_t)8 * LIST_HEAD * 2;
static_assert(WS_END <= 256 * MiB, "ws map");
static_assert(WS_U + (size_t)M * FF * 2 <= WS_PO, "u overlay");
static_assert(WS_PL + 3 * 8 * (size_t)M * 4 <= WS_W, "misc map");
constexpr size_t DO_Y = 0, DO_W = 32 * MiB;
constexpr size_t WS_X8 = WS_PO;

constexpr int RING_BYTES = 131072;
constexpr int LDSCTL_OFF = 145408, MISC_OFF = LDSCTL_OFF + 320;
constexpr int LDS_BYTES = 147456;
constexpr int L_K = 0, L_V = 32768, L_OST = 65536, L_WSF = 98304, L_LUT = 100352, L_TAB = 135168, L_SM = 143360;
constexpr int L_RSTD = 131072;
static_assert(L_RSTD + 2560 * 4 <= LDSCTL_OFF, "epilogue tables");
static_assert(L_LUT + 4 * LUTN * 4 <= L_TAB && L_TAB + 4096 <= L_SM && L_SM + 1024 <= LDSCTL_OFF && MISC_OFF + 128 <= LDS_BYTES, "LDS map");

__device__ __forceinline__ unsigned cvtpk(float lo, float hi) { f32x2 v = {lo, hi}; bf16x2_t b = __builtin_convertvector(v, bf16x2_t); return __builtin_bit_cast(unsigned, b); }
__device__ __forceinline__ float bf_lo(unsigned w) { return __builtin_bit_cast(float, w << 16); }
__device__ __forceinline__ float bf_hi(unsigned w) { return __builtin_bit_cast(float, w & 0xffff0000u); }
__device__ __forceinline__ unsigned f2bf(float f) { unsigned u = __builtin_bit_cast(unsigned, f); return (u + 0x7fffu + ((u >> 16) & 1u)) >> 16; }
__device__ __forceinline__ unsigned pk2(float lo, float hi) { return f2bf(lo) | (f2bf(hi) << 16); }
__device__ __forceinline__ unsigned pk4f8(float a, float b, float c, float d) { int p = __builtin_amdgcn_cvt_pk_fp8_f32(a, b, 0, false); p = __builtin_amdgcn_cvt_pk_fp8_f32(c, d, p, true); return (unsigned)p; }
constexpr float F8_SW = 40.f, F8_SY = F8_G2 ? 10.f : 1.f, F8_SM = F8_G3 ? 10.f : 1.f;
constexpr float F8_SW2 = F8_G2 ? F8_SW : 1.f, F8_SW3 = F8_G3 ? F8_SW : 1.f;

namespace pg8 {
constexpr int BM = 256, BK = 64, HALF = 128, HTB = HALF * BK * 2, NXCD = 8, WGM = 8;
__host__ __device__ __forceinline__ int lds_byte(int r, int c) { const int st = (r >> 4) * 2 + (c >> 5), rr = r & 15, cc = c & 31, ob = rr * 64 + cc * 2; return st * 1024 + (ob ^ (((ob >> 9) & 1) << 5)); }
__host__ __device__ __forceinline__ void stage_rc(int b, int& R, int& C) { const int st = b / 1024, sb = b % 1024, swz = sb ^ (((sb >> 9) & 1) << 5); R = (st >> 1) * 16 + swz / 64; C = (st & 1) * 32 + (swz % 64) / 2; }
__host__ __device__ __forceinline__ int perm32(int rho) { const int n = rho >> 4, i = rho & 15; return 8 * (i >> 2) + 4 * n + (i & 3); }

struct Unit { int pm, pn, part; };
struct Gemm { const void* A; const void* Bt; int lda, ldb, K, kpart; };

struct StaticOrder {
    int nM, nN, nwg, G, c, parts;
    int fixed, fpm, fpn;
    __device__ __forceinline__ void init(int M_, int N_, int G_, int c_, int parts_) { nM = M_ / BM; nN = N_ / BM; nwg = nM * nN; G = G_; c = c_; parts = parts_; fixed = 0; fpm = 0; fpn = 0; }
    __device__ __forceinline__ void init_single(int pm_, int pn_, bool have) { nM = 1; nN = 1; nwg = 1; G = 1; c = 0; parts = 1; fixed = have ? 1 : 2; fpm = pm_; fpn = pn_; }
    __device__ __forceinline__ int first_pm() const {
        if (c >= nwg) return -1;
        int wgid = c; { const int q = nwg / NXCD, r = nwg % NXCD, xcd = wgid % NXCD, off = wgid / NXCD; wgid = (xcd < r ? xcd * (q + 1) : r * (q + 1) + (xcd - r) * q) + off; }
        const int nig = WGM * nN, gid = wgid / nig, fm = gid * WGM, gsz = (nM - fm) < WGM ? (nM - fm) : WGM;
        return fm + ((wgid % nig) % gsz);
    }
    __device__ __forceinline__ bool next(int i, Unit& u) const {
        if (fixed) { u.pm = fpm; u.pn = fpn; u.part = 0; return fixed == 1 && i == 0; }
        const int ti = i / parts; u.part = i - ti * parts;
        const long L = (long)ti * G + c; if (L >= nwg) return false;
        int wgid = (int)L; { const int q = nwg / NXCD, r = nwg % NXCD, xcd = wgid % NXCD, off = wgid / NXCD; wgid = (xcd < r ? xcd * (q + 1) : r * (q + 1) + (xcd - r) * q) + off; }
        const int nig = WGM * nN, gid = wgid / nig, fm = gid * WGM, gsz = (nM - fm) < WGM ? (nM - fm) : WGM;
        u.pm = fm + ((wgid % nig) % gsz); u.pn = (wgid % nig) / gsz; return true;
    }
};

template <bool F8, class Epi>
__device__ __forceinline__ void gemm_phase(LAS unsigned char* lds, const Gemm g, const StaticOrder& S, const Epi& E) {
    const int tid = threadIdx.x, wid = __builtin_amdgcn_readfirstlane(tid >> 6), lane = tid & 63, wr = wid >> 2, wc = wid & 3, fr = lane & 15, fq = lane >> 4;
    const int nt = g.K / 128;
    unsigned voffA, voffB;
    { int R, C; stage_rc(tid * 16, R, C); const int Rb = (R & ~31) + perm32(R & 31); voffA = (unsigned)(R * g.lda + 2 * C); voffB = (unsigned)(Rb * g.ldb + 2 * C); }
    const size_t ivoffA = (size_t)64 * g.lda, ivoffB = (size_t)64 * g.ldb;
    const size_t kstep = (size_t)(BK * 2);
    const size_t hstepA = (size_t)HALF * g.lda, hstepB = (size_t)HALF * g.ldb;
    const size_t tstepA = 2 * hstepA, tstepB = 2 * hstepB;
    const unsigned ldsw = (unsigned)wid * 1024u;
    const int aoff = lds_byte(wr * 64 + fr, fq * 8), boff = lds_byte(wc * 32 + fr, fq * 8);
#define PG8_SA(b, h) (((b) * 2 + (h)) * HTB)
#define PG8_SB(b, h) ((4 + (b) * 2 + (h)) * HTB)
#define PG8_STAGE(bufoff, gbase, voff) do { _Pragma("unroll") for (int _i = 0; _i < 2; ++_i) \
        __builtin_amdgcn_global_load_lds((const unsigned*)((const char*)(gbase) + _i * i##voff + (voff)), (LAS unsigned*)(lds + (bufoff) + ldsw + _i * 8192), 16, 0, 0); } while (0)
#define PG8_LDA(dst, b, h) do { _Pragma("unroll") for (int m = 0; m < 4; ++m) _Pragma("unroll") for (int k = 0; k < 2; ++k) dst[m][k] = *(const LAS bf16x8*)(lds + PG8_SA(b, h) + aoff + m * 2048 + k * 1024); } while (0)
#define PG8_LDB(dst, b, h) do { _Pragma("unroll") for (int n = 0; n < 2; ++n) _Pragma("unroll") for (int k = 0; k < 2; ++k) dst[n][k] = *(const LAS bf16x8*)(lds + PG8_SB(b, h) + boff + n * 2048 + k * 1024); } while (0)
#define PG8_F8CAT(x) __builtin_shufflevector(__builtin_bit_cast(i32x4, x[0]), __builtin_bit_cast(i32x4, x[1]), 0, 1, 2, 3, 4, 5, 6, 7)
#define PG8_MMA(ai, bj, At, Bt) do { __builtin_amdgcn_s_setprio(1); _Pragma("unroll") for (int m = 0; m < 4; ++m) _Pragma("unroll") for (int n = 0; n < 2; ++n) { \
        if (F8) { const i32x8 b8_ = PG8_F8CAT(Bt[n]), a8_ = PG8_F8CAT(At[m]); asm volatile("v_mfma_scale_f32_16x16x128_f8f6f4 %0, %1, %2, %0, %3, %3 op_sel_hi:[0,0,0]" : "+v"(acc[ai][bj][m][n]) : "v"(b8_), "v"(a8_), "v"(f8one)); } \
        else { _Pragma("unroll") for (int k = 0; k < 2; ++k) acc[ai][bj][m][n] = __builtin_amdgcn_mfma_f32_16x16x32_bf16(Bt[n][k], At[m][k], acc[ai][bj][m][n], 0, 0, 0); } } __builtin_amdgcn_s_setprio(0); } while (0)
#define PG8_WAIT_V(n) asm volatile("s_waitcnt vmcnt(" #n ")" ::: "memory")
#define PG8_WAIT_L(n) asm volatile("s_waitcnt lgkmcnt(" #n ")" ::: "memory")
#define PG8_BAR __builtin_amdgcn_s_barrier()
#define PG8_SCHED __builtin_amdgcn_sched_barrier(0)
    Unit cur, nxt; int ui = 0;
    if (!S.next(0, cur)) return;
    const int f8one = 0x7f7f7f7f;
    f32x4 acc[2][2][4][2];
#pragma unroll
    for (int a = 0; a < 2; ++a)
#pragma unroll
        for (int b = 0; b < 2; ++b)
#pragma unroll
            for (int m = 0; m < 4; ++m)
#pragma unroll
                for (int n = 0; n < 2; ++n) acc[a][b][m][n] = (f32x4){0.f, 0.f, 0.f, 0.f};
    bf16x8 At[4][2], B0[2][2], B1[2][2];
    const char* cA = (const char*)g.A + (size_t)cur.pm * tstepA + (size_t)cur.part * g.kpart; const char* cB = (const char*)g.Bt + (size_t)cur.pn * tstepB + (size_t)cur.part * g.kpart;
    PG8_STAGE(PG8_SB(0, 0), cB, voffB); PG8_STAGE(PG8_SB(0, 1), cB + hstepB, voffB); PG8_STAGE(PG8_SA(0, 0), cA, voffA); PG8_STAGE(PG8_SA(0, 1), cA + hstepA, voffA);
    if (wr == 1) PG8_BAR;
    PG8_WAIT_V(2); PG8_BAR;
    PG8_STAGE(PG8_SB(1, 0), cB + kstep, voffB); PG8_STAGE(PG8_SA(1, 0), cA + kstep, voffA); PG8_STAGE(PG8_SB(1, 1), cB + hstepB + kstep, voffB);
    PG8_WAIT_V(6); PG8_BAR;
    for (;;) {
        const bool has_next = S.next(ui + 1, nxt);
        const char* nA = has_next ? (const char*)g.A + (size_t)nxt.pm * tstepA + (size_t)nxt.part * g.kpart : cA;
        const char* nB = has_next ? (const char*)g.Bt + (size_t)nxt.pn * tstepB + (size_t)nxt.part * g.kpart : cB;
#pragma unroll 1
        for (int t = 0; t < nt; t += 2) {
            const bool last = (t == nt - 2);
            const char* a1 = cA + (size_t)(t + 1) * kstep;
            const char* a2 = last ? nA : cA + (size_t)(t + 2) * kstep; const char* b2 = last ? nB : cB + (size_t)(t + 2) * kstep;
            const char* a3 = a2 + kstep; const char* b3 = b2 + kstep;
            PG8_LDB(B0, 0, 0); PG8_LDB(B1, 0, 1); PG8_SCHED; PG8_LDA(At, 0, 0); PG8_STAGE(PG8_SA(1, 1), a1 + hstepA, voffA);
            PG8_WAIT_V(8); PG8_WAIT_L(0); PG8_BAR; PG8_MMA(0, 0, At, B0); PG8_MMA(0, 1, At, B1); PG8_BAR; PG8_SCHED;
            PG8_LDA(At, 0, 1); PG8_STAGE(PG8_SB(0, 0), b2, voffB); PG8_STAGE(PG8_SB(0, 1), b2 + hstepB, voffB); PG8_STAGE(PG8_SA(0, 0), a2, voffA);
            PG8_WAIT_V(8); PG8_WAIT_L(0); PG8_BAR; PG8_MMA(1, 0, At, B0); PG8_MMA(1, 1, At, B1); PG8_BAR; PG8_SCHED;
            PG8_LDB(B0, 1, 0); PG8_LDB(B1, 1, 1); PG8_SCHED; PG8_LDA(At, 1, 0); PG8_STAGE(PG8_SA(0, 1), a2 + hstepA, voffA);
            PG8_WAIT_V(8); PG8_WAIT_L(0); PG8_BAR; PG8_MMA(0, 0, At, B0); PG8_MMA(0, 1, At, B1); PG8_BAR; PG8_SCHED;
            PG8_LDA(At, 1, 1); PG8_STAGE(PG8_SB(1, 0), b3, voffB); PG8_STAGE(PG8_SB(1, 1), b3 + hstepB, voffB); PG8_STAGE(PG8_SA(1, 0), a3, voffA);
            PG8_WAIT_V(8); PG8_WAIT_L(0); PG8_BAR; PG8_MMA(1, 0, At, B0); PG8_MMA(1, 1, At, B1); PG8_BAR; PG8_SCHED;
        }
        if (F8) asm volatile("s_nop 15\n\ts_nop 15" ::: "memory");
        if (wr == 0) PG8_BAR;
        E(acc, cur, wr, wc, fr, fq);
        if (!has_next) break;
        if (!E.keep(cur)) {
#pragma unroll
        for (int a = 0; a < 2; ++a)
#pragma unroll
            for (int b = 0; b < 2; ++b)
#pragma unroll
                for (int m = 0; m < 4; ++m)
#pragma unroll
                    for (int n = 0; n < 2; ++n) acc[a][b][m][n] = (f32x4){0.f, 0.f, 0.f, 0.f};
        }
        cur = nxt; cA = nA; cB = nB; ++ui;
        if (wr == 1) PG8_BAR;
    }
    PG8_WAIT_V(0);
    PG8_BAR;
#undef PG8_SA
#undef PG8_SB
#undef PG8_STAGE
#undef PG8_LDA
#undef PG8_LDB
#undef PG8_MMA
#undef PG8_F8CAT
#undef PG8_WAIT_V
#undef PG8_WAIT_L
#undef PG8_BAR
#undef PG8_SCHED
}

__device__ __forceinline__ float row_rstd(const float* ssq, int row, int fq) {
    const f32x4 s4 = *(const f32x4*)(ssq + (size_t)row * 16 + 4 * fq);
    float s = (s4[0] + s4[1]) + (s4[2] + s4[3]);
    s += __shfl_xor(s, 16); s += __shfl_xor(s, 32);
    return 1.0f / sqrtf(s * (1.0f / 1024.0f) + NORM_EPS);
}
__device__ __forceinline__ void store8(bf16_t* p, const f32x4 a, const f32x4 b) {
    u32x4 w; w.x = cvtpk(a[0], a[1]); w.y = cvtpk(a[2], a[3]); w.z = cvtpk(b[0], b[1]); w.w = cvtpk(b[2], b[3]); *(u32x4*)p = w;
}

struct EpiProj {
    const LAS float* rtab; bf16_t *Qa, *Ka, *Va, *Qb, *Kb, *Vb, *Gt; float* kmp;
    __device__ __forceinline__ bool keep(const Unit&) const { return false; }
    __device__ __forceinline__ void operator()(f32x4 (&acc)[2][2][4][2], const Unit& u, int wr, int wc, int fr, int fq) const {
        const int pn = u.pn, row0 = u.pm * BM + wr * 64 + fr;
        int mode; bf16_t* dst; int ld, col0; const LAS float* w = rtab + 256; int kmhead = -1;
        if (pn < 2) { mode = 0; dst = Qa; ld = 512; col0 = (4 * pn + wc) * 64; }
        else if (pn < 4) { mode = 0; dst = Ka; ld = 512; col0 = (4 * (pn - 2) + wc) * 64; w += 64; kmhead = 4 * (pn - 2) + wc; }
        else if (pn < 6) { mode = 1; dst = Va; ld = 512; col0 = (4 * (pn - 4) + wc) * 64; }
        else if (pn < 8) { mode = 0; dst = Qb; ld = 512; col0 = (4 * (pn - 6) + wc) * 64; w += 128; }
        else if (pn == 8) { if (wc < 2) { mode = 0; dst = Kb; ld = 128; col0 = wc * 64; w += 192; } else { mode = 1; dst = Vb; ld = 128; col0 = (wc - 2) * 64; } }
        else { mode = 2; dst = Gt; ld = 2048; col0 = (pn - 9) * 128 + 32 * wc; }
        f32x4 cw[2][2];
#pragma unroll
        for (int bj = 0; bj < 2; ++bj)
#pragma unroll
            for (int n = 0; n < 2; ++n) {
                if (mode == 0) cw[bj][n] = *(const LAS f32x4*)(w + 32 * bj + 8 * fq + 4 * n);
                else if (mode == 2) cw[bj][n] = *(const LAS f32x4*)(rtab + 512 + 1024 * bj + col0 + 8 * fq + 4 * n);
                else cw[bj][n] = (f32x4){1.f, 1.f, 1.f, 1.f};
            }
        f32x4 ks[2][2];
#pragma unroll
        for (int bj = 0; bj < 2; ++bj)
#pragma unroll
            for (int n = 0; n < 2; ++n) ks[bj][n] = (f32x4){0.f, 0.f, 0.f, 0.f};
#pragma unroll
        for (int ai = 0; ai < 2; ++ai)
#pragma unroll
            for (int m = 0; m < 4; ++m) {
                const int row = row0 + ai * HALF + m * 16;
                const float rs = rtab[ai * HALF + wr * 64 + m * 16 + fr];
                f32x4 v[2][2];
#pragma unroll
                for (int bj = 0; bj < 2; ++bj)
#pragma unroll
                    for (int n = 0; n < 2; ++n) v[bj][n] = acc[ai][bj][m][n] * rs;
                if (mode == 0) {
                    float ss = 0.f;
#pragma unroll
                    for (int bj = 0; bj < 2; ++bj)
#pragma unroll
                        for (int n = 0; n < 2; ++n) { const f32x4 x = v[bj][n]; ss += (x[0] * x[0] + x[1] * x[1]) + (x[2] * x[2] + x[3] * x[3]); }
                    ss += __shfl_xor(ss, 16); ss += __shfl_xor(ss, 32);
                    const float inv = 1.0f / sqrtf(ss * (1.0f / 64.0f) + NORM_EPS);
#pragma unroll
                    for (int bj = 0; bj < 2; ++bj)
#pragma unroll
                        for (int n = 0; n < 2; ++n) { v[bj][n] = v[bj][n] * inv * cw[bj][n]; ks[bj][n] += v[bj][n]; }
                } else if (mode == 2) {
#pragma unroll
                    for (int n = 0; n < 2; ++n) { f32x4 xa = v[0][n] + cw[0][n], xg = v[1][n] + cw[1][n];
#pragma unroll
                        for (int e = 0; e < 4; ++e) { const float da = 1.0f + __builtin_amdgcn_exp2f(-LOG2E * xa[e]), db = fminf(1.0f + __builtin_amdgcn_exp2f(-LOG2E * xg[e]), 1e20f);
                            xg[e] = __builtin_amdgcn_rcpf(db); xa[e] = db * __builtin_amdgcn_rcpf(da); }
                        v[0][n] = xa; v[1][n] = xg; }
                }
                bf16_t* rp = dst + (size_t)row * ld + col0 + 8 * fq;
                if (mode == 2) {
                    constexpr float cG = F8_SM / (F8_SW2 * F8_SY);
                    store8(rp, v[0][0], v[0][1]); store8(rp + 1024, v[1][0] * cG, v[1][1] * cG);
                } else { store8(rp, v[0][0], v[0][1]); store8(rp + 32, v[1][0], v[1][1]); }
            }
        if (kmhead >= 0) {
#pragma unroll
            for (int bj = 0; bj < 2; ++bj)
#pragma unroll
                for (int n = 0; n < 2; ++n) { f32x4 x = ks[bj][n];
#pragma unroll
                    for (int o = 1; o < 16; o <<= 1) { x[0] += __shfl_xor(x[0], o); x[1] += __shfl_xor(x[1], o); x[2] += __shfl_xor(x[2], o); x[3] += __shfl_xor(x[3], o); }
                    if (fr == 0) *(f32x4*)(kmp + ((size_t)(kmhead * 64 + u.pm) * 2 + wr) * 64 + 32 * bj + 8 * fq + 4 * n) = x; }
        }
    }
};

struct EpiMerge {
    const bf16_t* Gt; unsigned char* out;
    __device__ __forceinline__ bool keep(const Unit& u) const { return u.part == 0; }
    __device__ __forceinline__ void operator()(f32x4 (&acc)[2][2][4][2], const Unit& u, int wr, int wc, int fr, int fq) const {
        const int row0 = u.pm * BM + wr * 64 + fr, colb = u.pn * BM + wc * 32 + 8 * fq;
        const bf16_t* gp = Gt + (u.part == 0 ? 0 : 1024);
        u32x4 gw[2][4][2];
#pragma unroll
        for (int ai = 0; ai < 2; ++ai)
#pragma unroll
            for (int m = 0; m < 4; ++m)
#pragma unroll
                for (int bj = 0; bj < 2; ++bj) gw[ai][m][bj] = __builtin_nontemporal_load((const u32x4*)(gp + (size_t)(row0 + ai * HALF + m * 16) * 2048 + colb + bj * HALF));
#pragma unroll
        for (int ai = 0; ai < 2; ++ai)
#pragma unroll
            for (int m = 0; m < 4; ++m) {
                const int row = row0 + ai * HALF + m * 16;
#pragma unroll
                for (int bj = 0; bj < 2; ++bj) {
                    const int col = colb + bj * HALF; const u32x4 w = gw[ai][m][bj];
                    const f32x4 g0 = (f32x4){bf_lo(w.x), bf_hi(w.x), bf_lo(w.y), bf_hi(w.y)}, g1 = (f32x4){bf_lo(w.z), bf_hi(w.z), bf_lo(w.w), bf_hi(w.w)};
                    acc[ai][bj][m][0] *= g0; acc[ai][bj][m][1] *= g1;
                    if (u.part != 0) { const f32x4 a0 = acc[ai][bj][m][0], a1 = acc[ai][bj][m][1]; u32x2 w8; w8.x = pk4f8(a0[0], a0[1], a0[2], a0[3]); w8.y = pk4f8(a1[0], a1[1], a1[2], a1[3]); if (F8_G3) *(u32x2*)(out + (size_t)row * 1024 + col) = w8; else store8((bf16_t*)out + (size_t)row * 1024 + col, a0, a1); }
                }
            }
    }
};

struct EpiResid {
    bf16_t* xb; float* ssq; float* outf; float cs; unsigned char* x8;
    __device__ __forceinline__ bool keep(const Unit&) const { return false; }
    __device__ __forceinline__ void operator()(f32x4 (&acc)[2][2][4][2], const Unit& u, int wr, int wc, int fr, int fq) const {
        const int row0 = u.pm * BM + wr * 64 + fr, colb = u.pn * BM + wc * 32 + 8 * fq;
        u32x4 xw[2][4][2];
#pragma unroll
        for (int ai = 0; ai < 2; ++ai)
#pragma unroll
            for (int m = 0; m < 4; ++m)
#pragma unroll
                for (int bj = 0; bj < 2; ++bj) xw[ai][m][bj] = *(const u32x4*)(xb + (size_t)(row0 + ai * HALF + m * 16) * 1024 + colb + bj * HALF);
#pragma unroll
        for (int ai = 0; ai < 2; ++ai)
#pragma unroll
            for (int m = 0; m < 4; ++m) {
                const int row = row0 + ai * HALF + m * 16; float ss = 0.f;
#pragma unroll
                for (int bj = 0; bj < 2; ++bj) {
                    const size_t off = (size_t)row * 1024 + colb + bj * HALF;
                    const u32x4 w = xw[ai][m][bj];
                    const f32x4 x0 = (f32x4){bf_lo(w.x), bf_hi(w.x), bf_lo(w.y), bf_hi(w.y)} + acc[ai][bj][m][0] * cs, x1 = (f32x4){bf_lo(w.z), bf_hi(w.z), bf_lo(w.w), bf_hi(w.w)} + acc[ai][bj][m][1] * cs;
                    if (outf) { __builtin_nontemporal_store(x0, (f32x4*)(outf + off)); __builtin_nontemporal_store(x1, (f32x4*)(outf + off + 4)); }
                    else { store8(xb + off, x0, x1);
                        if (x8) { u32x2 w8; w8.x = pk4f8(x0[0], x0[1], x0[2], x0[3]); w8.y = pk4f8(x1[0], x1[1], x1[2], x1[3]); *(u32x2*)(x8 + off) = w8; }
                        ss += (x0[0] * x0[0] + x0[1] * x0[1]) + (x0[2] * x0[2] + x0[3] * x0[3]) + (x1[0] * x1[0] + x1[1] * x1[1]) + (x1[2] * x1[2] + x1[3] * x1[3]); }
                }
                if (!outf) { ss += __shfl_xor(ss, 16); ss += __shfl_xor(ss, 32);
                    if (fq == 0) ssq[(size_t)row * 16 + 4 * u.pn + wc] = ss; }
            }
    }
};

struct EpiFfnUp {
    const LAS float* rtab; bf16_t* U;
    __device__ __forceinline__ bool keep(const Unit&) const { return false; }
    __device__ __forceinline__ void operator()(f32x4 (&acc)[2][2][4][2], const Unit& u, int wr, int wc, int fr, int fq) const {
        const int row0 = u.pm * BM + wr * 64 + fr, colb = u.pn * BM + wc * 32 + 8 * fq;
#pragma unroll
        for (int ai = 0; ai < 2; ++ai)
#pragma unroll
            for (int m = 0; m < 4; ++m) {
                const int row = row0 + ai * HALF + m * 16;
                const float rs = rtab[ai * HALF + wr * 64 + m * 16 + fr];
#pragma unroll
                for (int bj = 0; bj < 2; ++bj) {
                    f32x4 a, b;
#pragma unroll
                    for (int e = 0; e < 4; ++e) { const float t0 = fmaxf(acc[ai][bj][m][0][e], 0.f) * rs, t1 = fmaxf(acc[ai][bj][m][1][e], 0.f) * rs; a[e] = t0 * t0; b[e] = t1 * t1; }
                    store8(U + (size_t)row * FF + colb + bj * HALF, a, b);
                }
            }
    }
};
}

namespace att {
__device__ __forceinline__ int crow(int r, int hi) { return (r & 3) + 8 * (r >> 2) + 4 * hi; }
__device__ __forceinline__ bf16x8 vtr2(const LAS char* p) {
    const v4i16_t lo = __builtin_amdgcn_ds_read_tr16_b64_v4i16((LAS v4i16_t*)p), hi = __builtin_amdgcn_ds_read_tr16_b64_v4i16((LAS v4i16_t*)(p + 512));
    return (bf16x8){lo[0], lo[1], lo[2], lo[3], hi[0], hi[1], hi[2], hi[3]};
}
__device__ __forceinline__ int kswz(int row, int chunk) { return chunk * 1024 + ((row & ~7) | ((row ^ chunk) & 7)) * 16; }
__device__ __forceinline__ void load_kv(LAS unsigned char* lds, const bf16_t* Kg, const bf16_t* Vg, int pitch, int row0, int tid) {
    const int lane = tid & 63, w = tid >> 6;
#pragma unroll
    for (int t = 0; t < 4; ++t) {
        const int kr = w * 8 + (lane >> 3), kc = lane & 7, gk = row0 + 64 * t + kr;
        u32x4 kv = (u32x4){0u, 0u, 0u, 0u};
        if (gk >= 0) kv = *(const u32x4*)(Kg + (size_t)gk * pitch + kc * 8);
        *(LAS u32x4*)(lds + L_K + t * 8192 + kswz(kr, kc)) = kv;
        const int gv = row0 + 64 * t + 16 * (w & 3) + (lane >> 2);
        u32x4 vv = (u32x4){0u, 0u, 0u, 0u};
        if (gv >= 0) vv = *(const u32x4*)(Vg + (size_t)gv * pitch + (w >> 2) * 32 + (lane & 3) * 8);
        *(LAS u32x4*)(lds + L_V + t * 8192 + w * 1024 + lane * 16) = vv;
    }
}
__device__ __forceinline__ void load_q(bf16x8 (&qr)[4], const bf16_t* qrow, int hi) {
#pragma unroll
    for (int d0 = 0; d0 < 4; ++d0) qr[d0] = *(const bf16x8*)(qrow + d0 * 16 + hi * 8);
}
__device__ __forceinline__ void qkt(f32x16& p0, f32x16& p1, const LAS unsigned char* Kt, const bf16x8 (&qr)[4], int r32, int hi) {
#pragma unroll
    for (int d0 = 0; d0 < 4; ++d0) {
        const LAS unsigned char* kb = Kt + kswz(r32, 2 * d0 + hi);
        const bf16x8 b0 = *(const LAS bf16x8*)(kb);
        const bf16x8 b1 = *(const LAS bf16x8*)(kb + 512);
        p0 = __builtin_amdgcn_mfma_f32_32x32x16_bf16(b0, qr[d0], p0, 0, 0, 0);
        p1 = __builtin_amdgcn_mfma_f32_32x32x16_bf16(b1, qr[d0], p1, 0, 0, 0);
    }
}
struct LutLane { const LAS float* lutp; int amax; };
__device__ __forceinline__ LutLane lut_lane(const LAS float* lut4, int cstride, int nmax, int dlane) {
    const int k = (dlane - 3 + LUTPAD) & 3; LutLane L; L.lutp = lut4 + k * cstride - k; L.amax = ((nmax - 4 - k) & ~3) + k; return L;
}
template <bool LUTB, bool MASKED>
__device__ __forceinline__ void tile(f32x16 (&o)[2], float& lsum, const bf16x8 (&qr)[4], const LAS unsigned char* Kt, const LAS unsigned char* Vt,
                                     float cbias, const LutLane L, int dbase, unsigned dmax, int r32, int hi, int lane, const bool domask = true) {
    f32x16 p0, p1;
    const int db = dbase - 4 * hi;
    if (LUTB) {
#pragma unroll
        for (int gq = 0; gq < 4; ++gq) {
            int a0 = db - 3 - 8 * gq + LUTPAD, a1 = a0 - 32; a0 = a0 < L.amax ? a0 : L.amax; a1 = a1 < L.amax ? a1 : L.amax;
            const f32x4 x0 = *(const LAS f32x4*)(L.lutp + a0), x1 = *(const LAS f32x4*)(L.lutp + a1);
#pragma unroll
            for (int i = 0; i < 4; ++i) { p0[4 * gq + i] = x0[3 - i]; p1[4 * gq + i] = x1[3 - i]; }
        }
    } else {
#pragma unroll
        for (int r = 0; r < 16; ++r) { p0[r] = cbias; p1[r] = cbias; }
    }
    qkt(p0, p1, Kt, qr, r32, hi);
    if (MASKED && domask) {
#pragma unroll
        for (int r = 0; r < 16; ++r) { const int c = (r & 3) + 8 * (r >> 2);
            if ((unsigned)(db - c) > dmax) p0[r] = -INFINITY;
            if ((unsigned)(db - 32 - c) > dmax) p1[r] = -INFINITY; }
    }
    float s = 0.f;
#pragma unroll
    for (int r = 0; r < 16; ++r) { p0[r] = __builtin_amdgcn_exp2f(p0[r]); p1[r] = __builtin_amdgcn_exp2f(p1[r]); s += p0[r] + p1[r]; }
    lsum += s;
    u32x4 pw[4];
#pragma unroll
    for (int k = 0; k < 4; ++k) { pw[0][k] = cvtpk(p0[2 * k], p0[2 * k + 1]); pw[1][k] = cvtpk(p0[8 + 2 * k], p0[9 + 2 * k]); pw[2][k] = cvtpk(p1[2 * k], p1[2 * k + 1]); pw[3][k] = cvtpk(p1[8 + 2 * k], p1[9 + 2 * k]); }
    const LAS char* vp = (const LAS char*)Vt + ((lane >> 4) & 1) * 32 + (lane & 3) * 8 + (4 * hi + ((lane & 15) >> 2)) * 64;
#pragma unroll
    for (int d0 = 0; d0 < 2; ++d0)
#pragma unroll
        for (int ks = 0; ks < 4; ++ks) {
            const bf16x8 vf = vtr2(vp + d0 * 4096 + ks * 1024);
            o[d0] = __builtin_amdgcn_mfma_f32_32x32x16_bf16(__builtin_bit_cast(bf16x8, pw[ks]), vf, o[d0], 0, 0, 0);
        }
}
__device__ __forceinline__ void lut4_put(LAS float* lut4, int cstride, int ix, float v) {
#pragma unroll
    for (int k = 0; k < 4; ++k) if (ix - k >= 0) lut4[k * cstride + ix - k] = v;
}
__device__ __forceinline__ void stage_o(LAS bf16_t* stg, const f32x16 (&o)[2], int r32, int hi) {
#pragma unroll
    for (int r = 0; r < 16; r += 2) { const int orow0 = crow(r, hi), orow1 = crow(r + 1, hi);
#pragma unroll
        for (int d0 = 0; d0 < 2; ++d0) { const unsigned w = cvtpk(o[d0][r], o[d0][r + 1]); stg[orow0 * 64 + d0 * 32 + r32] = (bf16_t)(w & 0xffffu); stg[orow1 * 64 + d0 * 32 + r32] = (bf16_t)(w >> 16); } }
}
__device__ __forceinline__ void unpack8(float (&f)[8], const u32x4 w) { f[0] = bf_lo(w.x); f[1] = bf_hi(w.x); f[2] = bf_lo(w.y); f[3] = bf_hi(w.y); f[4] = bf_lo(w.z); f[5] = bf_hi(w.z); f[6] = bf_lo(w.w); f[7] = bf_hi(w.w); }
__device__ __forceinline__ u32x2 pack8f8(const float (&f)[8]) { u32x2 w; w.x = pk4f8(f[0], f[1], f[2], f[3]); w.y = pk4f8(f[4], f[5], f[6], f[7]); return w; }
__device__ __forceinline__ u32x4 pack8(const float (&f)[8]) { u32x4 w; w.x = cvtpk(f[0], f[1]); w.y = cvtpk(f[2], f[3]); w.z = cvtpk(f[4], f[5]); w.w = cvtpk(f[6], f[7]); return w; }
}

typedef GAS unsigned gu32;
#define RLX_AGENT __ATOMIC_RELAXED, __HIP_MEMORY_SCOPE_AGENT
#define LDS_WAIT() asm volatile("s_waitcnt lgkmcnt(0)" ::: "memory")
#define VM_WAIT() asm volatile("s_waitcnt vmcnt(0)" ::: "memory")
#define XB_TMO      128
#define XB_XCNT(j)  (256  + 64 * (j))
#define XB_XSUB(j)  (1280 + 64 * (j))
#define XB_XGEN(j)  (2304 + 64 * (j))
#define XB_TOP      3328
#define XB_TOPGEN   3392
#define XCD_BAR_WORDS 3456
#define XB_SPIN_CAP (1u << 22)
__device__ __forceinline__ unsigned xb_ld(unsigned* p)              { return __hip_atomic_load(p, __ATOMIC_RELAXED, __HIP_MEMORY_SCOPE_AGENT); }
__device__ __forceinline__ unsigned xb_add(unsigned* p, unsigned v) { return __hip_atomic_fetch_add(p, v, __ATOMIC_RELAXED, __HIP_MEMORY_SCOPE_AGENT); }
__device__ __forceinline__ unsigned xb_xcc_id() { return (unsigned)__builtin_amdgcn_s_getreg((3 << 11) | 20) & 0xFu; }
#define XB_SPIN(cond, bar) do { unsigned _sp = 0; while (cond) { __builtin_amdgcn_s_sleep(1); \
    if ((++_sp & 255u) == 0u) { if (xb_ld(&(bar)[XB_TMO])) break; if (_sp > XB_SPIN_CAP) { atomicAdd(&(bar)[XB_TMO], 1u); break; } } } } while (0)
struct XcdBarrier { unsigned* bar; unsigned x; volatile LAS unsigned* st; };
__device__ __forceinline__ XcdBarrier xcd_barrier_post(unsigned* bar, volatile LAS unsigned* st) {
    XcdBarrier b; b.bar = bar; b.x = xb_xcc_id(); b.st = st;
    if (threadIdx.x == 0) (void)xb_add(&bar[XB_XCNT(b.x)], 1u);
    return b;
}
__device__ __forceinline__ void xcd_barrier_complete(unsigned* bar, unsigned x, unsigned& nloc, unsigned& nx) {
    const unsigned G = gridDim.x * gridDim.y * gridDim.z;
    unsigned sum, cnt, mine, sp = 0u;
    for (;;) {
        sum = 0u; cnt = 0u; mine = 0u;
#pragma unroll
        for (unsigned j = 0; j < 16; ++j) { const unsigned c = xb_ld(&bar[XB_XCNT(j)]); sum += c; cnt += (c > 0u) ? 1u : 0u; mine = (j == x) ? c : mine; }
        if (sum == G) break;
        __builtin_amdgcn_s_sleep(1);
        if ((++sp & 255u) == 0u) { if (xb_ld(&bar[XB_TMO])) break; if (sp > XB_SPIN_CAP) { atomicAdd(&bar[XB_TMO], 1u); break; } }
    }
    nloc = mine > 0u ? mine : 1u; nx = cnt > 0u ? cnt : 1u;
}
__device__ __forceinline__ void xcd_barrier(const XcdBarrier& b) {
    asm volatile("s_waitcnt vmcnt(0)" ::: "memory");
    __syncthreads();
    if (threadIdx.x == 0) {
        unsigned* bar = b.bar;
        __builtin_amdgcn_s_waitcnt(0);
        unsigned nloc = b.st[0], nx = b.st[1];
        if (nloc == 0u) { xcd_barrier_complete(bar, b.x, nloc, nx); b.st[0] = nloc; b.st[1] = nx; }
        const unsigned old = xb_add(&bar[XB_XSUB(b.x)], 1u);
        const unsigned gen = old / nloc;
        if (old + 1u == (gen + 1u) * nloc) {
            __builtin_amdgcn_fence(__ATOMIC_RELEASE, "agent");
            asm volatile("s_waitcnt vmcnt(0)" ::: "memory");
            const unsigned og = xb_add(&bar[XB_TOP], 1u);
            const unsigned tg = og / nx;
            if (og + 1u == (tg + 1u) * nx) xb_add(&bar[XB_TOPGEN], 1u);
            else XB_SPIN(xb_ld(&bar[XB_TOPGEN]) == tg, bar);
            __builtin_amdgcn_fence(__ATOMIC_ACQUIRE, "agent");
            xb_add(&bar[XB_XGEN(b.x)], 1u);
            asm volatile("s_waitcnt vmcnt(0)" ::: "memory");
        } else {
            XB_SPIN(xb_ld(&bar[XB_XGEN(b.x)]) == gen, bar);
            __builtin_amdgcn_fence(__ATOMIC_ACQUIRE, "agent");
            asm volatile("s_waitcnt vmcnt(0)" ::: "memory");
        }
    }
    __syncthreads();
}

__device__ __forceinline__ void rstd_table(LAS float* rtab, const float* ssq, int pm, const float scale) {
    const int tid = threadIdx.x;
    if (tid < 256) { const f32x4* p = (const f32x4*)(ssq + (size_t)(pm * 256 + tid) * 16); const f32x4 a = p[0], b = p[1], c = p[2], d = p[3];
        const float s = ((a[0] + a[1]) + (a[2] + a[3])) + ((b[0] + b[1]) + (b[2] + b[3])) + ((c[0] + c[1]) + (c[2] + c[3])) + ((d[0] + d[1]) + (d[2] + d[3]));
        rtab[tid] = scale / sqrtf(s * (1.0f / 1024.0f) + NORM_EPS); }
    __syncthreads();
}
__device__ __forceinline__ void proj_consts(LAS float* tab, const float* qna, const float* kna, const float* qnb, const float* knb, const float* bgate) {
    const int tid = threadIdx.x;
    if (tid < 256) { const int k = tid >> 6, i = tid & 63; tab[256 + tid] = (k == 0) ? qna[i] * C2 : (k == 1) ? kna[i] : (k == 2) ? qnb[i] * C2 : knb[i]; }
#pragma unroll
    for (int i = 0; i < 4; ++i) tab[512 + tid + 512 * i] = bgate[tid + 512 * i];
}
struct Args { const float* in[16]; float* out; unsigned char* ws; int ph_lo, ph_hi; };
struct Frame {
    LAS unsigned char* lds;
    int tid, lane, wave, G, vcu;
    unsigned char* ws; float* out;
};

__device__ __forceinline__ float wave_sum(float v) {
#pragma unroll
    for (int o = 1; o < 64; o <<= 1) v += __shfl_xor(v, o);
    return v;
}
__device__ __forceinline__ int rel_bucket(int d) {
    if (d < 16) return d < 0 ? 0 : d;
    int b = 16;
    b += (d >= 22); b += (d >= 30); b += (d >= 40); b += (d >= 54); b += (d >= 73); b += (d >= 99); b += (d >= 134); b += (d >= 182);
    b += (d >= 246); b += (d >= 332); b += (d >= 450); b += (d >= 609); b += (d >= 825); b += (d >= 1117); b += (d >= 1513);
    return b;
}

struct PItem { int type; const float* src; int N; const float* gs; unsigned char* dst; int f8, ldk, kcol, drowA, drowB, m0; };
__device__ __forceinline__ int win_drow(int n0) {
    if (n0 >= 2304) { const int gg = n0 - 2304, isb = gg >= 1024 ? 1 : 0, G0 = gg - 1024 * isb; return (9 + (G0 >> 7)) * 256 + 128 * isb + 32 * ((G0 & 127) >> 5); }
    const int cc = n0 & 255; return (n0 & ~255) + 128 * ((cc >> 5) & 1) + 32 * (cc >> 6);
}
constexpr int PT_LAYER = 16 * 68 + 2 * 8 * 16 + 16 * 16 + 16 * 64 + 64 * 16;
constexpr int PT_X = M / 4;
__device__ __forceinline__ PItem pro_decode(int it, const Args& a, unsigned char* ws, unsigned char* outb) {
    PItem p; p.gs = nullptr; p.m0 = 0; p.ldk = D; p.drowA = 0; p.drowB = 0; p.kcol = 0; p.N = D; p.dst = nullptr; p.src = nullptr; p.f8 = 0;
    if (it >= NLAYER * PT_LAYER) { p.type = 1; p.m0 = (it - NLAYER * PT_LAYER) * 4; p.src = a.in[0] + (size_t)p.m0 * D; return p; }
    p.type = 0;
    const int l = it / PT_LAYER; int r = it - l * PT_LAYER;
    unsigned char* wb = (l == 0) ? outb + DO_W : ws + WS_W;
    if (r < 16 * 68) { const int kb = r / 68, n0 = (r % 68) * 64, k0 = kb * 64; p.src = a.in[3] + (size_t)l * D * INW + (size_t)k0 * INW + n0; p.N = INW; p.gs = a.in[2] + (size_t)l * D + k0;
        p.dst = wb + OFF_WIN; p.f8 = F8_G1; p.kcol = k0; p.drowA = win_drow(n0); p.drowB = win_drow(n0 + 32); return p; } r -= 16 * 68;
    if (r < 128) { const int kb = r / 16, n0 = (r % 16) * 64, k0 = kb * 64; p.src = a.in[10] + (size_t)l * 512 * D + (size_t)k0 * D + n0; p.dst = wb + OFF_WBR; p.f8 = F8_G2; p.kcol = k0; p.drowA = n0; p.drowB = n0 + 32; return p; } r -= 128;
    if (r < 128) { const int kb = r / 16, n0 = (r % 16) * 64, k0 = kb * 64; p.src = a.in[11] + (size_t)l * 512 * D + (size_t)k0 * D + n0; p.dst = wb + OFF_WBR; p.f8 = F8_G2; p.kcol = 512 + k0; p.drowA = n0; p.drowB = n0 + 32; return p; } r -= 128;
    if (r < 256) { const int kb = r / 16, n0 = (r % 16) * 64, k0 = kb * 64; p.src = a.in[12] + (size_t)l * D * D + (size_t)k0 * D + n0; p.dst = wb + OFF_WOUT; p.f8 = F8_G3; p.kcol = k0; p.drowA = n0; p.drowB = n0 + 32; return p; } r -= 256;
    if (r < 1024) { const int kb = r / 64, n0 = (r % 64) * 64, k0 = kb * 64; p.src = a.in[14] + (size_t)l * D * FF + (size_t)k0 * FF + n0; p.N = FF; p.gs = a.in[13] + (size_t)l * D + k0;
        p.dst = wb + OFF_W1; p.kcol = k0; p.drowA = n0; p.drowB = n0 + 32; return p; } r -= 1024;
    { const int kb = r / 16, n0 = (r % 16) * 64, k0 = kb * 64; p.src = a.in[15] + (size_t)l * FF * D + (size_t)k0 * D + n0; p.dst = wb + OFF_W2; p.ldk = FF; p.kcol = k0; p.drowA = n0; p.drowB = n0 + 32; }
    return p;
}
__device__ __forceinline__ void pro_load(f32x4 (&v)[16], const PItem& p, int lane) {
    if (p.type == 0) { const float* s = p.src + (size_t)(lane >> 4) * p.N + (lane & 15) * 4;
#pragma unroll
        for (int i = 0; i < 16; ++i) v[i] = __builtin_nontemporal_load((const f32x4*)(s + (size_t)(4 * i) * p.N));
    } else { const float* s = p.src + lane * 4;
#pragma unroll
        for (int i = 0; i < 16; ++i) v[i] = __builtin_nontemporal_load((const f32x4*)(s + (i >> 2) * D + (i & 3) * 256));
    }
}
__device__ __forceinline__ void pro_process(const f32x4 (&v)[16], const PItem& p, LAS float* scr, int lane, unsigned char* ws, unsigned char* x8) {
    if (p.type == 0) {
        const int c = lane & 7, nl = lane >> 3;
        f32x4 g0 = (f32x4){1.f, 1.f, 1.f, 1.f}, g1 = g0;
        if (p.gs) { g0 = *(const f32x4*)(p.gs + 8 * c); g1 = *(const f32x4*)(p.gs + 8 * c + 4); }
        if (p.f8) { g0 = g0 * F8_SW; g1 = g1 * F8_SW; }
#pragma unroll
        for (int i = 0; i < 16; ++i) { LAS float* w = scr + (4 * i + (lane >> 4)) * 65 + (lane & 15) * 4; w[0] = v[i][0]; w[1] = v[i][1]; w[2] = v[i][2]; w[3] = v[i][3]; }
        LDS_WAIT(); asm volatile("" ::: "memory");
#pragma unroll
        for (int j = 0; j < 8; ++j) { const int n = nl + 8 * j; const LAS float* s = scr + (8 * c) * 65 + n;
            const float t0 = s[0 * 65] * g0[0], t1 = s[1 * 65] * g0[1], t2 = s[2 * 65] * g0[2], t3 = s[3 * 65] * g0[3], t4 = s[4 * 65] * g1[0], t5 = s[5 * 65] * g1[1], t6 = s[6 * 65] * g1[2], t7 = s[7 * 65] * g1[3];
            const int drow = (j < 4) ? p.drowA + n : p.drowB + n - 32;
            const size_t eo = (size_t)drow * p.ldk + p.kcol + 8 * c;
            if (p.f8) { u32x2 o; o.x = pk4f8(t0, t1, t2, t3); o.y = pk4f8(t4, t5, t6, t7); *(u32x2*)(p.dst + eo) = o; }
            else { u32x4 o; o.x = cvtpk(t0, t1); o.y = cvtpk(t2, t3); o.z = cvtpk(t4, t5); o.w = cvtpk(t6, t7); *(u32x4*)(p.dst + eo * 2) = o; } }
        LDS_WAIT(); asm volatile("" ::: "memory");
    } else {
        bf16_t* xb = (bf16_t*)(ws + WS_XB); float* ssq = (float*)(ws + WS_SSQ);
#pragma unroll
        for (int r = 0; r < 4; ++r) { float s = 0.f;
#pragma unroll
            for (int q = 0; q < 4; ++q) { const f32x4 x = v[4 * r + q]; s += (x[0] * x[0] + x[1] * x[1]) + (x[2] * x[2] + x[3] * x[3]); }
            s = wave_sum(s);
            u32x2* o8 = (u32x2*)(xb + (size_t)(p.m0 + r) * D) + lane;
#pragma unroll
            for (int q = 0; q < 4; ++q) { const f32x4 x = v[4 * r + q]; u32x2 w; w.x = cvtpk(x[0], x[1]); w.y = cvtpk(x[2], x[3]); o8[64 * q] = w;
                if (F8_G1) ((unsigned*)(x8 + (size_t)(p.m0 + r) * D))[lane + 64 * q] = pk4f8(x[0], x[1], x[2], x[3]); }
            if (lane < 16) ssq[(size_t)(p.m0 + r) * 16 + lane] = (lane == 0) ? s : 0.f; }
    }
}
constexpr int PT_DEFER = 2 * 1024, PT_DEFER0 = (NLAYER - 1) * PT_LAYER + (PT_LAYER - PT_DEFER);
__device__ __forceinline__ void pro_items(Frame& F, const Args& a, LAS float* scr, int gw, int ngw, int count, int skip_at, int skip) {
    unsigned char* ws = F.ws; unsigned char* outb = (unsigned char*)F.out;
    f32x4 va[16], vb[16]; PItem pa, pb;
#define PRO_IX(i_) ((i_) < skip_at ? (i_) : (i_) + skip)
    int it = gw;
    if (it < count) { pa = pro_decode(PRO_IX(it), a, ws, outb); pro_load(va, pa, F.lane); }
    while (it < count) {
        const int i1 = it + ngw; if (i1 < count) { pb = pro_decode(PRO_IX(i1), a, ws, outb); pro_load(vb, pb, F.lane); }
        pro_process(va, pa, scr, F.lane, ws, ws + WS_X8);
        if (i1 >= count) break;
        const int i2 = i1 + ngw; if (i2 < count) { pa = pro_decode(PRO_IX(i2), a, ws, outb); pro_load(va, pa, F.lane); }
        pro_process(vb, pb, scr, F.lane, ws, ws + WS_X8);
        it = i2;
    }
#undef PRO_IX
}
__device__ __forceinline__ void phase_prologue(Frame& F, const Args& a) {
    LAS float* scr = (LAS float*)(F.lds + F.wave * 16640);
    const int gw = F.vcu * 8 + F.wave, NGW = F.G * 8;
    unsigned char* ws = F.ws; unsigned char* outb = (unsigned char*)F.out;
    {
        if (gw == 0) { unsigned* cur = (unsigned*)(ws + WS_CUR); for (int i = F.lane; i < NLAYER * 512; i += 64) cur[i] = 0u; }
        const float* rel_bias = a.in[1]; float* lut = (float*)(ws + WS_LUT);
        for (int i = gw * 64 + F.lane; i < 16 * LUTN; i += NGW * 64) { const int hh = i / LUTN, k = i % LUTN, d = k - LUTPAD;
            lut[i] = (d < 0) ? 0.f : rel_bias[rel_bucket(d) * 16 + hh] * LOG2E; }
    }
    pro_items(F, a, scr, gw, NGW, NLAYER * PT_LAYER + PT_X - PT_DEFER, PT_DEFER0, PT_DEFER);
}

__device__ __forceinline__ void phase_swa_select(Frame& F, const Args& a, int l) {
    using namespace att;
    const bool tailwg = (F.G == 256) && (blockIdx.x < 64);
    if (F.G == 256) {
        unsigned char* ws_ = F.ws; unsigned char* wb_ = (l == 0) ? (unsigned char*)F.out + DO_W : ws_ + WS_W;
        pg8::Gemm g{F8_G1 ? ws_ + WS_X8 : ws_ + WS_XB, wb_ + OFF_WIN, F8_G1 ? D : 2 * D, F8_G1 ? D : 2 * D, F8_G1 ? D : 2 * D, 0}; pg8::StaticOrder S; S.init_single((int)blockIdx.x, 16, tailwg);
        if (tailwg) { proj_consts((LAS float*)(F.lds + L_RSTD), a.in[5] + l * 64, a.in[6] + l * 64, a.in[7] + l * 64, a.in[8] + l * 64, a.in[4] + l * 2048); rstd_table((LAS float*)(F.lds + L_RSTD), (const float*)(ws_ + WS_SSQ), (int)blockIdx.x, F8_G1 ? 1.0f / F8_SW : 1.0f); }
        pg8::EpiProj E{(const LAS float*)(F.lds + L_RSTD), (bf16_t*)(ws_ + WS_QA), (bf16_t*)(ws_ + WS_KA), (bf16_t*)(ws_ + WS_VA), (bf16_t*)(ws_ + WS_QB), (bf16_t*)(ws_ + WS_KB), (bf16_t*)(ws_ + WS_VB), (bf16_t*)(ws_ + WS_GT), (float*)(ws_ + WS_KMP)};
        if (tailwg) pg8::gemm_phase<F8_G1 != 0, pg8::EpiProj>(F.lds, g, S, E);
    }
    unsigned char* ws = F.ws; LAS unsigned char* lds = F.lds;
    const int tid = F.tid, lane = F.lane, wave = F.wave, r32 = lane & 31, hi = lane >> 5;
    const bf16_t* Qb = (const bf16_t*)(ws + WS_QB); const bf16_t* Kb = (const bf16_t*)(ws + WS_KB); const bf16_t* Vb = (const bf16_t*)(ws + WS_VB);
    unsigned char* Y = (unsigned char*)F.out + DO_Y;
    const float* lutg = (const float*)(ws + WS_LUT); const float* sinks = a.in[9] + l * 8;
    LAS float* lut = (LAS float*)(lds + L_LUT); LAS float* wsf = (LAS float*)(lds + L_WSF) + wave * 64; LAS bf16_t* stg = (LAS bf16_t*)(lds + L_OST) + wave * 2048;
    const int bxi = (int)blockIdx.x; const bool swa_split = (F.G == 256);
    for (int ui = 0; ui < 2; ++ui) {
        int unit, gi_lo = 0, gi_hi = 16;
        if (swa_split) { if (tailwg) break;
            if (ui == 0) unit = bxi;
            else if (bxi < 128) { unit = bxi - 64; gi_hi = 8; }
            else if (bxi < 192) { unit = bxi - 128; gi_lo = 8; }
            else break; }
        else { if (ui == 1) break; unit = F.vcu; if (unit >= 256) break; }
        const int kvh = unit >> 7, c = unit & 127;
        bf16x8 qsw[2][4];
#pragma unroll
        for (int k2 = 0; k2 < 2; ++k2) { const int gi_ = gi_lo + wave + 8 * k2; const int gg_ = gi_ < gi_hi ? gi_ : gi_lo + wave;
            load_q(qsw[k2], Qb + (size_t)(128 * c + 32 * (gg_ & 3) + r32) * 512 + (kvh * 4 + (gg_ >> 2)) * 64, hi); }
        __syncthreads();
        load_kv(lds, Kb + kvh * 64, Vb + kvh * 64, 128, 128 * c - 128, tid);
        for (int i = tid; i < 4 * 512; i += 512) lut4_put(lut + (i >> 9) * 2048, 512, i & 511, lutg[(size_t)(8 + kvh * 4 + (i >> 9)) * LUTN + (i & 511)]);
        __syncthreads();
        for (int gi = gi_lo + wave; gi < gi_hi; gi += 8) {
            const int hl = gi >> 2, g = gi & 3, hq = kvh * 4 + hl, q = 128 * c + 32 * g + r32;
            bf16x8 qr[4];
#pragma unroll
            for (int d0 = 0; d0 < 4; ++d0) qr[d0] = (gi - gi_lo - wave) ? qsw[1][d0] : qsw[0][d0];
            f32x16 o[2];
#pragma unroll
            for (int r = 0; r < 16; ++r) { o[0][r] = 0.f; o[1][r] = 0.f; }
            float lsum = 0.f; const unsigned dmax = (unsigned)(q < 127 ? q : 127);
            const int t0 = g < 2 ? 0 : 1; const LutLane LL = lut_lane(lut + hl * 2048, 512, 512, r32 - 4 * hi);
            for (int t = t0; t < t0 + 3; ++t)
                tile<true, true>(o, lsum, qr, lds + L_K + t * 8192, lds + L_V + t * 8192, 0.f, LL, 32 * g + r32 + 128 - 64 * t, dmax, r32, hi, lane, t != t0 + 1 || c == 0);
            lsum += __shfl_xor(lsum, 32);
            lsum += __builtin_amdgcn_exp2f(sinks[hq] * LOG2E);
            if (hi == 0) wsf[r32] = lsum;
            stage_o(stg, o, r32, hi);
            LDS_WAIT(); asm volatile("" ::: "memory");
#pragma unroll
            for (int i = 0; i < 4; ++i) { const int row = i * 8 + (lane >> 3), ch = lane & 7;
                const u32x4 v = *(const LAS u32x4*)(stg + row * 64 + ch * 8); float f[8]; unpack8(f, v);
                const float inv = F8_SY / wsf[row];
#pragma unroll
                for (int e = 0; e < 8; ++e) f[e] *= inv;
                const size_t yo = (size_t)(128 * c + 32 * g + row) * 1024 + 512 + hq * 64 + ch * 8;
                if (F8_G2) *(u32x2*)(Y + yo) = pack8f8(f); else *(u32x4*)(Y + 2 * yo) = pack8(f); }
            LDS_WAIT(); asm volatile("" ::: "memory");
        }
    }
    const bf16_t* Qa = (const bf16_t*)(ws + WS_QA); const float* kmp = (const float*)(ws + WS_KMP);
    unsigned* cursor = (unsigned*)(ws + WS_CUR) + l * 512; unsigned short* lists = (unsigned short*)(ws + WS_LISTS);
    LAS unsigned* hist = (LAS unsigned*)(lds + L_SM); LAS unsigned* lbase = hist + 64;
    int sel0, selstep, selend;
    if (F.G == 256) { const int bx_ = (int)blockIdx.x;
        if (bx_ < 64) { sel0 = bx_; selstep = 512; selend = 64; }
        else if (bx_ < 192) { sel0 = bx_; selstep = 128; selend = 320; }
        else { sel0 = 320 + (bx_ - 192); selstep = 64; selend = 512; } }
    else { sel0 = F.vcu; selstep = F.G; selend = 512; }
    f32x4 kmr[4]; bf16x8 qsel[4];
#define SEL_FETCH(unit_) do { const int h_ = (unit_) >> 6, qb_ = (unit_) & 63; const float* p_ = kmp + ((size_t)(h_ * 64 + (tid >> 3)) * 2) * 64 + (tid & 7) * 8; \
        kmr[0] = *(const f32x4*)(p_); kmr[1] = *(const f32x4*)(p_ + 4); kmr[2] = *(const f32x4*)(p_ + 64); kmr[3] = *(const f32x4*)(p_ + 68); \
        load_q(qsel, Qa + (size_t)(qb_ * 256 + 32 * wave + r32) * 512 + h_ * 64, hi); } while (0)
    if (sel0 < selend) SEL_FETCH(sel0);
    for (int unit = sel0; unit < selend; unit += selstep) {
        const int h = unit >> 6, qb = unit & 63;
        __syncthreads();
        { const int j = tid >> 3, cch = tid & 7;
          float hi8[8], lo8[8];
#pragma unroll
          for (int e = 0; e < 8; ++e) { const float km = (kmr[e >> 2][e & 3] + kmr[2 + (e >> 2)][e & 3]) * (1.0f / 256.0f); const unsigned hb = f2bf(km); const float hf = __builtin_bit_cast(float, hb << 16); hi8[e] = hf; lo8[e] = km - hf; }
          *(LAS u32x4*)(lds + L_K + kswz(j, cch)) = pack8(hi8); *(LAS u32x4*)(lds + L_K + 8192 + kswz(j, cch)) = pack8(lo8); }
        if (tid < 64) hist[tid] = 0u;
        __syncthreads();
        const int q = qb * 256 + 32 * wave + r32;
        int i1 = 255, i2 = 255, i3 = 255;
        {
            bf16x8 qr[4];
#pragma unroll
            for (int d0 = 0; d0 < 4; ++d0) qr[d0] = qsel[d0];
            if (unit + selstep < selend) SEL_FETCH(unit + selstep);
            f32x16 p0, p1;
#pragma unroll
            for (int r = 0; r < 16; ++r) { p0[r] = 0.f; p1[r] = 0.f; }
            qkt(p0, p1, lds + L_K, qr, r32, hi); qkt(p0, p1, lds + L_K + 8192, qr, r32, hi);
            float v1 = -INFINITY, v2 = -INFINITY, v3 = -INFINITY;
#define TOP_INS(v_, i_) do { const float vv = (v_); const int ii = (i_); if (vv > v3) { if (vv > v2) { v3 = v2; i3 = i2; if (vv > v1) { v2 = v1; i2 = i1; v1 = vv; i1 = ii; } else { v2 = vv; i2 = ii; } } else { v3 = vv; i3 = ii; } } } while (0)
#pragma unroll
            for (int r = 0; r < 16; ++r) { const int j0 = crow(r, hi), j1 = 32 + j0;
                TOP_INS(j0 < qb ? p0[r] : -INFINITY, j0); TOP_INS(j1 < qb ? p1[r] : -INFINITY, j1); }
            const float w1 = __shfl_xor(v1, 32), w2 = __shfl_xor(v2, 32), w3 = __shfl_xor(v3, 32);
            const int k1 = __shfl_xor(i1, 32), k2 = __shfl_xor(i2, 32), k3 = __shfl_xor(i3, 32);
            TOP_INS(w1, k1); TOP_INS(w2, k2); TOP_INS(w3, k3);
#undef TOP_INS
            if (hi == 0) {
                if (i1 < 64) __hip_atomic_fetch_add(hist + i1, 1u, __ATOMIC_RELAXED, __HIP_MEMORY_SCOPE_WORKGROUP);
                if (i2 < 64) __hip_atomic_fetch_add(hist + i2, 1u, __ATOMIC_RELAXED, __HIP_MEMORY_SCOPE_WORKGROUP);
                if (i3 < 64) __hip_atomic_fetch_add(hist + i3, 1u, __ATOMIC_RELAXED, __HIP_MEMORY_SCOPE_WORKGROUP);
            }
        }
        __syncthreads();
        if (tid < 64) { const unsigned c = hist[tid]; unsigned bs = 0u; if (c) bs = __hip_atomic_fetch_add(cursor + h * 64 + tid, c, __ATOMIC_RELAXED, __HIP_MEMORY_SCOPE_AGENT); lbase[tid] = bs; hist[tid] = 0u; }
        __syncthreads();
        if (hi == 0) {
            const int pick[3] = {i1, i2, i3};
#pragma unroll
            for (int s = 0; s < 3; ++s) { const int j = pick[s];
                if (j < 64) { const unsigned rk = __hip_atomic_fetch_add(hist + j, 1u, __ATOMIC_RELAXED, __HIP_MEMORY_SCOPE_WORKGROUP);
                    lists[(size_t)h * LIST_HEAD + 256 * (63 * j - (j * (j - 1)) / 2) + lbase[j] + rk] = (unsigned short)(q | (s << 14)); } }
        }
    }
#undef SEL_FETCH
    if (l == 0 && tailwg) {
        __syncthreads();
        pro_items(F, a, (LAS float*)(F.lds + F.wave * 16640), (int)blockIdx.x * 8 + F.wave, 64 * 8, PT_DEFER, 0, PT_DEFER0);
    }
}

__device__ __forceinline__ void phase_moba_past(Frame& F, const Args& a, int l) {
    using namespace att;
    constexpr int PCH = 512;
    unsigned char* ws = F.ws; LAS unsigned char* lds = F.lds;
    const int tid = F.tid, lane = F.lane, wave = F.wave, r32 = lane & 31, hi = lane >> 5;
    const bf16_t* Qa = (const bf16_t*)(ws + WS_QA); const bf16_t* Ka = (const bf16_t*)(ws + WS_KA); const bf16_t* Va = (const bf16_t*)(ws + WS_VA);
    const unsigned* cursor = (const unsigned*)(ws + WS_CUR) + l * 512; const unsigned short* lists = (const unsigned short*)(ws + WS_LISTS);
    bf16_t* Po = (bf16_t*)(ws + WS_PO); float* Pl = (float*)(ws + WS_PL);
    const float* lutg = (const float*)(ws + WS_LUT);
    LAS float* lut = (LAS float*)(lds + L_LUT); LAS bf16_t* stg = (LAS bf16_t*)(lds + L_OST) + wave * 2048;
    LAS unsigned* pfx = (LAS unsigned*)(lds + L_TAB); LAS unsigned* nls = pfx + 512; LAS unsigned* pfs = pfx + 1024;
    LAS unsigned* scan = (LAS unsigned*)(lds + L_SM);
    __syncthreads();
    const int nlist = (int)cursor[tid];
    const int nrem = nlist % PCH, nbig = nlist / PCH + (nrem > PCH / 2 ? 1 : 0), nsml = (nrem > 0 && nrem <= PCH / 2) ? 1 : 0;
    int inc = nbig | (nsml << 16);
#pragma unroll
    for (int o = 1; o < 64; o <<= 1) { const int v = __shfl_up(inc, o); if (lane >= o) inc += v; }
    if (lane == 63) scan[wave] = (unsigned)inc;
    __syncthreads();
    { int base = 0; for (int w = 0; w < wave; ++w) base += (int)scan[w]; const int tot_ = base + inc; pfx[tid] = (unsigned)(tot_ & 0xffff); pfs[tid] = (unsigned)(tot_ >> 16); nls[tid] = (unsigned)nlist; }
    int totb = 0; for (int w = 0; w < 8; ++w) totb += (int)scan[w];
    totb = __builtin_amdgcn_readfirstlane(totb);
    const int nbigtot = totb & 0xffff; const int total = nbigtot + (totb >> 16);
    __syncthreads();
    u32x4 kreg[4], vreg[4]; float lreg[5];
    const int lw = tid >> 6, kr = lw * 8 + (lane >> 3), kc8 = lane & 7;
#define PAST_FETCH(h_, j_) do { \
        const bf16_t* Kg_ = Ka + (h_) * 64 + (size_t)((j_) * 256) * 512; const bf16_t* Vg_ = Va + (h_) * 64 + (size_t)((j_) * 256) * 512; \
        _Pragma("unroll") for (int t = 0; t < 4; ++t) { kreg[t] = *(const u32x4*)(Kg_ + (size_t)(64 * t + kr) * 512 + kc8 * 8); \
            vreg[t] = *(const u32x4*)(Vg_ + (size_t)(64 * t + 16 * (lw & 3) + (lane >> 2)) * 512 + (lw >> 2) * 32 + (lane & 3) * 8); } \
        _Pragma("unroll") for (int i = 0; i < 5; ++i) { const int ix = tid + 512 * i; lreg[i] = lutg[(size_t)(h_) * LUTN + (ix < LUTN ? ix : LUTN - 1)]; } } while (0)
#define PAST_DEC(it_, h_, j_, k_, n_) int h_, j_, k_, n_; { const bool big_ = (it_) < nbigtot; const int iq_ = big_ ? (it_) : (it_) - nbigtot; const LAS unsigned* px_ = big_ ? pfx : pfs; \
        int lo_ = 0, hi_ = 511; while (lo_ < hi_) { const int mid_ = (lo_ + hi_) >> 1; if ((int)px_[mid_] > iq_) hi_ = mid_; else lo_ = mid_ + 1; } \
        h_ = lo_ >> 6; j_ = lo_ & 63; k_ = big_ ? iq_ - (lo_ ? (int)pfx[lo_ - 1] : 0) : (int)nls[lo_] / PCH; n_ = (int)nls[lo_] - PCH * k_; n_ = n_ > PCH ? PCH : n_; \
        h_ = __builtin_amdgcn_readfirstlane(h_); j_ = __builtin_amdgcn_readfirstlane(j_); k_ = __builtin_amdgcn_readfirstlane(k_); n_ = __builtin_amdgcn_readfirstlane(n_); }
#define PAST_LP(h_, j_, k_) (lists + (size_t)(h_) * LIST_HEAD + 256 * (63 * (j_) - ((j_) * ((j_) - 1)) / 2) + (k_) * PCH)
#define WG_BAR() asm volatile("s_waitcnt lgkmcnt(0)\n\ts_barrier" ::: "memory")
    int it = F.vcu;
    unsigned ec0 = 0u, ec1 = 0u; bf16x8 qr_c[4]; int hprev = -1;
#pragma unroll
    for (int d0 = 0; d0 < 4; ++d0) qr_c[d0] = (bf16x8){0, 0, 0, 0, 0, 0, 0, 0};
    int h = 0, j = 0, kc = 0, n = 0;
    if (it < total) { PAST_DEC(it, h0, j0, k0, n0); h = h0; j = j0; kc = k0; n = n0; const int idx0 = wave * 32 + r32; const unsigned short* lp0 = PAST_LP(h0, j0, k0);
        ec0 = lp0[idx0 < n0 ? idx0 : 0]; ec1 = lp0[idx0 + 256 < n0 ? idx0 + 256 : 0]; PAST_FETCH(h0, j0); load_q(qr_c, Qa + (size_t)(ec0 & 0x3fffu) * 512 + h0 * 64, hi); }
    for (; it < total; it += F.G) {
        WG_BAR();
#pragma unroll
        for (int t = 0; t < 4; ++t) { *(LAS u32x4*)(lds + L_K + t * 8192 + kswz(kr, kc8)) = kreg[t]; *(LAS u32x4*)(lds + L_V + t * 8192 + lw * 1024 + lane * 16) = vreg[t]; }
        if (h != hprev) {
#pragma unroll
            for (int i = 0; i < 5; ++i) { const int ix = tid + 512 * i; if (ix < LUTN) lut4_put(lut, LUTN, ix, lreg[i]); }
            hprev = h; }
        WG_BAR();
        const bool hn = it + F.G < total; unsigned en0 = 0u, en1 = 0u; int hnx = 0, jnx = 0, knx = 0, nnx = 0;
        if (hn) { PAST_DEC(it + F.G, h1, j1, k1, n1); const int idx1 = wave * 32 + r32; hnx = h1; jnx = j1; knx = k1; nnx = n1; const unsigned short* lp1 = PAST_LP(h1, j1, k1);
            en0 = lp1[idx1 < n1 ? idx1 : 0]; en1 = lp1[idx1 + 256 < n1 ? idx1 + 256 : 0]; PAST_FETCH(h1, j1); }
        const float cbias = lut[LUTN - 1];
        const bool act1 = (wave + 8) * 32 < n;
#pragma unroll 1
        for (int gi = 0; gi < 2; ++gi) {
            const int g = wave + 8 * gi;
            const bool nx_same = (gi == 0) && act1; const bool nx_any = nx_same || hn;
            const unsigned nx_ent = nx_same ? ec1 : en0; const int nx_h = nx_same ? h : hnx;
            const bf16_t* nx_q = Qa + (size_t)(nx_ent & 0x3fffu) * 512 + nx_h * 64;
            if (g * 32 < n) {
                const unsigned ent_c = gi ? ec1 : ec0;
                const int idx = g * 32 + r32; const bool valid = idx < n;
                const int q = (int)(ent_c & 0x3fffu), s = (int)(ent_c >> 14);
                f32x16 o[2];
#pragma unroll
                for (int r = 0; r < 16; ++r) { o[0][r] = 0.f; o[1][r] = 0.f; }
                float lsum = 0.f;
                const int dfirst = q - j * 256;
                const LutLane LL = lut_lane(lut, LUTN, LUTN, dfirst - 4 * hi);
                bf16x8 qr_n[4];
#pragma unroll
                for (int d0 = 0; d0 < 4; ++d0) qr_n[d0] = qr_c[d0];
                if (__all(dfirst - 255 >= 1513)) {
#pragma unroll 1
                    for (int t = 0; t < 4; ++t) { tile<false, false>(o, lsum, qr_c, lds + L_K + t * 8192, lds + L_V + t * 8192, cbias, LL, dfirst - 64 * t, 0u, r32, hi, lane);
                        if (t == 1 && nx_any) load_q(qr_n, nx_q, hi); }
                } else {
#pragma unroll 1
                    for (int t = 0; t < 4; ++t) { tile<true, false>(o, lsum, qr_c, lds + L_K + t * 8192, lds + L_V + t * 8192, 0.f, LL, dfirst - 64 * t, 0u, r32, hi, lane);
                        if (t == 1 && nx_any) load_q(qr_n, nx_q, hi); }
                }
                lsum += __shfl_xor(lsum, 32);
                if (hi == 0 && valid) Pl[(size_t)(s * 8 + h) * M + q] = lsum;
                stage_o(stg, o, r32, hi);
                LDS_WAIT(); asm volatile("" ::: "memory");
#pragma unroll
                for (int i = 0; i < 4; ++i) { const int row = i * 8 + (lane >> 3), ch = lane & 7;
                    const u32x4 v = *(const LAS u32x4*)(stg + row * 64 + ch * 8);
                    const unsigned en = (unsigned)__shfl((int)ent_c, row);
                    if (g * 32 + row < n) { const int qq = (int)(en & 0x3fffu), ss = (int)(en >> 14);
                        *(u32x4*)(Po + ((size_t)(ss * 8 + h) * M + qq) * 64 + ch * 8) = v; } }
                LDS_WAIT(); asm volatile("" ::: "memory");
#pragma unroll
                for (int d0 = 0; d0 < 4; ++d0) qr_c[d0] = qr_n[d0];
            } else if (gi == 0 && nx_any) load_q(qr_c, nx_q, hi);
        }
        ec0 = en0; ec1 = en1; h = hnx; j = jnx; kc = knx; n = nnx;
    }
#undef WG_BAR
#undef PAST_FETCH
#undef PAST_DEC
#undef PAST_LP
}

__device__ __forceinline__ void phase_moba_own(Frame& F, const Args& a, int l) {
    using namespace att;
    unsigned char* ws = F.ws; LAS unsigned char* lds = F.lds;
    const int tid = F.tid, lane = F.lane, wave = F.wave, r32 = lane & 31, hi = lane >> 5;
    const bf16_t* Qa = (const bf16_t*)(ws + WS_QA); const bf16_t* Ka = (const bf16_t*)(ws + WS_KA); const bf16_t* Va = (const bf16_t*)(ws + WS_VA);
    const bf16_t* Po = (const bf16_t*)(ws + WS_PO); const float* Pl = (const float*)(ws + WS_PL);
    unsigned char* Y = (unsigned char*)F.out + DO_Y;
    const float* lutg = (const float*)(ws + WS_LUT);
    LAS float* lut = (LAS float*)(lds + L_LUT); LAS float* wsf = (LAS float*)(lds + L_WSF) + wave * 64; LAS bf16_t* stg = (LAS bf16_t*)(lds + L_OST) + wave * 2048;
#define WG_BAR() asm volatile("s_waitcnt lgkmcnt(0)\n\ts_barrier" ::: "memory")
    u32x4 kreg[4], vreg[4]; float lreg;
    const int lw = tid >> 6, kr = lw * 8 + (lane >> 3), kc8 = lane & 7;
#define OWN_FETCH(unit_) do { const int h_ = (unit_) >> 6, qb_ = (unit_) & 63; \
        const bf16_t* Kg_ = Ka + h_ * 64 + (size_t)(qb_ * 256) * 512; const bf16_t* Vg_ = Va + h_ * 64 + (size_t)(qb_ * 256) * 512; \
        _Pragma("unroll") for (int t = 0; t < 4; ++t) { kreg[t] = *(const u32x4*)(Kg_ + (size_t)(64 * t + kr) * 512 + kc8 * 8); \
            vreg[t] = *(const u32x4*)(Vg_ + (size_t)(64 * t + 16 * (lw & 3) + (lane >> 2)) * 512 + (lw >> 2) * 32 + (lane & 3) * 8); } \
        lreg = lutg[(size_t)h_ * LUTN + tid]; } while (0)
    int unit = F.vcu;
    if (unit < 512) OWN_FETCH(unit);
    for (; unit < 512; unit += F.G) {
        const int h = unit >> 6, qb = unit & 63, nsl = qb < 3 ? qb : 3;
        const int q = qb * 256 + 32 * wave + r32;
        bf16x8 qr[4]; load_q(qr, Qa + (size_t)q * 512 + h * 64, hi);
        u32x4 pov[4][3]; float plv[4][3];
#pragma unroll
        for (int i = 0; i < 4; ++i) { const int row = i * 8 + (lane >> 3), ch = lane & 7, qq = qb * 256 + 32 * wave + row;
#pragma unroll
            for (int s = 0; s < 3; ++s) { const size_t pi = (size_t)(s * 8 + h) * M + qq;
                if (s < nsl) { plv[i][s] = Pl[pi]; pov[i][s] = __builtin_nontemporal_load((const u32x4*)(Po + pi * 64 + ch * 8)); } else { plv[i][s] = 0.f; pov[i][s] = (u32x4){0u, 0u, 0u, 0u}; } } }
        WG_BAR();
#pragma unroll
        for (int t = 0; t < 4; ++t) { *(LAS u32x4*)(lds + L_K + t * 8192 + kswz(kr, kc8)) = kreg[t]; *(LAS u32x4*)(lds + L_V + t * 8192 + lw * 1024 + lane * 16) = vreg[t]; }
        lut4_put(lut, 512, tid, lreg);
        WG_BAR();
        if (unit + F.G < 512) OWN_FETCH(unit + F.G);
        f32x16 o[2];
#pragma unroll
        for (int r = 0; r < 16; ++r) { o[0][r] = 0.f; o[1][r] = 0.f; }
        float lsum = 0.f; const int nt = (wave >> 1) + 1; const LutLane LL = lut_lane(lut, 512, 512, r32 - 4 * hi);
#pragma unroll 1
        for (int t = 0; t < nt; ++t)
            tile<true, true>(o, lsum, qr, lds + L_K + t * 8192, lds + L_V + t * 8192, 0.f, LL, 32 * wave + r32 - 64 * t, 0x7fffffffu, r32, hi, lane, t == nt - 1);
        lsum += __shfl_xor(lsum, 32);
        if (hi == 0) wsf[r32] = lsum;
        stage_o(stg, o, r32, hi);
        LDS_WAIT(); asm volatile("" ::: "memory");
#pragma unroll
        for (int i = 0; i < 4; ++i) { const int row = i * 8 + (lane >> 3), ch = lane & 7, qq = qb * 256 + 32 * wave + row;
            const u32x4 v = *(const LAS u32x4*)(stg + row * 64 + ch * 8); float f[8]; unpack8(f, v);
            float L = wsf[row];
#pragma unroll
            for (int s = 0; s < 3; ++s) { L += plv[i][s]; float pf[8]; unpack8(pf, pov[i][s]);
#pragma unroll
                for (int e = 0; e < 8; ++e) f[e] += pf[e]; }
            const float inv = F8_SY / L;
#pragma unroll
            for (int e = 0; e < 8; ++e) f[e] *= inv;
            const size_t yo = (size_t)qq * 1024 + h * 64 + ch * 8;
            if (F8_G2) *(u32x2*)(Y + yo) = pack8f8(f); else *(u32x4*)(Y + 2 * yo) = pack8(f); }
        LDS_WAIT(); asm volatile("" ::: "memory");
    }
#undef OWN_FETCH
#undef WG_BAR
}

__global__ void __launch_bounds__(512, 2) fwd_kernel(Args args) {
    extern __shared__ __attribute__((aligned(16))) unsigned char lds_raw[];
    Frame F;
    F.lds = (LAS unsigned char*)lds_raw;
    F.tid = threadIdx.x; F.lane = F.tid & 63; F.wave = __builtin_amdgcn_readfirstlane(F.tid >> 6);
    F.G = gridDim.x; { const int bx = blockIdx.x; F.vcu = (F.G % 8 == 0) ? (bx % 8) * (F.G / 8) + bx / 8 : bx; }
    F.ws = args.ws; F.out = args.out;
    unsigned char* ws = args.ws;
    volatile LAS unsigned* MISC = (volatile LAS unsigned*)(F.lds + MISC_OFF);
    for (int u = F.tid; u < (LDS_BYTES - LDSCTL_OFF) / 4; u += 512) ((LAS unsigned*)(F.lds + LDSCTL_OFF))[u] = 0u;
    __syncthreads();
    XcdBarrier bar; bar.bar = (unsigned*)(ws + WS_CTL) + 4096; bar.x = 0; bar.st = nullptr;
    const bool multi = (args.ph_hi - args.ph_lo) > 1;
    if (multi) bar = xcd_barrier_post((unsigned*)(ws + WS_CTL) + 4096, MISC + 8);

    const int lo = args.ph_lo, hi = args.ph_hi;
    float* ssq = (float*)(ws + WS_SSQ);
#ifndef PH_MASK
#define PH_MASK 0x1ffff
#endif
#define IN(k) (lo <= (k) && (k) < hi && ((PH_MASK >> ((k) > 8 ? (k) - 8 : (k))) & 1))
#define SEAM(k) do { if (IN(k) && IN((k) + 1)) xcd_barrier(bar); } while (0)
#ifndef REP_MASK
#define REP_MASK 0
#endif
#define RUN(p, l, X) do { if (IN(1 + NPH * (l) + (p))) { X; if ((REP_MASK >> (p)) & 1) { xcd_barrier(bar); X; } } SEAM(1 + NPH * (l) + (p)); } while (0)
#define WB(l) ((l) == 0 ? (unsigned char*)args.out + DO_W : ws + WS_W)
#define PH_G1(l) do { \
        pg8::Gemm g{F8_G1 ? ws + WS_X8 : ws + WS_XB, WB(l) + OFF_WIN, F8_G1 ? D : 2 * D, F8_G1 ? D : 2 * D, F8_G1 ? D : 2 * D, 0}; pg8::StaticOrder S; S.init(M, INW - 256, F.G, (int)blockIdx.x, 1); \
        const int pm0_ = S.first_pm(); const LAS float* rt_ = (const LAS float*)(F.lds + L_RSTD); proj_consts((LAS float*)(F.lds + L_RSTD), args.in[5] + (l) * 64, args.in[6] + (l) * 64, args.in[7] + (l) * 64, args.in[8] + (l) * 64, args.in[4] + (l) * 2048); rstd_table((LAS float*)(F.lds + L_RSTD), ssq, pm0_ < 0 ? 0 : pm0_, F8_G1 ? 1.0f / F8_SW : 1.0f); \
        pg8::EpiProj E{rt_, (bf16_t*)(ws + WS_QA), (bf16_t*)(ws + WS_KA), (bf16_t*)(ws + WS_VA), (bf16_t*)(ws + WS_QB), (bf16_t*)(ws + WS_KB), (bf16_t*)(ws + WS_VB), (bf16_t*)(ws + WS_GT), (float*)(ws + WS_KMP)}; \
        pg8::gemm_phase<F8_G1 != 0, pg8::EpiProj>(F.lds, g, S, E); } while (0)
#define PH_G2(l) do { \
        pg8::Gemm g{(unsigned char*)args.out + DO_Y, WB(l) + OFF_WBR, F8_G2 ? D : 2 * D, F8_G2 ? D : 2 * D, F8_G2 ? 512 : 1024, F8_G2 ? 512 : 1024}; pg8::StaticOrder S; S.init(M, D, F.G, (int)blockIdx.x, 2); \
        pg8::EpiMerge E{(const bf16_t*)(ws + WS_GT), ws + WS_MRG}; \
        pg8::gemm_phase<F8_G2 != 0, pg8::EpiMerge>(F.lds, g, S, E); } while (0)
#define PH_G3(l) do { \
        pg8::Gemm g{ws + WS_MRG, WB(l) + OFF_WOUT, F8_G3 ? D : 2 * D, F8_G3 ? D : 2 * D, F8_G3 ? D : 2 * D, 0}; pg8::StaticOrder S; S.init(M, D, F.G, (int)blockIdx.x, 1); \
        pg8::EpiResid E{(bf16_t*)(ws + WS_XB), ssq, nullptr, 1.0f / (F8_SM * F8_SW3), nullptr}; \
        pg8::gemm_phase<F8_G3 != 0, pg8::EpiResid>(F.lds, g, S, E); } while (0)
#define PH_G4(l) do { \
        pg8::Gemm g{ws + WS_XB, WB(l) + OFF_W1, 2 * D, 2 * D, 2 * D, 0}; pg8::StaticOrder S; S.init(M, FF, F.G, (int)blockIdx.x, 1); \
        const int pm0_ = S.first_pm(); const LAS float* rt_ = (const LAS float*)(F.lds + L_RSTD); rstd_table((LAS float*)(F.lds + L_RSTD), ssq, pm0_ < 0 ? 0 : pm0_, 1.0f); \
        pg8::EpiFfnUp E{rt_, (bf16_t*)(ws + WS_U)}; \
        pg8::gemm_phase<false, pg8::EpiFfnUp>(F.lds, g, S, E); } while (0)
#define PH_G5(l) do { \
        pg8::Gemm g{ws + WS_U, WB(l) + OFF_W2, 2 * FF, 2 * FF, 2 * FF, 0}; pg8::StaticOrder S; S.init(M, D, F.G, (int)blockIdx.x, 1); \
        pg8::EpiResid E{(bf16_t*)(ws + WS_XB), ssq, (l) == NLAYER - 1 ? args.out : nullptr, 1.0f, (l) == NLAYER - 1 || !F8_G1 ? nullptr : ws + WS_X8}; \
        pg8::gemm_phase<false, pg8::EpiResid>(F.lds, g, S, E); } while (0)
#define LAYER(l) do { \
    RUN(0, l, PH_G1(l)); \
    RUN(1, l, phase_swa_select(F, args, (l))); \
    RUN(2, l, phase_moba_past(F, args, (l))); \
    RUN(3, l, phase_moba_own(F, args, (l))); \
    RUN(4, l, PH_G2(l)); \
    if (IN(1 + NPH * (l) + 5)) { PH_G3(l); } SEAM(1 + NPH * (l) + 5); \
    RUN(6, l, PH_G4(l)); \
    if (IN(1 + NPH * (l) + 7)) { PH_G5(l); } SEAM(1 + NPH * (l) + 7); \
    } while (0)
    if (IN(0)) { phase_prologue(F, args); } SEAM(0);
    LAYER(0);
    LAYER(1);
#undef LAYER
#undef RUN
#undef WB
#undef SEAM
#undef IN
}

extern "C" void kernel_launch(void* const* d_in, const int* in_sizes, int n_in, void* d_out, int out_size, void* d_ws, size_t ws_size, hipStream_t stream) {
    static int grid = 0;
    if (grid == 0) {
        if (n_in != 16 || out_size != M * D || ws_size < WS_END) { fprintf(stderr, "kernel_launch: unexpected shapes (n_in %d out %d ws %zu)\n", n_in, out_size, ws_size); grid = -1; return; }
        if (hipFuncSetAttribute((const void*)fwd_kernel, hipFuncAttributeMaxDynamicSharedMemorySize, LDS_BYTES) != hipSuccess) { fprintf(stderr, "kernel_launch: hipFuncSetAttribute failed\n"); grid = -1; return; }
        (void)hipGetLastError();
        grid = 256;
    }
    if (grid < 0) return;
    (void)hipMemsetAsync((char*)d_ws + WS_CTL, 0, CTL_ZERO_BYTES, stream);
    Args a{};
    for (int i = 0; i < 16; ++i) a.in[i] = (const float*)d_in[i];
    a.out = (float*)d_out; a.ws = (unsigned char*)d_ws;
    constexpr int NPHASES = 1 + NLAYER * NPH;
    if (MK_N_LAUNCHES == 1) {
        a.ph_lo = 0; a.ph_hi = NPHASES;
        hipLaunchKernelGGL(fwd_kernel, dim3(grid), dim3(512), LDS_BYTES, stream, a);
    } else {
        for (int p = 0; p < NPHASES; ++p) { a.ph_lo = p; a.ph_hi = p + 1; hipLaunchKernelGGL(fwd_kernel, dim3(grid), dim3(512), LDS_BYTES, stream, a); }
    }
}
```
